# Optimizing an MI355X kernel written in HIP

```python
import math
import jax
import jax.numpy as jnp
from jax import lax
import numpy as np

D_MODEL = 2048
BATCH = 4
SEQ = 2048
DEPTH = 1
DEC_BATCH = 128
DEC_SEQ = 4
PAST_LEN = 2048
PAGE_SIZE = 128

N_HEADS = 16
N_KV_HEADS = 4
D_HEAD = 64
ATTN_W = N_HEADS * D_HEAD
KV_W = N_KV_HEADS * D_HEAD
IDX_HEADS = 8
D_IDX = 64
TOPK_MAX = 256
Q_BLOCK = 128
S5_W = D_MODEL // 2
S5_GROUP = 16
S5_GROUPS = S5_W // S5_GROUP
S5_STATE = 64
STEP_MIN = 0.001
STEP_MAX = 0.1
D_FF = 11 * D_MODEL // 4
CONV_W = 3
EPS = 1e-6
IN_SPLITS = (ATTN_W, KV_W, KV_W, IDX_HEADS * D_IDX, D_IDX, IDX_HEADS, S5_W, D_MODEL, D_MODEL)
IN_COLS = sum(IN_SPLITS)

kernel_name = "hybrid_dsa_s5_convffn_step"


def _rmsnorm(x, g):
    xf = x.astype(jnp.float32)
    y = xf * lax.rsqrt(jnp.mean(xf * xf, axis=-1, keepdims=True) + EPS) * g.astype(jnp.float32)
    return y.astype(x.dtype)


def _dsa_block(q, qi, wi, qpos, k, v, ki, kpos):
    b, t = q.shape[0], q.shape[1]
    k_sel = min(TOPK_MAX, k.shape[1] // 4)
    logits = jax.nn.relu(jnp.einsum('bthd,bsd->btsh', qi.astype(jnp.float32), ki.astype(jnp.float32)) * (D_IDX ** -0.5))
    score = jnp.einsum('btsh,bth->bts', logits, wi.astype(jnp.float32) * (IDX_HEADS ** -0.5))
    causal = kpos[None, :] <= qpos[:, None]
    score = jnp.where(causal[None], score, -jnp.inf)
    _, idx = lax.top_k(score, k_sel)
    valid = kpos[idx] <= qpos[None, :, None]
    gather = jax.vmap(lambda rows, ii: rows[ii])
    k_g = gather(k, idx).astype(jnp.float32)
    v_g = gather(v, idx).astype(jnp.float32)
    qg = q.reshape(b, t, N_KV_HEADS, N_HEADS // N_KV_HEADS, D_HEAD).astype(jnp.float32)
    s = jnp.einsum('btngd,btjnd->btngj', qg, k_g) * (D_HEAD ** -0.5)
    s = jnp.where(valid[:, :, None, None, :], s, -jnp.inf)
    p = jax.nn.softmax(s, axis=-1)
    o = jnp.einsum('btngj,btjnd->btngd', p, v_g)
    return o.reshape(b, t, ATTN_W).astype(q.dtype)


def _dsa_attend(q, qi, wi, qpos, k, v, ki, kpos):
    b, t = q.shape[0], q.shape[1]
    if t > Q_BLOCK and t % Q_BLOCK == 0:
        nb = t // Q_BLOCK

        def blocks(a):
            return jnp.moveaxis(a.reshape(b, nb, Q_BLOCK, *a.shape[2:]), 1, 0)

        out = lax.map(lambda args: _dsa_block(*args, k, v, ki, kpos),
                      (blocks(q), blocks(qi), blocks(wi), qpos.reshape(nb, Q_BLOCK)))
        return jnp.moveaxis(out, 0, 1).reshape(b, t, ATTN_W)
    return _dsa_block(q, qi, wi, qpos, k, v, ki, kpos)


def _lin_combine(left, right):
    a1, b1 = left
    a2, b2 = right
    return a2 * a1, a2 * b1 + b2


def _s5(u, x0_re, x0_im, a_re, a_im, log_step, b_re, b_im, c_re, c_im, d_skip):
    b, t = u.shape[0], u.shape[1]
    f32 = jnp.float32
    uf = u.astype(f32).reshape(b, t, S5_GROUPS, S5_GROUP)
    lam = lax.complex(a_re.astype(f32), a_im.astype(f32))
    step = jnp.exp(log_step.astype(f32))[:, None]
    lam_bar = jnp.exp(lam * step)
    b_bar = ((lam_bar - 1.0) / lam)[..., None] * lax.complex(b_re.astype(f32), b_im.astype(f32))
    bu = jnp.einsum('gpc,btgc->btgp', b_bar, uf.astype(jnp.complex64))
    x0 = lax.complex(x0_re.astype(f32), x0_im.astype(f32))
    bu = bu.at[:, 0].add(lam_bar[None] * x0)
    decay = jnp.broadcast_to(lam_bar, bu.shape)
    _, xs = lax.associative_scan(_lin_combine, (decay, bu), axis=1)
    c = lax.complex(c_re.astype(f32), c_im.astype(f32))
    y = jnp.real(jnp.einsum('gcp,btgp->btgc', c, xs)) + d_skip.astype(f32).reshape(S5_GROUPS, S5_GROUP) * uf
    last = xs[:, -1]
    return y.reshape(b, t, S5_W), jnp.real(last), jnp.imag(last)


def _conv_ffn(h, conv_state, w_up, conv_w, conv_b, w_down):
    t = h.shape[1]
    up = h @ w_up
    padded = jnp.concatenate([conv_state.astype(up.dtype), up], axis=1)
    mixed = conv_b
    for j in range(CONV_W):
        mixed = mixed + conv_w[j] * padded[:, j:j + t]
    gate, val = jnp.split(mixed, 2, axis=-1)
    out = (jax.nn.silu(gate) * val) @ w_down
    return out, padded[:, t:]


def _split_points():
    pts, acc = [], 0
    for w in IN_SPLITS[:-1]:
        acc += w
        pts.append(acc)
    return pts


def _layer(x, k_past, v_past, ki_past, s_re, s_im, conv_state, lp):
    (norm_mix, w_in, w_attn_proj, a_re, a_im, log_step, b_re, b_im, c_re, c_im, d_skip,
     w_glu, w_out, norm_ffn, w_up, conv_w, conv_b, w_down) = lp
    b, t = x.shape[0], x.shape[1]
    h = _rmsnorm(x, norm_mix)
    proj = h @ w_in
    q, k, v, qi, ki, wi, u, ga, gb = jnp.split(proj, _split_points(), axis=-1)
    q = q.reshape(b, t, N_HEADS, D_HEAD)
    k = k.reshape(b, t, N_KV_HEADS, D_HEAD)
    v = v.reshape(b, t, N_KV_HEADS, D_HEAD)
    qi = qi.reshape(b, t, IDX_HEADS, D_IDX)
    past = k_past.shape[1]
    k_all = jnp.concatenate([k_past.astype(k.dtype), k], axis=1)
    v_all = jnp.concatenate([v_past.astype(v.dtype), v], axis=1)
    ki_all = jnp.concatenate([ki_past.astype(ki.dtype), ki], axis=1)
    kpos = jnp.arange(past + t, dtype=jnp.int32)
    qpos = past + jnp.arange(t, dtype=jnp.int32)
    attn = _dsa_attend(q, qi, wi, qpos, k_all, v_all, ki_all, kpos)
    y_a = attn @ w_attn_proj
    s5_y, new_re, new_im = _s5(u, s_re, s_im, a_re, a_im, log_step, b_re, b_im, c_re, c_im, d_skip)
    z = jax.nn.gelu(s5_y).astype(x.dtype)
    glu_a, glu_g = jnp.split(z @ w_glu, 2, axis=-1)
    y_b = glu_a * jax.nn.sigmoid(glu_g)
    merged = jax.nn.sigmoid(ga) * y_a + jax.nn.sigmoid(gb) * y_b
    x = x + merged @ w_out
    ffn, new_conv = _conv_ffn(_rmsnorm(x, norm_ffn), conv_state, w_up, conv_w, conv_b, w_down)
    x = x + ffn
    return x, k, v, ki, new_re, new_im, new_conv


def setup_inputs(seed: int = 0) -> dict:
    key = jax.random.key(seed)
    ks = iter(jax.random.split(key, 40))
    f32 = jnp.float32

    def nrm(shape, scale):
        return jax.random.normal(next(ks), shape, f32) * scale

    n_pages = PAST_LEN // PAGE_SIZE
    n_pool = (DEC_BATCH * n_pages * 5) // 4
    page_table = jax.random.permutation(next(ks), n_pool)[:DEC_BATCH * n_pages].reshape(DEC_BATCH, n_pages).astype(jnp.int32)
    a_im_init = jnp.pi * jnp.arange(S5_STATE, dtype=f32)
    inp = {
        "x_prompt": nrm((BATCH, SEQ, D_MODEL), 1.0),
        "x_sample": nrm((DEC_BATCH, DEC_SEQ, D_MODEL), 1.0),
        "cache_k": nrm((DEPTH, n_pool, PAGE_SIZE, N_KV_HEADS, D_HEAD), 1.0),
        "cache_v": nrm((DEPTH, n_pool, PAGE_SIZE, N_KV_HEADS, D_HEAD), 1.0),
        "cache_kidx": nrm((DEPTH, n_pool, PAGE_SIZE, D_IDX), 1.0),
        "state_s5_re": nrm((DEPTH, DEC_BATCH, S5_GROUPS, S5_STATE), 0.3),
        "state_s5_im": nrm((DEPTH, DEC_BATCH, S5_GROUPS, S5_STATE), 0.3),
        "state_ffn_conv": nrm((DEPTH, DEC_BATCH, CONV_W - 1, 2 * D_FF), 1.0),
        "page_table": page_table,
        "norm_mix": 1.0 + nrm((DEPTH, D_MODEL), 0.02),
        "w_in": nrm((DEPTH, D_MODEL, IN_COLS), D_MODEL ** -0.5),
        "w_attn_proj": nrm((DEPTH, ATTN_W, D_MODEL), ATTN_W ** -0.5),
        "s5_a_re": -0.5 + nrm((DEPTH, S5_GROUPS, S5_STATE), 0.01),
        "s5_a_im": a_im_init + nrm((DEPTH, S5_GROUPS, S5_STATE), 0.01),
        "s5_log_step": jax.random.uniform(next(ks), (DEPTH, S5_GROUPS), f32, math.log(STEP_MIN), math.log(STEP_MAX)),
        "s5_b_re": nrm((DEPTH, S5_GROUPS, S5_STATE, S5_GROUP), (2 * S5_GROUP) ** -0.5),
        "s5_b_im": nrm((DEPTH, S5_GROUPS, S5_STATE, S5_GROUP), (2 * S5_GROUP) ** -0.5),
        "s5_c_re": nrm((DEPTH, S5_GROUPS, S5_GROUP, S5_STATE), (2 * S5_STATE) ** -0.5),
        "s5_c_im": nrm((DEPTH, S5_GROUPS, S5_GROUP, S5_STATE), (2 * S5_STATE) ** -0.5),
        "s5_d": nrm((DEPTH, S5_W), 1.0),
        "w_glu": nrm((DEPTH, S5_W, 2 * D_MODEL), S5_W ** -0.5),
        "w_out": nrm((DEPTH, D_MODEL, D_MODEL), D_MODEL ** -0.5),
        "norm_ffn": 1.0 + nrm((DEPTH, D_MODEL), 0.02),
        "w_up": nrm((DEPTH, D_MODEL, 2 * D_FF), D_MODEL ** -0.5),
        "conv_w": nrm((DEPTH, CONV_W, 2 * D_FF), CONV_W ** -0.5),
        "conv_b": nrm((DEPTH, 2 * D_FF), 0.02),
        "w_down": nrm((DEPTH, D_FF, D_MODEL), D_FF ** -0.5),
        "norm_final": 1.0 + nrm((D_MODEL,), 0.02),
    }
    return inp


def reference(x_prompt, x_sample, cache_k, cache_v, cache_kidx, state_s5_re, state_s5_im, state_ffn_conv,
              page_table, norm_mix, w_in, w_attn_proj, s5_a_re, s5_a_im, s5_log_step, s5_b_re, s5_b_im,
              s5_c_re, s5_c_im, s5_d, w_glu, w_out, norm_ffn, w_up, conv_w, conv_b, w_down, norm_final):
    xp, xs = x_prompt, x_sample
    bp, bs = xp.shape[0], xs.shape[0]
    kp_l, vp_l, kip_l, srp_l, sip_l, cp_l = [], [], [], [], [], []
    ks_l, vs_l, kis_l, srs_l, sis_l, cs_l = [], [], [], [], [], []
    for l in range(DEPTH):
        lp = (norm_mix[l], w_in[l], w_attn_proj[l], s5_a_re[l], s5_a_im[l], s5_log_step[l],
              s5_b_re[l], s5_b_im[l], s5_c_re[l], s5_c_im[l], s5_d[l], w_glu[l], w_out[l],
              norm_ffn[l], w_up[l], conv_w[l], conv_b[l], w_down[l])
        zk = jnp.zeros((bp, 0, N_KV_HEADS, D_HEAD), xp.dtype)
        zki = jnp.zeros((bp, 0, D_IDX), xp.dtype)
        zs = jnp.zeros((bp, S5_GROUPS, S5_STATE), jnp.float32)
        zc = jnp.zeros((bp, CONV_W - 1, 2 * D_FF), xp.dtype)
        xp, kp, vp, kip, srp, sip, cp = _layer(xp, zk, zk, zki, zs, zs, zc, lp)
        pk = cache_k[l][page_table].reshape(bs, -1, N_KV_HEADS, D_HEAD)
        pv = cache_v[l][page_table].reshape(bs, -1, N_KV_HEADS, D_HEAD)
        pki = cache_kidx[l][page_table].reshape(bs, -1, D_IDX)
        xs, ksm, vsm, kism, srs, sis, cs = _layer(xs, pk, pv, pki, state_s5_re[l], state_s5_im[l],
                                                 state_ffn_conv[l], lp)
        kp_l.append(kp); vp_l.append(vp); kip_l.append(kip); srp_l.append(srp); sip_l.append(sip); cp_l.append(cp)
        ks_l.append(ksm); vs_l.append(vsm); kis_l.append(kism); srs_l.append(srs); sis_l.append(sis); cs_l.append(cs)
    y_prompt = _rmsnorm(xp, norm_final)
    y_sample = _rmsnorm(xs, norm_final)
    return (y_prompt, y_sample,
            jnp.stack(kp_l), jnp.stack(vp_l), jnp.stack(kip_l), jnp.stack(srp_l), jnp.stack(sip_l), jnp.stack(cp_l),
            jnp.stack(ks_l), jnp.stack(vs_l), jnp.stack(kis_l), jnp.stack(srs_l), jnp.stack(sis_l), jnp.stack(cs_l))
```

```cpp
#include <hip/hip_runtime.h>
#include <cstdio>
#include <cstdint>
namespace pg8 {
#define PG8_LAS __attribute__((address_space(3)))
typedef unsigned short bf16_t;
typedef short bf16x8 __attribute__((ext_vector_type(8)));
typedef float f32x4 __attribute__((ext_vector_type(4)));
typedef unsigned u32x4 __attribute__((ext_vector_type(4)));
typedef unsigned u32x2 __attribute__((ext_vector_type(2)));
constexpr int BM = 256, BK = 64, HALF = 128, HTB = HALF * BK * 2  , STAGE_BYTES = 8 * HTB, NXCD = 8, WGM = 8;
__host__ __device__ __forceinline__ int lds_byte(int r, int c) { const int st = (r >> 4) * 2 + (c >> 5), rr = r & 15, cc = c & 31, ob = rr * 64 + cc * 2; return st * 1024 + (ob ^ (((ob >> 9) & 1) << 5)); }
__host__ __device__ __forceinline__ void stage_rc(int b, int& R, int& C) { const int st = b / 1024, sb = b % 1024, swz = sb ^ (((sb >> 9) & 1) << 5); R = (st >> 1) * 16 + swz / 64; C = (st & 1) * 32 + (swz % 64) / 2; }
__host__ __device__ __forceinline__ int perm32(int rho) { const int n = rho >> 4, i = rho & 15; return 8 * (i >> 2) + 4 * n + (i & 3); }

struct Unit { int pm, pn, kofs; };
struct Gemm { const bf16_t* A; const bf16_t* Bt; int lda, ldb, K; };

struct StaticOrder {
    int nM, nN, nwg, G, c;
    __host__ __device__ void init(int M, int N, int G_, int c_) { nM = M / BM; nN = N / BM; nwg = nM * nN; G = G_; c = c_; }
    __host__ __device__ bool next(int i, Unit& u) const {
        const long L = (long)i * G + c; if (L >= nwg) return false;
        int wgid = (int)L; { const int q = nwg / NXCD, r = nwg % NXCD, xcd = wgid % NXCD, off = wgid / NXCD; wgid = (xcd < r ? xcd * (q + 1) : r * (q + 1) + (xcd - r) * q) + off; }
        const int nig = WGM * nN, gid = wgid / nig, fm = gid * WGM, gsz = (nM - fm) < WGM ? (nM - fm) : WGM;
        u.pm = fm + ((wgid % nig) % gsz); u.pn = (wgid % nig) / gsz; u.kofs = 0; return true;
    }
    __device__ __forceinline__ void a_ready(const Unit&) const {}
    __device__ __forceinline__ void done(const Unit&) const {}
};
__device__ __forceinline__ unsigned cvt_pk_bf16(float lo, float hi) { unsigned r; asm volatile("v_cvt_pk_bf16_f32 %0, %1, %2" : "=v"(r) : "v"(lo), "v"(hi)); return r; }
__device__ __forceinline__ float bf_lo(unsigned w) { return __uint_as_float(w << 16); }
__device__ __forceinline__ float bf_hi(unsigned w) { return __uint_as_float(w & 0xffff0000u); }
__device__ __forceinline__ float sigmoidf_(float v) { return __builtin_amdgcn_rcpf(1.0f + __builtin_amdgcn_exp2f(-1.4426950408889634f * v)); }
template <class Epi, class Sched, bool ALIGN_EPI = false, bool SP2 = false>
__device__ __forceinline__ void gemm_phase(PG8_LAS unsigned char* lds, const Gemm g, const Sched& S, const Epi& E) {
    const int tid = threadIdx.x, wid = __builtin_amdgcn_readfirstlane(tid >> 6), lane = tid & 63, wr = wid >> 2, wc = wid & 3, fr = lane & 15, fq = lane >> 4;
    const int nt = g.K / BK, lda = g.lda, ldb = g.ldb;
    unsigned voffA[2], voffB[2];
#pragma unroll
    for (int i = 0; i < 2; ++i) { int R, C; stage_rc(tid * 16 + i * 8192, R, C); const int Rb = Epi::PERM ? ((R & ~31) + perm32(R & 31)) : R;
        voffA[i] = (unsigned)(R * lda + C) * 2u; voffB[i] = (unsigned)(Rb * ldb + C) * 2u; }
    const size_t kstep = (size_t)(BK * 2);
    const size_t hstepA = (size_t)HALF * lda * 2, hstepB = (size_t)HALF * ldb * 2;
    const size_t tstepA = 2 * hstepA, tstepB = 2 * hstepB;
    const unsigned ldsw = (unsigned)wid * 1024u;
    const int aoff = lds_byte(wr * 64 + fr, fq * 8), boff = lds_byte(wc * 32 + fr, fq * 8);
#define PG8_SA(b, h) (((b) * 2 + (h)) * HTB)
#define PG8_SB(b, h) ((4 + (b) * 2 + (h)) * HTB)
#define PG8_STAGE(bufoff, gbase, voff) do { _Pragma("unroll") for (int _i = 0; _i < 2; ++_i) \
        __builtin_amdgcn_global_load_lds((const unsigned*)((const char*)(gbase) + (voff)[_i]), (PG8_LAS unsigned*)(lds + (bufoff) + ldsw + _i * 8192), 16, 0, 0); } while (0)
#define PG8_LDA(dst, b, h) do { _Pragma("unroll") for (int m = 0; m < 4; ++m) _Pragma("unroll") for (int k = 0; k < 2; ++k) dst[m][k] = *(const PG8_LAS bf16x8*)(lds + PG8_SA(b, h) + aoff + m * 2048 + k * 1024); } while (0)
#define PG8_LDB(dst, b, h) do { _Pragma("unroll") for (int n = 0; n < 2; ++n) _Pragma("unroll") for (int k = 0; k < 2; ++k) dst[n][k] = *(const PG8_LAS bf16x8*)(lds + PG8_SB(b, h) + boff + n * 2048 + k * 1024); } while (0)
#define PG8_MMA(ai, bj, At, Bt) do { __builtin_amdgcn_s_setprio(1); _Pragma("unroll") for (int m = 0; m < 4; ++m) _Pragma("unroll") for (int n = 0; n < 2; ++n) _Pragma("unroll") for (int k = 0; k < 2; ++k) \
        acc[ai][bj][m][n] = __builtin_amdgcn_mfma_f32_16x16x32_bf16(Bt[n][k], At[m][k], acc[ai][bj][m][n], 0, 0, 0); __builtin_amdgcn_s_setprio(0); } while (0)
#define PG8_WAIT_V(n) asm volatile("s_waitcnt vmcnt(" #n ")" ::: "memory")
#define PG8_WAIT_L(n) asm volatile("s_waitcnt lgkmcnt(" #n ")" ::: "memory")
#define PG8_BAR __builtin_amdgcn_s_barrier()
#define PG8_SCHED __builtin_amdgcn_sched_barrier(0)
    Unit cur, nxt; int ui = 0;
    if (!S.next(0, cur)) return;
    f32x4 acc[2][2][4][2];
#pragma unroll
    for (int a = 0; a < 2; ++a)
#pragma unroll
        for (int b = 0; b < 2; ++b)
#pragma unroll
            for (int m = 0; m < 4; ++m)
#pragma unroll
                for (int n = 0; n < 2; ++n) acc[a][b][m][n] = (f32x4){0.f, 0.f, 0.f, 0.f};
    bf16x8 At[4][2], B0[2][2], B1[2][2];
    const char* cA = (const char*)g.A + (size_t)cur.pm * tstepA + (size_t)cur.kofs * 2; const char* cB = (const char*)g.Bt + (size_t)cur.pn * tstepB + (size_t)cur.kofs * 2;
    S.a_ready(cur);
    if constexpr (SP2) {
        PG8_STAGE(PG8_SB(0, 0), cB, voffB); PG8_STAGE(PG8_SB(0, 1), cB + hstepB, voffB); PG8_STAGE(PG8_SA(0, 0), cA, voffA); PG8_STAGE(PG8_SA(0, 1), cA + hstepA, voffA);
        if (wr == 1) PG8_BAR;
        PG8_WAIT_V(2); PG8_BAR;
        PG8_STAGE(PG8_SB(1, 0), cB + kstep, voffB); PG8_STAGE(PG8_SA(1, 0), cA + kstep, voffA); PG8_STAGE(PG8_SB(1, 1), cB + hstepB + kstep, voffB);
        PG8_WAIT_V(6); PG8_BAR;
    } else {
        PG8_STAGE(PG8_SB(0, 0), cB, voffB); PG8_STAGE(PG8_SA(0, 0), cA, voffA); PG8_STAGE(PG8_SB(0, 1), cB + hstepB, voffB); PG8_STAGE(PG8_SA(0, 1), cA + hstepA, voffA);
        if (wr == 1) PG8_BAR;
        PG8_WAIT_V(4); PG8_BAR;
        PG8_STAGE(PG8_SB(1, 0), cB + kstep, voffB); PG8_STAGE(PG8_SA(1, 0), cA + kstep, voffA); PG8_STAGE(PG8_SB(1, 1), cB + hstepB + kstep, voffB);
        PG8_WAIT_V(6); PG8_BAR;
    }
    for (;;) {
        const bool has_next = S.next(ui + 1, nxt);
        const char* nA = has_next ? (const char*)g.A + (size_t)nxt.pm * tstepA + (size_t)nxt.kofs * 2 : cA; const char* nB = has_next ? (const char*)g.Bt + (size_t)nxt.pn * tstepB + (size_t)nxt.kofs * 2 : cB;
        for (int t = 0; t < nt; t += 2) {
            const bool last = (t == nt - 2);
            const char* a1 = cA + (size_t)(t + 1) * kstep;
            const char* a2 = last ? nA : cA + (size_t)(t + 2) * kstep; const char* b2 = last ? nB : cB + (size_t)(t + 2) * kstep;
            const char* a3 = a2 + kstep; const char* b3 = b2 + kstep;
            if (last && has_next) S.a_ready(nxt);
            if constexpr (SP2) {
            PG8_LDB(B0, 0, 0); PG8_LDB(B1, 0, 1); PG8_SCHED; PG8_LDA(At, 0, 0); PG8_STAGE(PG8_SA(1, 1), a1 + hstepA, voffA);
            PG8_WAIT_V(8); PG8_WAIT_L(0); PG8_BAR; PG8_MMA(0, 0, At, B0); PG8_MMA(0, 1, At, B1); PG8_BAR; PG8_SCHED;
            PG8_LDA(At, 0, 1); PG8_STAGE(PG8_SB(0, 0), b2, voffB); PG8_STAGE(PG8_SB(0, 1), b2 + hstepB, voffB); PG8_STAGE(PG8_SA(0, 0), a2, voffA);
            PG8_WAIT_V(8); PG8_WAIT_L(0); PG8_BAR; PG8_MMA(1, 0, At, B0); PG8_MMA(1, 1, At, B1); PG8_BAR; PG8_SCHED;
            PG8_LDB(B0, 1, 0); PG8_LDB(B1, 1, 1); PG8_SCHED; PG8_LDA(At, 1, 0); PG8_STAGE(PG8_SA(0, 1), a2 + hstepA, voffA);
            PG8_WAIT_V(8); PG8_WAIT_L(0); PG8_BAR; PG8_MMA(0, 0, At, B0); PG8_MMA(0, 1, At, B1); PG8_BAR; PG8_SCHED;
            PG8_LDA(At, 1, 1); PG8_STAGE(PG8_SB(1, 0), b3, voffB); PG8_STAGE(PG8_SB(1, 1), b3 + hstepB, voffB); PG8_STAGE(PG8_SA(1, 0), a3, voffA);
            PG8_WAIT_V(8); PG8_WAIT_L(0); PG8_BAR; PG8_MMA(1, 0, At, B0); PG8_MMA(1, 1, At, B1); PG8_BAR; PG8_SCHED;
            } else {
            PG8_LDB(B0, 0, 0); PG8_SCHED; PG8_LDA(At, 0, 0); PG8_STAGE(PG8_SA(1, 1), a1 + hstepA, voffA);
            PG8_WAIT_L(8); PG8_BAR; PG8_WAIT_L(0); PG8_MMA(0, 0, At, B0); PG8_BAR; PG8_SCHED;
            PG8_LDB(B1, 0, 1); PG8_STAGE(PG8_SB(0, 0), b2, voffB);
            PG8_BAR; PG8_WAIT_L(0); PG8_MMA(0, 1, At, B1); PG8_BAR;
            PG8_LDA(At, 0, 1); PG8_STAGE(PG8_SA(0, 0), a2, voffA);
            PG8_BAR; PG8_WAIT_L(0); PG8_MMA(1, 0, At, B0); PG8_BAR; PG8_SCHED;
            PG8_STAGE(PG8_SB(0, 1), b2 + hstepB, voffB);
            PG8_WAIT_V(6); PG8_BAR; PG8_MMA(1, 1, At, B1); PG8_BAR;
            PG8_LDB(B0, 1, 0); PG8_SCHED; PG8_LDA(At, 1, 0); PG8_STAGE(PG8_SA(0, 1), a2 + hstepA, voffA);
            PG8_WAIT_L(8); PG8_BAR; PG8_WAIT_L(0); PG8_MMA(0, 0, At, B0); PG8_BAR; PG8_SCHED;
            PG8_LDB(B1, 1, 1); PG8_STAGE(PG8_SB(1, 0), b3, voffB);
            PG8_BAR; PG8_WAIT_L(0); PG8_MMA(0, 1, At, B1); PG8_BAR;
            PG8_LDA(At, 1, 1); PG8_STAGE(PG8_SA(1, 0), a3, voffA);
            PG8_BAR; PG8_WAIT_L(0); PG8_MMA(1, 0, At, B0); PG8_BAR; PG8_SCHED;
            PG8_STAGE(PG8_SB(1, 1), b3 + hstepB, voffB);
            PG8_WAIT_V(6); PG8_BAR; PG8_MMA(1, 1, At, B1); PG8_BAR;
            }
        }
        if constexpr (ALIGN_EPI) { if (wr == 0) PG8_BAR; }
        if constexpr (!Epi::AFTER_DRAIN) { E(acc, cur, wr, wc, fr, fq); S.done(cur); }
        if (!has_next) break;
#pragma unroll
        for (int a = 0; a < 2; ++a)
#pragma unroll
            for (int b = 0; b < 2; ++b)
#pragma unroll
                for (int m = 0; m < 4; ++m)
#pragma unroll
                    for (int n = 0; n < 2; ++n) acc[a][b][m][n] = (f32x4){0.f, 0.f, 0.f, 0.f};
        cur = nxt; cA = nA; cB = nB; ++ui;
        if constexpr (ALIGN_EPI) { if (wr == 1) PG8_BAR; }
    }
    PG8_WAIT_V(0);
    if constexpr (!ALIGN_EPI) { if (wr == 0) PG8_BAR; }
    PG8_BAR;
    if constexpr (Epi::AFTER_DRAIN) { E.fused(acc, cur, wr, wc, fr, fq, lds, wid, lane); S.done(cur); }
#undef PG8_SA
#undef PG8_SB
#undef PG8_STAGE
#undef PG8_LDA
#undef PG8_LDB
#undef PG8_MMA
#undef PG8_WAIT_V
#undef PG8_WAIT_L
#undef PG8_BAR
#undef PG8_SCHED
}
}
#include <hip/hip_bf16.h>
#include <cmath>
namespace attn_body {
using bf16=__hip_bfloat16;
using bf16x8=__attribute__((ext_vector_type(8)))short;
using s16x4=__attribute__((ext_vector_type(4)))short;
using f32x16=__attribute__((ext_vector_type(16)))float;
using u32x4=__attribute__((ext_vector_type(4)))unsigned;
constexpr int BATCH=4,NHEAD=16,SEQ=2048,D=64,DM=NHEAD*D,KP=256;
constexpr int NW=8,QBLK=32,QB=QBLK*NW,KVBLK=64,NQB=SEQ/QB;
constexpr int ATTN_PITCH=DM, ATTN_UNIT_ROWS=QB;
__device__ __forceinline__ int crow(int r,int hi){return (r&3)+8*(r>>2)+4*hi;}
#define SBAR() __builtin_amdgcn_sched_barrier(0)
__device__ __forceinline__ void amask(f32x16&p0,f32x16&p1,unsigned mw){
  #pragma unroll
  for(int r=0;r<16;++r){
    const unsigned m0=(unsigned)__builtin_amdgcn_sbfe((int)mw,r,1), m1=(unsigned)__builtin_amdgcn_sbfe((int)mw,16+r,1);
    p0[r]=__uint_as_float((__float_as_uint(p0[r])&m0)|(0xff800000u&~m0));
    p1[r]=__uint_as_float((__float_as_uint(p1[r])&m1)|(0xff800000u&~m1));}
}
constexpr int NSLOT=3, SLOTB=8192;
constexpr int LDS_K=0, LDS_V=NSLOT*SLOTB, LDS_WS=2*NSLOT*SLOTB, LDS_OST=LDS_WS+NW*64*4, LDS_BYTES=LDS_OST+NW*4096;
constexpr float C2=0.125f*1.4426950408889634f;
__device__ __forceinline__ void glds16(const void*gsrc,unsigned lds_dst){unsigned keep;
  asm volatile("s_mov_b32 %0, m0\n\ts_mov_b32 m0, %2\n\ts_nop 0\n\tglobal_load_lds_dwordx4 %1, off\n\ts_mov_b32 m0, %0":"=&s"(keep):"v"(gsrc),"s"(lds_dst):"memory");}
__device__ __forceinline__ float max3f(float a,float b,float c){float r;asm("v_max3_f32 %0, %1, %2, %3":"=v"(r):"v"(a),"v"(b),"v"(c));return r;}
__device__ __forceinline__ float max2f(float a,float b){float r;asm("v_max_f32_e32 %0, %1, %2":"=v"(r):"v"(a),"v"(b));return r;}
__device__ __forceinline__ float fadd_s(float a,float b){float r;asm("v_add_f32_e32 %0, %1, %2":"=v"(r):"v"(a),"v"(b));return r;}
__device__ __forceinline__ float fsub_s(float a,float b){float r;asm("v_sub_f32_e32 %0, %1, %2":"=v"(r):"v"(a),"v"(b));return r;}
typedef float f32x2_t __attribute__((ext_vector_type(2))); typedef __bf16 bf16x2_t __attribute__((ext_vector_type(2)));
__device__ __forceinline__ unsigned cvtpk_s(float lo,float hi){f32x2_t v={lo,hi};bf16x2_t b=__builtin_convertvector(v,bf16x2_t);return __builtin_bit_cast(unsigned,b);}
#define WAIT_BAR(N) asm volatile("s_waitcnt vmcnt(" #N ") lgkmcnt(0)\n\ts_barrier":::"memory")

__device__ __forceinline__ void qkt(f32x16&p0,f32x16&p1,const char*Kslot,const bf16x8*qr,const f32x16&negm,int r32,int hi){
  const char*kb=Kslot+hi*1024+r32*16;
  #pragma unroll
  for(int d0=0;d0<4;++d0){
    const bf16x8 b0=*reinterpret_cast<const bf16x8*>(kb+d0*2048);
    const bf16x8 b1=*reinterpret_cast<const bf16x8*>(kb+d0*2048+512);
    if(d0==0){p0=__builtin_amdgcn_mfma_f32_32x32x16_bf16(b0,qr[0],negm,0,0,0);p1=__builtin_amdgcn_mfma_f32_32x32x16_bf16(b1,qr[0],negm,0,0,0);}
    else{p0=__builtin_amdgcn_mfma_f32_32x32x16_bf16(b0,qr[d0],p0,0,0,0);p1=__builtin_amdgcn_mfma_f32_32x32x16_bf16(b1,qr[d0],p1,0,0,0);}}
}
typedef __attribute__((address_space(3))) const char* lds_cptr;
typedef short v4i16_t __attribute__((ext_vector_type(4)));
__device__ __forceinline__ void kload8(bf16x8*kf,lds_cptr kp){
  kf[0]=*(const __attribute__((address_space(3))) bf16x8*)(kp);      kf[1]=*(const __attribute__((address_space(3))) bf16x8*)(kp+512);
  kf[2]=*(const __attribute__((address_space(3))) bf16x8*)(kp+2048); kf[3]=*(const __attribute__((address_space(3))) bf16x8*)(kp+2560);
  kf[4]=*(const __attribute__((address_space(3))) bf16x8*)(kp+4096); kf[5]=*(const __attribute__((address_space(3))) bf16x8*)(kp+4608);
  kf[6]=*(const __attribute__((address_space(3))) bf16x8*)(kp+6144); kf[7]=*(const __attribute__((address_space(3))) bf16x8*)(kp+6656);
}
__device__ __forceinline__ void kload2(bf16x8*kf,lds_cptr kp,int j){ kf[2*j]=*(const __attribute__((address_space(3))) bf16x8*)(kp+j*2048); kf[2*j+1]=*(const __attribute__((address_space(3))) bf16x8*)(kp+j*2048+512); }
__device__ __forceinline__ s16x4 vtr(lds_cptr p){ return __builtin_bit_cast(s16x4,__builtin_amdgcn_ds_read_tr16_b64_v4i16((__attribute__((address_space(3))) v4i16_t*)p)); }
__device__ __forceinline__ float rowmax(const f32x16&p0,const f32x16&p1){
  float a=max3f(p0[0],p0[1],p1[0]),b=max3f(p0[2],p0[3],p1[1]);a=max3f(a,p1[2],p1[3]);
  #pragma unroll
  for(int r=4;r<16;r+=4){a=max3f(a,p0[r],p0[r+1]);b=max3f(b,p0[r+2],p0[r+3]);a=max3f(a,p1[r],p1[r+1]);b=max3f(b,p1[r+2],p1[r+3]);}
  const float m=max2f(a,b);
  auto rr=__builtin_amdgcn_permlane32_swap(__float_as_uint(m),__float_as_uint(m),false,false);
  return max2f(__uint_as_float(rr[0]),__uint_as_float(rr[1]));
}
__device__ __forceinline__ void pv(f32x16*o,int vb,bf16x8 pa0,bf16x8 pa1,bf16x8 pa2,bf16x8 pa3){
  #pragma unroll
  for(int d0=0;d0<2;++d0){s16x4 lo[4],hi[4];
    #pragma unroll
    for(int ks=0;ks<4;++ks){
      asm volatile("ds_read_b64_tr_b16 %0,%1 offset:%c2":"=&v"(lo[ks]):"v"(vb),"i"(d0*4096+ks*1024):"memory");
      asm volatile("ds_read_b64_tr_b16 %0,%1 offset:%c2":"=&v"(hi[ks]):"v"(vb),"i"(d0*4096+ks*1024+512):"memory");}
    asm volatile("s_waitcnt lgkmcnt(0)":::"memory");SBAR();
    #define PK(k) (bf16x8){lo[k][0],lo[k][1],lo[k][2],lo[k][3],hi[k][0],hi[k][1],hi[k][2],hi[k][3]}
    o[d0]=__builtin_amdgcn_mfma_f32_32x32x16_bf16(pa0,PK(0),o[d0],0,0,0);
    o[d0]=__builtin_amdgcn_mfma_f32_32x32x16_bf16(pa1,PK(1),o[d0],0,0,0);
    o[d0]=__builtin_amdgcn_mfma_f32_32x32x16_bf16(pa2,PK(2),o[d0],0,0,0);
    o[d0]=__builtin_amdgcn_mfma_f32_32x32x16_bf16(pa3,PK(3),o[d0],0,0,0);
    #undef PK
  }
}

#ifndef ATTN_STORE16
#define ATTN_STORE16(p,v) (*(u32x4*)(p)=(v))
#endif
template<int THRL> __device__ __forceinline__ void attn_unit(int b,int h,int qb,const bf16*Q,const bf16*__restrict__ K,const bf16*__restrict__ V,bf16*O,const unsigned*__restrict__ MG,char*shm,char*mshm){
  const int tid=threadIdx.x,lane=tid&63,r32=lane&31,hi=lane>>5; const int wid=__builtin_amdgcn_readfirstlane(tid>>6);
  const long rowbase=(long)b*SEQ; const int q0=qb*QB;
  const bf16*Qw=Q+(rowbase+q0+wid*QBLK)*DM+h*D;
  const bf16*Kh=K+rowbase*KP+(h>>2)*D,*Vh=V+rowbase*KP+(h>>2)*D;
  const unsigned lds0=(unsigned)(uintptr_t)shm;
  float*wsf=(float*)(shm+LDS_WS)+wid*64;
  const bf16*ksrc=Kh+(long)lane*KP+wid*8;
  const bf16*vsrc=Vh+(long)(16*(wid&3)+(lane>>2))*KP+(wid>>2)*32+(lane&3)*8;
  const unsigned kdst=lds0+LDS_K+wid*1024, vdst=lds0+LDS_V+wid*1024;
  #define DMA_K(t,slot) glds16(ksrc+(long)(t)*KVBLK*KP,(unsigned)__builtin_amdgcn_readfirstlane(kdst+(slot)))
  #define DMA_V(t,slot) glds16(vsrc+(long)(t)*KVBLK*KP,(unsigned)__builtin_amdgcn_readfirstlane(vdst+(slot)))
  const int vb0=(int)(lds0+LDS_V)+((lane>>4)&1)*32+(lane&3)*8+(4*hi+((lane&15)>>2))*64;
  const char*Kbase=shm+LDS_K; bf16x8 kf[8];
  const lds_cptr shm3=(lds_cptr)shm; const lds_cptr kp0=shm3+LDS_K+hi*1024+r32*16; const lds_cptr vp0=shm3+LDS_V+((lane>>4)&1)*32+(lane&3)*8+(4*hi+((lane&15)>>2))*64;
  const int NT=(q0+QB)/KVBLK;
  unsigned*mwv=(unsigned*)(mshm+wid*8192);
  { const u32x4*msrc=(const u32x4*)(MG+(size_t)((b*(SEQ/QBLK))+qb*NW+wid)*2048);
    #pragma unroll
    for(int i=0;i<8;++i){ if(i<=qb){ const u32x4 v_=msrc[i*64+lane]; *(u32x4*)(mwv+(i*64+lane)*4)=v_; } } }
  const unsigned*mldsw=mwv+hi*32+r32;
  asm volatile("s_waitcnt vmcnt(0) lgkmcnt(0)":::"memory");
  DMA_K(0,0);DMA_V(0,0);DMA_K(1,SLOTB);
  bf16x8 qr[4];
  #pragma unroll
  for(int d0=0;d0<4;++d0)qr[d0]=*reinterpret_cast<const bf16x8*>(&Qw[(long)r32*DM+d0*16+hi*8]);
  float mhat=0.f,l_reg=0.f;f32x16 o[2];o[0]=f32x16{};o[1]=f32x16{};const f32x16 negm=f32x16{};
  const int qrel=wid*QBLK+r32;
  #define CMASK(P0,P1,t) do{ _Pragma("unroll") for(int r_=0;r_<16;++r_){P0[r_]-=mhat;P1[r_]-=mhat;} amask(P0,P1,mldsw[(t)*64]); }while(0)
  bool resc=false;
  #define START(P0,P1) do{ const float rm=rowmax(P0,P1); resc=false; \
    { const float dl=(rm<-3.0e38f)?0.f:rm; mhat=fadd_s(mhat,dl); \
      _Pragma("unroll") for(int r=0;r<16;++r){P0[r]=fsub_s(P0[r],dl);P1[r]=fsub_s(P1[r],dl);} \
    } \
    _Pragma("unroll") for(int r=0;r<16;++r)P0[r]=__builtin_amdgcn_exp2f(P0[r]); }while(0)
  #define RESC() do{ if(resc){ asm volatile("s_waitcnt lgkmcnt(0)":::"memory"); \
      _Pragma("unroll") for(int d_=0;d_<2;++d_) _Pragma("unroll") for(int r=0;r<16;++r)o[d_][r]*=wsf[crow(r,hi)]; } }while(0)
  f32x16 pA0,pA1,pB0,pB1;
  int sl_prev=0,sl_cur=0,sl_next=SLOTB;
  #define ROT() do{sl_prev=sl_cur;sl_cur=sl_next;sl_next=(sl_next==(NSLOT-1)*SLOTB)?0:sl_next+SLOTB;}while(0)
  DMA_K(2,2*SLOTB);
  WAIT_BAR(3);
  qkt(pA0,pA1,Kbase,qr,negm,r32,hi);asm volatile("s_nop 15\n\ts_nop 7":"+v"(pA0),"+v"(pA1));CMASK(pA0,pA1,0);
  START(pA0,pA1);
  _Pragma("unroll") for(int r=0;r<16;++r)pA1[r]=__builtin_amdgcn_exp2f(pA1[r]);
  WAIT_BAR(0);
  DMA_K(3,0);DMA_V(1,SLOTB);
  ROT();
  kload8(kf,kp0+sl_cur);
  WAIT_BAR(2);
  s16x4 vlo[8],vhi[8]; u32x4 pw0,pw1,pw2,pw3;
  #define PKW(P,B) cvtpk_s(P[B],P[B+1])
  #define PAF(k) __builtin_bit_cast(bf16x8,pw##k)
  #define VFR(i) (bf16x8){vlo[i][0],vlo[i][1],vlo[i][2],vlo[i][3],vhi[i][0],vhi[i][1],vhi[i][2],vhi[i][3]}
  #define PIN(x) asm volatile("":"+v"(x))
  #define MX3(a,b,c) __builtin_fmaxf(__builtin_fmaxf((a),(b)),(c))
  #define GAPA(MF,A0,A1,A2,A3,W0,W1,PW) do{ MF; sacc+=A0; sacc+=A1; sacc+=A2; sacc+=A3; PIN(sacc); W0; W1; PIN(PW); SBAR(); }while(0)
  #define EX(v) __builtin_amdgcn_exp2f(v)
  #define GAPB(MF,X,B) do{ MF; X[B]=EX(X[B]); X[B+1]=EX(X[B+1]); X[B+2]=EX(X[B+2]); X[B+3]=EX(X[B+3]); PIN(X); SBAR(); }while(0)
  #define VRD(i) do{ vlo[i]=vtr(vp_+(((i)>>2)*4096+((i)&3)*1024)); vhi[i]=vtr(vp_+(((i)>>2)*4096+((i)&3)*1024+512)); }while(0)
  #define KRD(G,j) do{ if(G){ kload2(kf,kp0+sl_next,j); SBAR(); } }while(0)
  #define STEP(C0,C1,P0,P1,t,GK,GV,GL) do{ SBAR(); \
    const lds_cptr vp_=vp0+sl_prev; \
    VRD(0); SBAR(); float sacc=(P0[0]+P0[1]); \
    GAPA(C0=__builtin_amdgcn_mfma_f32_32x32x16_bf16(kf[0],qr[0],f32x16{},0,0,0), P0[2],P0[3],P0[4],P0[5],     pw0[0]=PKW(P0,0), pw0[1]=PKW(P0,2), pw0); \
    VRD(4); SBAR(); GAPA(C1=__builtin_amdgcn_mfma_f32_32x32x16_bf16(kf[1],qr[0],f32x16{},0,0,0), P0[6],P0[7],P0[8],P0[9],     pw0[2]=PKW(P0,4), pw0[3]=PKW(P0,6), pw0); \
    VRD(1); SBAR(); GAPA(C0=__builtin_amdgcn_mfma_f32_32x32x16_bf16(kf[2],qr[1],C0,0,0,0),   P0[10],P0[11],P0[12],P0[13], pw1[0]=PKW(P0,8), pw1[1]=PKW(P0,10), pw1); \
    VRD(5); SBAR(); GAPA(C1=__builtin_amdgcn_mfma_f32_32x32x16_bf16(kf[3],qr[1],C1,0,0,0),   P0[14],P0[15],P1[0],P1[1],   pw1[2]=PKW(P0,12),pw1[3]=PKW(P0,14), pw1); \
    VRD(2); SBAR(); GAPA(C0=__builtin_amdgcn_mfma_f32_32x32x16_bf16(kf[4],qr[2],C0,0,0,0),   P1[2],P1[3],P1[4],P1[5],     pw2[0]=PKW(P1,0), pw2[1]=PKW(P1,2), pw2); \
    VRD(6); SBAR(); GAPA(C1=__builtin_amdgcn_mfma_f32_32x32x16_bf16(kf[5],qr[2],C1,0,0,0),   P1[6],P1[7],P1[8],P1[9],     pw2[2]=PKW(P1,4), pw2[3]=PKW(P1,6), pw2); \
    VRD(3); SBAR(); GAPA(C0=__builtin_amdgcn_mfma_f32_32x32x16_bf16(kf[6],qr[3],C0,0,0,0),   P1[10],P1[11],P1[12],P1[13], pw3[0]=PKW(P1,8), pw3[1]=PKW(P1,10), pw3); \
    VRD(7); SBAR(); GAPA(C1=__builtin_amdgcn_mfma_f32_32x32x16_bf16(kf[7],qr[3],C1,0,0,0),   P1[14],P1[15],0.f,0.f,       pw3[2]=PKW(P1,12),pw3[3]=PKW(P1,14), pw3); \
    l_reg+=sacc; \
    if(GK){DMA_K((t)+3,sl_cur);} if(GV){DMA_V((t)+1,sl_next);} \
    CMASK(C0,C1,t); \
    { float a=MX3(C0[0],C0[1],C1[0]),b=MX3(C0[2],C0[3],C1[1]); a=MX3(a,C1[2],C1[3]); \
      _Pragma("unroll") for(int r=4;r<16;r+=4){a=MX3(a,C0[r],C0[r+1]);b=MX3(b,C0[r+2],C0[r+3]);a=MX3(a,C1[r],C1[r+1]);b=MX3(b,C1[r+2],C1[r+3]);} \
      float rm=__builtin_fmaxf(a,b); { auto rr=__builtin_amdgcn_permlane32_swap(__float_as_uint(rm),__float_as_uint(rm),false,false); rm=__builtin_fmaxf(__uint_as_float(rr[0]),__uint_as_float(rr[1])); } \
      resc=false; \
      if(__builtin_expect(__any(rm>(float)THRL),0)){ const float dl=__builtin_fmaxf(rm,0.f); mhat+=dl; \
        _Pragma("unroll") for(int r=0;r<16;++r){C0[r]-=dl;C1[r]-=dl;} \
        const float f=__builtin_amdgcn_exp2f(-dl); l_reg*=f; if(hi==0)wsf[r32]=f; resc=true; } } \
    SBAR(); \
    GAPB(o[0]=__builtin_amdgcn_mfma_f32_32x32x16_bf16(PAF(0),VFR(0),o[0],0,0,0), C0,0); \
    GAPB(o[1]=__builtin_amdgcn_mfma_f32_32x32x16_bf16(PAF(0),VFR(4),o[1],0,0,0), C0,4); \
    KRD(GL,0); GAPB(o[0]=__builtin_amdgcn_mfma_f32_32x32x16_bf16(PAF(1),VFR(1),o[0],0,0,0), C0,8); \
    KRD(GL,1); GAPB(o[1]=__builtin_amdgcn_mfma_f32_32x32x16_bf16(PAF(1),VFR(5),o[1],0,0,0), C0,12); \
    KRD(GL,2); GAPB(o[0]=__builtin_amdgcn_mfma_f32_32x32x16_bf16(PAF(2),VFR(2),o[0],0,0,0), C1,0); \
    KRD(GL,3); GAPB(o[1]=__builtin_amdgcn_mfma_f32_32x32x16_bf16(PAF(2),VFR(6),o[1],0,0,0), C1,4); \
    GAPB(o[0]=__builtin_amdgcn_mfma_f32_32x32x16_bf16(PAF(3),VFR(3),o[0],0,0,0), C1,8); \
    GAPB(o[1]=__builtin_amdgcn_mfma_f32_32x32x16_bf16(PAF(3),VFR(7),o[1],0,0,0), C1,12); \
    }while(0)
  int t=1;
  for(;t+5<NT;t+=2){
    STEP(pB0,pB1,pA0,pA1,t,true,true,true);     WAIT_BAR(2); RESC(); ROT();
    STEP(pA0,pA1,pB0,pB1,t+1,true,true,true);   WAIT_BAR(2); RESC(); ROT();
  }
  #undef CMASK
  #define CMASK(P0,P1,t) do{ _Pragma("unroll") for(int r_=0;r_<16;++r_){P0[r_]-=mhat;P1[r_]-=mhat;} amask(P0,P1,mldsw[(t)*64]); }while(0)
  #define ENDW(tt) do{ if((tt)+3<NT){WAIT_BAR(2);} else if((tt)+2<NT){WAIT_BAR(1);} else {WAIT_BAR(0);} }while(0)
  for(;t+1<NT;t+=2){
    STEP(pB0,pB1,pA0,pA1,t,(t+3<NT),(t+1<NT),(t+1<NT));       ENDW(t);   RESC(); ROT();
    STEP(pA0,pA1,pB0,pB1,t+1,(t+4<NT),(t+2<NT),(t+2<NT));     ENDW(t+1); RESC(); ROT();
  }
  STEP(pB0,pB1,pA0,pA1,NT-1,false,false,false); RESC();
  { float sacc=pB0[0]+pB0[1]; _Pragma("unroll") for(int r=2;r<16;++r)sacc+=pB0[r]; _Pragma("unroll") for(int r=0;r<16;++r)sacc+=pB1[r]; l_reg+=sacc;
    pw0=(u32x4){PKW(pB0,0),PKW(pB0,2),PKW(pB0,4),PKW(pB0,6)};pw1=(u32x4){PKW(pB0,8),PKW(pB0,10),PKW(pB0,12),PKW(pB0,14)};pw2=(u32x4){PKW(pB1,0),PKW(pB1,2),PKW(pB1,4),PKW(pB1,6)};pw3=(u32x4){PKW(pB1,8),PKW(pB1,10),PKW(pB1,12),PKW(pB1,14)};
    SBAR(); pv(o,vb0+sl_cur,PAF(0),PAF(1),PAF(2),PAF(3)); }
  #undef PKW
  #undef PAF
  #undef VFR
  #undef PIN
  #undef MX3
  #undef GAPA
  #undef GAPB
  #undef EX
  #undef VRD
  #undef KRD
  #undef STEP
  #undef ENDW
  {auto rr=__builtin_amdgcn_permlane32_swap(__float_as_uint(l_reg),__float_as_uint(l_reg),false,false);l_reg=__uint_as_float(rr[0])+__uint_as_float(rr[1]);}
  if(hi==0)wsf[32+r32]=l_reg;asm volatile("s_waitcnt lgkmcnt(0)":::"memory");
  float rli[16];
  #pragma unroll
  for(int r=0;r<16;++r)rli[r]=__builtin_amdgcn_rcpf(wsf[32+crow(r,hi)]);
  bf16*Ow=O+(rowbase+q0+wid*QBLK)*DM+h*D;
  { bf16*stg=(bf16*)(shm+LDS_OST)+wid*2048;
    #pragma unroll
    for(int r=0;r<16;++r){const int orow=crow(r,hi);
      #pragma unroll
      for(int d0=0;d0<2;++d0)stg[orow*64+d0*32+r32]=__float2bfloat16(o[d0][r]*rli[r]);}
    asm volatile("s_waitcnt lgkmcnt(0)":::"memory");
    #pragma unroll
    for(int i=0;i<4;++i){const int row=i*8+(lane>>3),ch=lane&7; const u32x4 v=*(const u32x4*)(stg+row*64+ch*8); ATTN_STORE16(Ow+(long)row*DM+ch*8,v);} }
  asm volatile("s_waitcnt lgkmcnt(0)\n\ts_barrier":::"memory");
  #undef DMA_K
  #undef DMA_V
  #undef CMASK
  #undef START
  #undef RESC
  #undef ROT
}
constexpr int ATTN_LDS_BYTES=LDS_BYTES;
struct AttnTensors { const bf16* Q; const bf16* K; const bf16* V; bf16* O; };
struct AttnUnit { int bh; int qb; };
struct StaticOrder {
  int vcu;
  __device__ __forceinline__ explicit StaticOrder(int grid,int block):vcu((block%8)*(grid/8)+block/8){}
  __device__ __forceinline__ bool next(int i,AttnUnit&u)const{ if(i>=4)return false; const int s=vcu&7; u.bh=vcu>>3; u.qb=(i==0)?s:(i==1)?15-s:(i==2)?16+s:31-s; return true; }
  __device__ __forceinline__ void a_ready(const AttnUnit&)const{}
  __device__ __forceinline__ void done(const AttnUnit&)const{}
};
#undef SBAR
#undef WAIT_BAR
}

constexpr int DM_ = 2048, PB = 4, PT_ = 2048, SB_ = 128, ST_ = 4, NPAGES = 16, PAGE = 128;
constexpr int MP = PB * PT_;
constexpr int MS = SB_ * ST_;
constexpr int MROWS = MP + MS;
constexpr int NIN = 7424;
constexpr int DFF = 5632, DFF2 = 11264;
constexpr float EPS_ = 1e-6f;
constexpr float C2 = 0.125f * 1.4426950408889634f;
constexpr size_t O_YP = 0, O_YS = O_YP + (size_t)MP * DM_, O_KP = O_YS + (size_t)MS * DM_, O_VP = O_KP + (size_t)MP * 256, O_KIP = O_VP + (size_t)MP * 256,
                 O_SRP = O_KIP + (size_t)MP * 64, O_SIP = O_SRP + 4 * 64 * 64, O_CP = O_SIP + 4 * 64 * 64, O_KS = O_CP + (size_t)4 * 2 * DFF2, O_VS = O_KS + (size_t)MS * 256,
                 O_KIS = O_VS + (size_t)MS * 256, O_SRS = O_KIS + (size_t)MS * 64, O_SIS = O_SRS + (size_t)128 * 64 * 64, O_CS = O_SIS + (size_t)128 * 64 * 64, O_END = O_CS + (size_t)128 * 2 * DFF2;
constexpr size_t MiB = 1u << 20;
constexpr size_t WS_CTL = 0, CTL_ZERO_BYTES = 1 * MiB;
constexpr size_t WS_WIN = 1 * MiB, WS_WP = 30 * MiB, WS_WG = 34 * MiB, WS_WO = 42 * MiB, WS_WUP = 50 * MiB, WS_WDN = 94 * MiB;
constexpr size_t WS_XB = 116 * MiB, WS_Q = 150 * MiB, WS_KB = 167 * MiB, WS_VB = 172 * MiB, WS_QI = 177 * MiB, WS_KI = 186 * MiB, WS_WI = 188 * MiB, WS_RS0 = 189 * MiB;
constexpr size_t WS_U = 190 * MiB, WS_SGA = 207 * MiB, WS_SGB = 241 * MiB, WS_Z = 275 * MiB, WS_MRG = 292 * MiB, WS_SS1 = 326 * MiB, WS_SS2 = 328 * MiB;
constexpr size_t WS_MASK = 330 * MiB, WS_LIST = 332 * MiB, WS_SCP = 333 * MiB, WS_SCS = 397 * MiB, WS_UP = 402 * MiB, WS_ACT = 590 * MiB, WS_END = 684 * MiB;
constexpr int SCS_PITCH = 2304;
constexpr int CW_BAR = 4096;
constexpr int CW_QUEUE = 16384;
constexpr int RING_OFF = 0, RING_BYTES = 131072;
constexpr int AMASK_OFF = 86016;
constexpr int MISC_OFF = 151552;
constexpr int LDS_BYTES = 155648;
static_assert(AMASK_OFF >= attn_body::ATTN_LDS_BYTES && AMASK_OFF + 65536 <= MISC_OFF && MISC_OFF + 512 <= LDS_BYTES, "LDS map");

#define GAS __attribute__((address_space(1)))
#define LAS __attribute__((address_space(3)))
typedef unsigned short bf16;
typedef unsigned v4u __attribute__((ext_vector_type(4)));
typedef unsigned v2u __attribute__((ext_vector_type(2)));
typedef float f32x4 __attribute__((ext_vector_type(4)));
typedef float f32x16 __attribute__((ext_vector_type(16)));
typedef short bf16x8 __attribute__((ext_vector_type(8)));
typedef short s16x4 __attribute__((ext_vector_type(4)));
typedef GAS unsigned gu32;
#define RLX_AGENT __ATOMIC_RELAXED, __HIP_MEMORY_SCOPE_AGENT
#define LDS_WAIT() asm volatile("s_waitcnt lgkmcnt(0)" ::: "memory")
#define VM_WAIT() asm volatile("s_waitcnt vmcnt(0)" ::: "memory")
__device__ __forceinline__ unsigned f2bf(float f) { unsigned u = __builtin_bit_cast(unsigned, f); return (u + 0x7fffu + ((u >> 16) & 1u)) >> 16; }
__device__ __forceinline__ unsigned pk2(float lo, float hi) { return pg8::cvt_pk_bf16(lo, hi); }
__device__ __forceinline__ float bflo(unsigned w) { return __uint_as_float(w << 16); }
__device__ __forceinline__ float bfhi(unsigned w) { return __uint_as_float(w & 0xffff0000u); }
using pg8::sigmoidf_;

#define XB_TMO      128
#define XB_XCNT(j)  (256  + 64 * (j))
#define XB_XSUB(j)  (1280 + 64 * (j))
#define XB_XGEN(j)  (2304 + 64 * (j))
#define XB_TOP      3328
#define XB_TOPGEN   3392
#define XCD_BAR_WORDS 3456
#define XB_SPIN_CAP (1u << 18)
__device__ __forceinline__ unsigned xb_ld(unsigned* p)              { return __hip_atomic_load(p, __ATOMIC_RELAXED, __HIP_MEMORY_SCOPE_AGENT); }
__device__ __forceinline__ unsigned xb_add(unsigned* p, unsigned v) { return __hip_atomic_fetch_add(p, v, __ATOMIC_RELAXED, __HIP_MEMORY_SCOPE_AGENT); }
__device__ __forceinline__ unsigned xb_xcc_id() { return (unsigned)__builtin_amdgcn_s_getreg((3 << 11) | 20) & 0xFu; }
#define XB_SPIN(cond, bar) do { unsigned _sp = 0; while (cond) { __builtin_amdgcn_s_sleep(1); \
    if ((++_sp & 255u) == 0u) { if (xb_ld(&(bar)[XB_TMO])) break; if (_sp > XB_SPIN_CAP) { atomicAdd(&(bar)[XB_TMO], 1u); break; } } } } while (0)
struct XcdBarrier { unsigned* bar; unsigned x; volatile LAS unsigned* st; };
__device__ __forceinline__ XcdBarrier xcd_barrier_post(unsigned* bar, volatile LAS unsigned* st) {
    XcdBarrier b; b.bar = bar; b.x = xb_xcc_id(); b.st = st;
    if (threadIdx.x == 0) (void)xb_add(&bar[XB_XCNT(b.x)], 1u);
    return b;
}
__device__ __forceinline__ void xcd_barrier_complete(unsigned* bar, unsigned x, unsigned& nloc, unsigned& nx) {
    const unsigned G = gridDim.x * gridDim.y * gridDim.z;
    unsigned sum, cnt, mine, sp = 0u;
    for (;;) {
        sum = 0u; cnt = 0u; mine = 0u;
#pragma unroll
        for (unsigned j = 0; j < 16; ++j) { const unsigned c = xb_ld(&bar[XB_XCNT(j)]); sum += c; cnt += (c > 0u) ? 1u : 0u; mine = (j == x) ? c : mine; }
        if (sum == G) break;
        __builtin_amdgcn_s_sleep(1);
        if ((++sp & 255u) == 0u) { if (xb_ld(&bar[XB_TMO])) break; if (sp > XB_SPIN_CAP) { atomicAdd(&bar[XB_TMO], 1u); break; } }
    }
    nloc = mine > 0u ? mine : 1u; nx = cnt > 0u ? cnt : 1u;
}
__device__ __forceinline__ void xcd_barrier(const XcdBarrier& b) {
    asm volatile("s_waitcnt vmcnt(0)" ::: "memory");
    __syncthreads();
    if (threadIdx.x == 0) {
        unsigned* bar = b.bar;
        __builtin_amdgcn_s_waitcnt(0);
        unsigned nloc = b.st[0], nx = b.st[1];
        if (nloc == 0u) { xcd_barrier_complete(bar, b.x, nloc, nx); b.st[0] = nloc; b.st[1] = nx; }
        const unsigned old = xb_add(&bar[XB_XSUB(b.x)], 1u);
        const unsigned gen = old / nloc;
        if (old + 1u == (gen + 1u) * nloc) {
            __builtin_amdgcn_fence(__ATOMIC_RELEASE, "agent");
            asm volatile("s_waitcnt vmcnt(0)" ::: "memory");
            const unsigned og = xb_add(&bar[XB_TOP], 1u);
            const unsigned tg = og / nx;
            if (og + 1u == (tg + 1u) * nx) xb_add(&bar[XB_TOPGEN], 1u);
            else XB_SPIN(xb_ld(&bar[XB_TOPGEN]) == tg, bar);
            __builtin_amdgcn_fence(__ATOMIC_ACQUIRE, "agent");
            xb_add(&bar[XB_XGEN(b.x)], 1u);
            asm volatile("s_waitcnt vmcnt(0)" ::: "memory");
        } else {
            XB_SPIN(xb_ld(&bar[XB_XGEN(b.x)]) == gen, bar);
            __builtin_amdgcn_fence(__ATOMIC_ACQUIRE, "agent");
            asm volatile("s_waitcnt vmcnt(0)" ::: "memory");
        }
    }
    __syncthreads();
}

struct Args { const void* in[28]; float* out; unsigned char* ws; int ph_lo, ph_hi; };
struct Frame {
    LAS unsigned char* lds;
    volatile LAS unsigned* MISC;
    gu32* ctl;
    int tid, lane, wave, vcu, G;
    const void* const* in; float* out; unsigned char* ws;
};
#define INF(k) ((const float*)F.in[k])
#define WSP(T, off) ((T*)(F.ws + (off)))
__device__ __forceinline__ float wave_sum(float v) {
#pragma unroll
    for (int o = 1; o < 64; o <<= 1) v += __shfl_xor(v, o);
    return v;
}
__device__ __forceinline__ int queue_pop(Frame& F, int q) {
    __syncthreads();
    if (F.tid == 0) F.MISC[16] = __hip_atomic_fetch_add(F.ctl + CW_QUEUE + 64 * q, 1u, RLX_AGENT);
    __syncthreads();
    return (int)F.MISC[16];
}

using pg8::Unit;
#define EPI_ARGS const f32x4 (&acc)[2][2][4][2], const Unit& u, int wr, int wc, int fr, int fq
__device__ __forceinline__ v4u pack8(f32x4 a, f32x4 b) { v4u w; w.x = pk2(a[0], a[1]); w.y = pk2(a[2], a[3]); w.z = pk2(b[0], b[1]); w.w = pk2(b[2], b[3]); return w; }
__device__ __forceinline__ void unpack8(v4u w, f32x4& a, f32x4& b) { a = (f32x4){bflo(w.x), bfhi(w.x), bflo(w.y), bfhi(w.y)}; b = (f32x4){bflo(w.z), bfhi(w.z), bflo(w.w), bfhi(w.w)}; }
__device__ __forceinline__ f32x4 sig4(f32x4 v) { return (f32x4){sigmoidf_(v[0]), sigmoidf_(v[1]), sigmoidf_(v[2]), sigmoidf_(v[3])}; }

struct EpiIn {
    static constexpr bool PERM = true, AFTER_DRAIN = false;
    bf16 *Q, *KB, *VB, *QI, *KI, *U, *SGA, *SGB; float* WI; const float* RS0; float* out;
    __device__ __forceinline__ void operator()(EPI_ARGS) const {
        const int row0 = u.pm * 256 + wr * 64 + fr, cl = wc * 32 + 8 * fq, pn = u.pn;
        if (pn < 4 || pn == 6 || pn == 7 || (pn >= 9 && pn < 13)) {
            bf16* base; int ldc, colt; float sc = 1.f;
            if (pn < 4) { base = Q; ldc = 1024; colt = pn * 256; sc = C2; } else if (pn < 8) { base = QI; ldc = 512; colt = (pn - 6) * 256; } else { base = U; ldc = 1024; colt = (pn - 9) * 256; }
#pragma unroll
            for (int ai = 0; ai < 2; ++ai)
#pragma unroll
                for (int m = 0; m < 4; ++m) { const int r = row0 + ai * 128 + m * 16; const float s = RS0[r] * sc; bf16* rowp = base + (size_t)r * ldc + colt + cl;
#pragma unroll
                    for (int bj = 0; bj < 2; ++bj) *(v4u*)(rowp + bj * 128) = pack8(acc[ai][bj][m][0] * s, acc[ai][bj][m][1] * s); }
        } else if (pn >= 13) {
            bf16* base = pn < 21 ? SGA : SGB; const int colt = (pn - (pn < 21 ? 13 : 21)) * 256;
#pragma unroll
            for (int ai = 0; ai < 2; ++ai)
#pragma unroll
                for (int m = 0; m < 4; ++m) { const int r = row0 + ai * 128 + m * 16; const float s = RS0[r]; bf16* rowp = base + (size_t)r * 2048 + colt + cl;
#pragma unroll
                    for (int bj = 0; bj < 2; ++bj) *(v4u*)(rowp + bj * 128) = pack8(sig4(acc[ai][bj][m][0] * s), sig4(acc[ai][bj][m][1] * s)); }
        } else if (pn == 4 || pn == 5) {
            bf16* cb = pn == 4 ? KB : VB; float* oP = out + (pn == 4 ? O_KP : O_VP); float* oS = out + (pn == 4 ? O_KS : O_VS);
#pragma unroll
            for (int ai = 0; ai < 2; ++ai)
#pragma unroll
                for (int m = 0; m < 4; ++m) { const int r = row0 + ai * 128 + m * 16; const float s = RS0[r]; float* orow = (r < MP ? oP + (size_t)r * 256 : oS + (size_t)(r - MP) * 256) + cl; bf16* crow_ = cb + (size_t)r * 256 + cl;
#pragma unroll
                    for (int bj = 0; bj < 2; ++bj) { const f32x4 v0 = acc[ai][bj][m][0] * s, v1 = acc[ai][bj][m][1] * s; *(f32x4*)(orow + bj * 128) = v0; *(f32x4*)(orow + bj * 128 + 4) = v1; *(v4u*)(crow_ + bj * 128) = pack8(v0, v1); } }
        } else if (pn == 8) {
            float* oP = out + O_KIP; float* oS = out + O_KIS;
#pragma unroll
            for (int ai = 0; ai < 2; ++ai)
#pragma unroll
                for (int m = 0; m < 4; ++m) { const int r = row0 + ai * 128 + m * 16; const float s = RS0[r]; const f32x4 v0 = acc[ai][0][m][0] * s, v1 = acc[ai][0][m][1] * s;
                    if (cl < 64) { float* orow = (r < MP ? oP + (size_t)r * 64 : oS + (size_t)(r - MP) * 64) + cl; *(f32x4*)orow = v0; *(f32x4*)(orow + 4) = v1; *(v4u*)(KI + (size_t)r * 64 + cl) = pack8(v0, v1); }
                    else if (cl == 64) { *(f32x4*)(WI + (size_t)r * 8) = v0; *(f32x4*)(WI + (size_t)r * 8 + 4) = v1; } }
        }
    }
};
struct EpiGlu {
    static constexpr bool PERM = true, AFTER_DRAIN = false;
    const bf16* SGB; bf16* MRG;
    __device__ __forceinline__ void operator()(EPI_ARGS) const {
        const int row0 = u.pm * 256 + wr * 64 + fr, col = u.pn * 128 + wc * 32 + 8 * fq;
#pragma unroll
        for (int ai = 0; ai < 2; ++ai)
#pragma unroll
            for (int m = 0; m < 4; ++m) { const size_t off = (size_t)(row0 + ai * 128 + m * 16) * 2048 + col; f32x4 g0, g1; unpack8(*(const v4u*)(SGB + off), g0, g1);
                const f32x4 y0 = acc[ai][0][m][0] * sig4(acc[ai][1][m][0]) * g0, y1 = acc[ai][0][m][1] * sig4(acc[ai][1][m][1]) * g1;
                *(v4u*)(MRG + off) = pack8(y0, y1); }
    }
};
struct EpiProj {
    static constexpr bool PERM = true, AFTER_DRAIN = false;
    const bf16* SGA; bf16* MRG;
    __device__ __forceinline__ void operator()(EPI_ARGS) const {
        const int row0 = u.pm * 256 + wr * 64 + fr, col = u.pn * 256 + wc * 32 + 8 * fq;
#pragma unroll
        for (int ai = 0; ai < 2; ++ai)
#pragma unroll
            for (int m = 0; m < 4; ++m)
#pragma unroll
                for (int bj = 0; bj < 2; ++bj) { const size_t off = (size_t)(row0 + ai * 128 + m * 16) * 2048 + col + bj * 128; f32x4 g0, g1, p0, p1; unpack8(*(const v4u*)(SGA + off), g0, g1); unpack8(*(const v4u*)(MRG + off), p0, p1);
                    *(v4u*)(MRG + off) = pack8(p0 + g0 * acc[ai][bj][m][0], p1 + g1 * acc[ai][bj][m][1]); }
    }
};
struct EpiOut {
    static constexpr bool PERM = true, AFTER_DRAIN = false;
    const float *xP, *xS; float* out; bf16* X1B; float* SS1;
    __device__ __forceinline__ void operator()(EPI_ARGS) const {
        const int row0 = u.pm * 256 + wr * 64 + fr, col = u.pn * 256 + wc * 32 + 8 * fq;
#pragma unroll
        for (int ai = 0; ai < 2; ++ai)
#pragma unroll
            for (int m = 0; m < 4; ++m) { const int r = row0 + ai * 128 + m * 16; const float* xrow = (r < MP ? xP + (size_t)r * 2048 : xS + (size_t)(r - MP) * 2048) + col; float* yrow = out + (size_t)r * 2048 + col;
                float ss = 0.f;
#pragma unroll
                for (int bj = 0; bj < 2; ++bj) { const f32x4 v0 = *(const f32x4*)(xrow + bj * 128) + acc[ai][bj][m][0], v1 = *(const f32x4*)(xrow + bj * 128 + 4) + acc[ai][bj][m][1];
                    *(f32x4*)(yrow + bj * 128) = v0; *(f32x4*)(yrow + bj * 128 + 4) = v1; *(v4u*)(X1B + (size_t)r * 2048 + col + bj * 128) = pack8(v0, v1);
                    ss += (v0[0] * v0[0] + v0[1] * v0[1]) + (v0[2] * v0[2] + v0[3] * v0[3]) + (v1[0] * v1[0] + v1[1] * v1[1]) + (v1[2] * v1[2] + v1[3] * v1[3]); }
                ss += __shfl_xor(ss, 16); ss += __shfl_xor(ss, 32);
                if (fq == 0) SS1[(size_t)r * 32 + u.pn * 4 + wc] = ss; }
    }
};
__device__ __forceinline__ float row_rs(const float* part) {
    const f32x4* p = (const f32x4*)part; float s = 0.f;
#pragma unroll
    for (int i = 0; i < 8; ++i) { const f32x4 v = p[i]; s += (v[0] + v[1]) + (v[2] + v[3]); }
    return 1.0f / sqrtf(s * (1.0f / 2048.0f) + EPS_);
}
struct EpiUp {
    static constexpr bool PERM = true, AFTER_DRAIN = false;
    const float* SS1; bf16* UP; float* out;
    __device__ __forceinline__ void operator()(EPI_ARGS) const {
        const int row0 = u.pm * 256 + wr * 64 + fr, cl = wc * 32 + 8 * fq;
#pragma unroll
        for (int ai = 0; ai < 2; ++ai)
#pragma unroll
            for (int m = 0; m < 4; ++m) { const int r = row0 + ai * 128 + m * 16; const float s = row_rs(SS1 + (size_t)r * 32); bf16* rowp = UP + (size_t)r * DFF2 + u.pn * 256 + cl;
                float* cdst = nullptr;
                if (r < MP) { const int t = r & 2047; if (t >= 2046) cdst = out + O_CP + (size_t)((r >> 11) * 2 + (t - 2046)) * DFF2; }
                else { const int t = (r - MP) & 3; if (t >= 2) cdst = out + O_CS + (size_t)(((r - MP) >> 2) * 2 + (t - 2)) * DFF2; }
#pragma unroll
                for (int bj = 0; bj < 2; ++bj) { const f32x4 v0 = acc[ai][bj][m][0] * s, v1 = acc[ai][bj][m][1] * s; *(v4u*)(rowp + bj * 128) = pack8(v0, v1);
                    if (cdst) { float* d = cdst + (bj ? DFF : 0) + u.pn * 128 + cl; *(f32x4*)d = v0; *(f32x4*)(d + 4) = v1; } } }
    }
};
struct EpiDown {
    static constexpr bool PERM = true, AFTER_DRAIN = false;
    float* out; float* SS2;
    __device__ __forceinline__ void operator()(EPI_ARGS) const {
        const int row0 = u.pm * 256 + wr * 64 + fr, col = u.pn * 256 + wc * 32 + 8 * fq;
#pragma unroll
        for (int ai = 0; ai < 2; ++ai)
#pragma unroll
            for (int m = 0; m < 4; ++m) { const int r = row0 + ai * 128 + m * 16; float* yrow = out + (size_t)r * 2048 + col; float ss = 0.f;
#pragma unroll
                for (int bj = 0; bj < 2; ++bj) { const f32x4 v0 = *(const f32x4*)(yrow + bj * 128) + acc[ai][bj][m][0], v1 = *(const f32x4*)(yrow + bj * 128 + 4) + acc[ai][bj][m][1];
                    *(f32x4*)(yrow + bj * 128) = v0; *(f32x4*)(yrow + bj * 128 + 4) = v1;
                    ss += (v0[0] * v0[0] + v0[1] * v0[1]) + (v0[2] * v0[2] + v0[3] * v0[3]) + (v1[0] * v1[0] + v1[1] * v1[1]) + (v1[2] * v1[2] + v1[3] * v1[3]); }
                ss += __shfl_xor(ss, 16); ss += __shfl_xor(ss, 32);
                if (fq == 0) SS2[(size_t)r * 32 + u.pn * 4 + wc] = ss; }
    }
};
struct OrderGlu {
    int c;
    __device__ __forceinline__ bool next(int i, Unit& u) const {
        if (i < 2) { const int x = c & 7, ii = c >> 3; u.pm = 4 * x + (ii >> 3); u.pn = 2 * (ii & 7) + i; u.kofs = 0; return true; }
        if (i < 4 && c < 16) { u.pm = 32 + (c >> 3); u.pn = 2 * (c & 7) + (i - 2); u.kofs = 0; return true; }
        return false; }
    __device__ __forceinline__ void a_ready(const Unit&) const {}
    __device__ __forceinline__ void done(const Unit&) const {}
};
struct OrderProj {
    int c;
    __device__ __forceinline__ bool next(int i, Unit& u) const {
        if (i == 0) { const int x = c & 7, ii = c >> 3; u.pm = 4 * x + (ii >> 3); u.pn = ii & 7; u.kofs = 0; return true; }
        if (i == 1 && c < 16) { u.pm = 32 + (c >> 3); u.pn = c & 7; u.kofs = 0; return true; }
        return false; }
    __device__ __forceinline__ void a_ready(const Unit&) const {}
    __device__ __forceinline__ void done(const Unit&) const {}
};

template <int MAT> __device__ __forceinline__ int colmap(int n) {
    if (MAT == 0) return n < 2120 ? n : (n < 2304 ? -1 : n - 184);
    if (MAT == 2) { const int j = n >> 8, i = n & 255; return i < 128 ? 128 * j + i : 2048 + 128 * j + (i - 128); }
    if (MAT == 4) { const int j = n >> 8, i = n & 255; return i < 128 ? 128 * j + i : DFF + 128 * j + (i - 128); }
    return n;
}
template <int MAT> __device__ __forceinline__ void p0_transpose_item(const float* W, int K, int Nsrc, int Nrows, const float* gain, bf16* WT, LAS float* scr, int item, int lane) {
    const int nblk = Nrows / 32, kb = item / nblk, nb = item % nblk, k0 = 64 * kb, n0 = 32 * nb;
    const int nc = colmap<MAT>(n0 + (lane & 31));
#pragma unroll 8
    for (int i = 0; i < 32; ++i) { const int kk = 2 * i + (lane >> 5); float v = 0.f; if (nc >= 0) { v = W[(size_t)(k0 + kk) * Nsrc + nc]; if (gain) v *= gain[k0 + kk]; } scr[kk * 33 + (lane & 31)] = v; }
    LDS_WAIT(); asm volatile("" ::: "memory");
    const int c = lane & 7;
#pragma unroll
    for (int j = 0; j < 4; ++j) { const int n = (lane >> 3) + 8 * j; const LAS float* s = scr + (8 * c) * 33 + n;
        v4u o; o.x = pk2(s[0 * 33], s[1 * 33]); o.y = pk2(s[2 * 33], s[3 * 33]); o.z = pk2(s[4 * 33], s[5 * 33]); o.w = pk2(s[6 * 33], s[7 * 33]);
        *(GAS v4u*)(WT + (size_t)(n0 + n) * K + k0 + 8 * c) = o; }
    LDS_WAIT(); asm volatile("" ::: "memory");
}
__device__ __forceinline__ void p0_prologue(Frame& F) {
    LAS float* scr = (LAS float*)(F.lds + RING_OFF + F.wave * 16384);
    const int gw = F.vcu * 8 + F.wave, NGW = F.G * 8;
    constexpr int I0 = 32 * (NIN / 32), I1 = 16 * 64, I2 = 16 * 128, I3 = 32 * 64, I4 = 32 * (DFF2 / 32), I5 = 88 * 64;
    constexpr int NITEMS = I0 + I1 + I2 + I3 + I4 + I5;
    for (int m = gw; m < MROWS; m += NGW) {
        const float* xrow = m < MP ? INF(0) + (size_t)m * 2048 : INF(1) + (size_t)(m - MP) * 2048;
        const GAS f32x4* xr = (const GAS f32x4*)xrow + F.lane; f32x4 v[8]; float s = 0.f;
#pragma unroll
        for (int j = 0; j < 8; ++j) { v[j] = xr[64 * j]; s += (v[j][0] * v[j][0] + v[j][1] * v[j][1]) + (v[j][2] * v[j][2] + v[j][3] * v[j][3]); }
        s = wave_sum(s);
        GAS v2u* o8 = (GAS v2u*)(WSP(bf16, WS_XB) + (size_t)m * 2048) + F.lane;
#pragma unroll
        for (int j = 0; j < 8; ++j) { v2u w; w.x = pk2(v[j][0], v[j][1]); w.y = pk2(v[j][2], v[j][3]); o8[64 * j] = w; }
        if (F.lane == 0) WSP(float, WS_RS0)[m] = 1.0f / sqrtf(s * (1.0f / 2048.0f) + EPS_);
    }
    for (int it = gw; it < NITEMS; it += NGW) {
        int r = it;
        if (r < I0) { p0_transpose_item<0>(INF(10), 2048, 7240, NIN, INF(9), WSP(bf16, WS_WIN), scr, r, F.lane); continue; } r -= I0;
        if (r < I1) { p0_transpose_item<1>(INF(11), 1024, 2048, 2048, nullptr, WSP(bf16, WS_WP), scr, r, F.lane); continue; } r -= I1;
        if (r < I2) { p0_transpose_item<2>(INF(20), 1024, 4096, 4096, nullptr, WSP(bf16, WS_WG), scr, r, F.lane); continue; } r -= I2;
        if (r < I3) { p0_transpose_item<3>(INF(21), 2048, 2048, 2048, nullptr, WSP(bf16, WS_WO), scr, r, F.lane); continue; } r -= I3;
        if (r < I4) { p0_transpose_item<4>(INF(23), 2048, DFF2, DFF2, INF(22), WSP(bf16, WS_WUP), scr, r, F.lane); continue; } r -= I4;
        p0_transpose_item<5>(INF(26), DFF, 2048, 2048, nullptr, WSP(bf16, WS_WDN), scr, r, F.lane);
    }
}

#define MFMA32(a, b, c) __builtin_amdgcn_mfma_f32_32x32x16_bf16((a), (b), (c), 0, 0, 0)
__device__ __forceinline__ s16x4 tr_read(unsigned lds_addr) { s16x4 r; asm volatile("ds_read_b64_tr_b16 %0, %1\n\ts_waitcnt lgkmcnt(0)" : "=&v"(r) : "v"(lds_addr) : "memory"); return r; }
__device__ __forceinline__ float gelu_tanh(float x) {
    const float t = 1.5957691216057308f * (x + 0.044715f * x * x * x);
    return x * sigmoidf_(t);
}
struct S5Const { bf16x8 Bf[2][2]; bf16x8 Cf[8]; bf16x8 Df; float lbr[2], lbi[2]; };
__device__ __forceinline__ void s5_consts(Frame& F, int g, S5Const& C) {
    const int r32 = F.lane & 31, hi = F.lane >> 5;
    const float step = expf(INF(14)[g]);
#pragma unroll
    for (int pg = 0; pg < 2; ++pg) {
        const int p = 32 * pg + r32; const float ar = INF(12)[g * 64 + p], ai = INF(13)[g * 64 + p];
        const float e = expf(ar * step), lr = e * cosf(ai * step), li = e * sinf(ai * step);
        C.lbr[pg] = lr; C.lbi[pg] = li;
        const float den = 1.0f / (ar * ar + ai * ai), cr = ((lr - 1.f) * ar + li * ai) * den, ci = (li * ar - (lr - 1.f) * ai) * den;
        const float* bre = INF(15) + (size_t)(g * 64 + p) * 16 + 8 * hi; const float* bim = INF(16) + (size_t)(g * 64 + p) * 16 + 8 * hi;
#pragma unroll
        for (int j = 0; j < 8; ++j) { const float br = bre[j], bi = bim[j]; C.Bf[pg][0][j] = (short)f2bf(cr * br - ci * bi); C.Bf[pg][1][j] = (short)f2bf(cr * bi + ci * br); }
    }
#pragma unroll
    for (int s = 0; s < 8; ++s)
#pragma unroll
        for (int j = 0; j < 8; ++j) { const int kap = 16 * s + 8 * hi + j, blk = kap >> 5, p = 32 * (blk & 1) + (kap & 31); float v = 0.f;
            if (r32 < 16) v = (blk < 2) ? INF(17)[(size_t)(g * 16 + r32) * 64 + p] : -INF(18)[(size_t)(g * 16 + r32) * 64 + p];
            C.Cf[s][j] = (short)f2bf(v); }
#pragma unroll
    for (int j = 0; j < 8; ++j) C.Df[j] = (short)((r32 < 16 && 8 * hi + j == r32) ? f2bf(INF(19)[g * 16 + r32]) : 0u);
}
__device__ __forceinline__ f32x16 s5_ytile(const f32x16 (&x)[4], const bf16x8& ua, const S5Const& C, LAS unsigned char* img, int lane) {
    const int r32 = lane & 31, hi = lane >> 5;
#pragma unroll
    for (int blk = 0; blk < 4; ++blk)
#pragma unroll
        for (int g4 = 0; g4 < 4; ++g4) { v2u w; w.x = pk2(x[blk][4 * g4], x[blk][4 * g4 + 1]); w.y = pk2(x[blk][4 * g4 + 2], x[blk][4 * g4 + 3]);
            *(LAS v2u*)(img + (32 * blk + r32) * 64 + 8 * (2 * g4 + hi)) = w; }
    LDS_WAIT(); asm volatile("" ::: "memory");
    const unsigned base = (unsigned)(size_t)img;
    const int i16 = lane & 15, q = i16 >> 2, p = i16 & 3, bk = (lane >> 4) & 1;
    f32x16 y = {};
#pragma unroll
    for (int s = 0; s < 8; ++s) {
        const s16x4 lo = tr_read(base + (16 * s + 8 * hi + q) * 64 + 8 * (4 * bk + p));
        const s16x4 hh = tr_read(base + (16 * s + 8 * hi + 4 + q) * 64 + 8 * (4 * bk + p));
        const bf16x8 xa = __builtin_shufflevector(lo, hh, 0, 1, 2, 3, 4, 5, 6, 7);
        y = MFMA32(xa, C.Cf[s], y);
    }
    y = MFMA32(ua, C.Df, y);
    return y;
}
__device__ __forceinline__ void s5_unit(Frame& F, int bp, int g) {
    const int lane = F.lane, w = F.wave, r32 = lane & 31, hi = lane >> 5;
    LAS unsigned char* img = F.lds + w * 8192;
    LAS float* EL = (LAS float*)(F.lds + 65536);
    S5Const C; s5_consts(F, g, C);
    const bf16* U = WSP(bf16, WS_U); bf16* Z = WSP(bf16, WS_Z);
    const int rho = r32, rb = 2 * bp + ((rho >> 2) & 1), rtau = (rho & 3) + 4 * (rho >> 3);
    const bf16* ubase = U + (size_t)(rb * 2048 + 256 * w + rtau) * 1024 + g * 16 + 8 * hi;
    float xr[2] = {0.f, 0.f}, xi[2] = {0.f, 0.f};
    for (int tt = 0; tt < 16; ++tt) {
        const bf16x8 ua = *(const bf16x8*)(ubase + (size_t)tt * 16 * 1024);
        f32x16 acc[4];
#pragma unroll
        for (int blk = 0; blk < 4; ++blk) acc[blk] = MFMA32(ua, C.Bf[blk & 1][blk >> 1], (f32x16){});
#pragma unroll
        for (int pg = 0; pg < 2; ++pg)
#pragma unroll
            for (int r = 0; r < 16; ++r) { const float nr = C.lbr[pg] * xr[pg] - C.lbi[pg] * xi[pg] + acc[pg][r], ni = C.lbr[pg] * xi[pg] + C.lbi[pg] * xr[pg] + acc[2 + pg][r]; xr[pg] = nr; xi[pg] = ni; }
    }
#pragma unroll
    for (int pg = 0; pg < 2; ++pg) { EL[(w * 4 + pg * 2 + 0) * 64 + lane] = xr[pg]; EL[(w * 4 + pg * 2 + 1) * 64 + lane] = xi[pg]; }
    __syncthreads();
#pragma unroll
    for (int pg = 0; pg < 2; ++pg) {
        float pr = C.lbr[pg], pi = C.lbi[pg];
#pragma unroll
        for (int k = 0; k < 8; ++k) { const float nr = pr * pr - pi * pi, ni = 2.f * pr * pi; pr = nr; pi = ni; }
        float cr = 0.f, ci = 0.f;
        for (int ww = 0; ww < w; ++ww) { const float er = EL[(ww * 4 + pg * 2 + 0) * 64 + lane], ei = EL[(ww * 4 + pg * 2 + 1) * 64 + lane];
            const float nr = pr * cr - pi * ci + er, ni = pr * ci + pi * cr + ei; cr = nr; ci = ni; }
        xr[pg] = cr; xi[pg] = ci;
    }
    for (int tt = 0; tt < 16; ++tt) {
        const bf16x8 ua = *(const bf16x8*)(ubase + (size_t)tt * 16 * 1024);
        f32x16 acc[4];
#pragma unroll
        for (int blk = 0; blk < 4; ++blk) acc[blk] = MFMA32(ua, C.Bf[blk & 1][blk >> 1], (f32x16){});
#pragma unroll
        for (int pg = 0; pg < 2; ++pg)
#pragma unroll
            for (int r = 0; r < 16; ++r) { const float nr = C.lbr[pg] * xr[pg] - C.lbi[pg] * xi[pg] + acc[pg][r], ni = C.lbr[pg] * xi[pg] + C.lbi[pg] * xr[pg] + acc[2 + pg][r]; xr[pg] = nr; xi[pg] = ni; acc[pg][r] = nr; acc[2 + pg][r] = ni; }
        const f32x16 y = s5_ytile(acc, ua, C, img, lane);
        if (r32 < 16) {
#pragma unroll
            for (int r = 0; r < 16; ++r) { const int orho = (r & 3) + 8 * (r >> 2) + 4 * hi, ob = 2 * bp + ((orho >> 2) & 1), otau = (orho & 3) + 4 * (orho >> 3);
                Z[(size_t)(ob * 2048 + 256 * w + 16 * tt + otau) * 1024 + g * 16 + r32] = (bf16)f2bf(gelu_tanh(y[r])); }
        }
        LDS_WAIT(); asm volatile("" ::: "memory");
    }
    if (w == 7) {
#pragma unroll
        for (int pg = 0; pg < 2; ++pg) { const size_t o = (size_t)((2 * bp + hi) * 64 + g) * 64 + 32 * pg + r32; F.out[O_SRP + o] = xr[pg]; F.out[O_SIP + o] = xi[pg]; }
    }
    {
        const int T = 8 * bp + w;
        const bf16x8 ua = *(const bf16x8*)(U + (size_t)(MP + 32 * T + r32) * 1024 + g * 16 + 8 * hi);
        f32x16 acc[4];
#pragma unroll
        for (int blk = 0; blk < 4; ++blk) acc[blk] = MFMA32(ua, C.Bf[blk & 1][blk >> 1], (f32x16){});
#pragma unroll
        for (int pg = 0; pg < 2; ++pg)
#pragma unroll
            for (int k4 = 0; k4 < 4; ++k4) { const size_t so = (size_t)((8 * T + 2 * k4 + hi) * 64 + g) * 64 + 32 * pg + r32; float sr = INF(5)[so], si = INF(6)[so];
#pragma unroll
                for (int t = 0; t < 4; ++t) { const int r = 4 * k4 + t; const float nr = C.lbr[pg] * sr - C.lbi[pg] * si + acc[pg][r], ni = C.lbr[pg] * si + C.lbi[pg] * sr + acc[2 + pg][r]; sr = nr; si = ni; acc[pg][r] = nr; acc[2 + pg][r] = ni; }
                F.out[O_SRS + so] = sr; F.out[O_SIS + so] = si; }
        const f32x16 y = s5_ytile(acc, ua, C, img, lane);
        if (r32 < 16) {
#pragma unroll
            for (int r = 0; r < 16; ++r) { const int orho = (r & 3) + 8 * (r >> 2) + 4 * hi; Z[(size_t)(MP + 32 * T + orho) * 1024 + g * 16 + r32] = (bf16)f2bf(gelu_tanh(y[r])); }
        }
        LDS_WAIT();
    }
    __syncthreads();
}

__device__ __forceinline__ unsigned wave_incl_scan(unsigned v, int lane) {
#pragma unroll
    for (int o = 1; o < 64; o <<= 1) { const unsigned t = __shfl_up(v, o); if (lane >= o) v += t; }
    return v;
}
__device__ __forceinline__ unsigned fkey(float f) { const unsigned u = __float_as_uint(f); return (u & 0x80000000u) ? ~u : (u | 0x80000000u); }
template <int MODE> __device__ __forceinline__ void select_query(const float* row, int n_valid, LAS unsigned* hist  , LAS unsigned* mwords  , unsigned* mout, int q32, unsigned* list, int lane) {
    constexpr int NJ = MODE == 0 ? 8 : 9;
    const int L = (n_valid + 255) >> 8;
    unsigned key[NJ][4];
#pragma unroll
    for (int j = 0; j < NJ; ++j) {
        f32x4 v = {0.f, 0.f, 0.f, 0.f};
        if (j < L) v = *(const f32x4*)(row + 256 * j + 4 * lane);
#pragma unroll
        for (int i = 0; i < 4; ++i) { const int kv = 256 * j + 4 * lane + i; key[j][i] = (j < L && kv < n_valid) ? fkey(v[i]) : 0u; }
    }
    unsigned T = 0u, need = 256u; bool all = (n_valid <= 256);
    if (!all) {
#pragma unroll 1
        for (int lvl = 3; lvl >= 0; --lvl) {
            const int sh = 8 * lvl;
            hist[lane] = 0u; hist[64 + lane] = 0u; hist[128 + lane] = 0u; hist[192 + lane] = 0u;
            LDS_WAIT();
            const unsigned pmask = lvl == 3 ? 0u : (0xffffffffu << (sh + 8));
#pragma unroll
            for (int j = 0; j < NJ; ++j) if (j < L) {
#pragma unroll
                for (int i = 0; i < 4; ++i) { const unsigned k = key[j][i]; if (k != 0u && ((k ^ T) & pmask) == 0u) __hip_atomic_fetch_add(&hist[(k >> sh) & 255u], 1u, __ATOMIC_RELAXED, __HIP_MEMORY_SCOPE_WORKGROUP); } }
            LDS_WAIT();
            const unsigned c0 = hist[4 * lane], c1 = hist[4 * lane + 1], c2 = hist[4 * lane + 2], c3 = hist[4 * lane + 3];
            const unsigned tl = c0 + c1 + c2 + c3, incl = wave_incl_scan(tl, lane), tot = __shfl(incl, 63);
            unsigned run = tot - incl;
            int fb = -1; unsigned fab = 0u;
            if (run < need && need <= run + c3) { fb = 4 * lane + 3; fab = run; } run += c3;
            if (fb < 0 && run < need && need <= run + c2) { fb = 4 * lane + 2; fab = run; } run += c2;
            if (fb < 0 && run < need && need <= run + c1) { fb = 4 * lane + 1; fab = run; } run += c1;
            if (fb < 0 && run < need && need <= run + c0) { fb = 4 * lane + 0; fab = run; }
            const unsigned long long bal = __ballot(fb >= 0);
            const int src = bal ? (int)__builtin_ctzll(bal) : 0;
            const int bsel = __shfl(fb, src); const unsigned above = __shfl(fab, src);
            T |= ((unsigned)(bsel < 0 ? 0 : bsel)) << sh; need -= above;
            LDS_WAIT();
        }
    }
    unsigned eqtot = 0u;
    if (!all) { unsigned c = 0u;
#pragma unroll
        for (int j = 0; j < NJ; ++j)
#pragma unroll
            for (int i = 0; i < 4; ++i) c += (key[j][i] == T) ? 1u : 0u;
        eqtot = __shfl(wave_incl_scan(c, lane), 63); }
    const bool ties = !all && eqtot != need;
    unsigned nib[NJ]; unsigned ebase = 0u;
#pragma unroll
    for (int j = 0; j < NJ; ++j) {
        unsigned nb = 0u;
        if (all) {
#pragma unroll
            for (int i = 0; i < 4; ++i) nb |= (key[j][i] != 0u) ? (1u << i) : 0u;
        } else if (!ties) {
#pragma unroll
            for (int i = 0; i < 4; ++i) nb |= (key[j][i] >= T && key[j][i] != 0u) ? (1u << i) : 0u;
        } else {
            unsigned cnt = 0u;
#pragma unroll
            for (int i = 0; i < 4; ++i) cnt += (key[j][i] == T) ? 1u : 0u;
            const unsigned incl = wave_incl_scan(cnt, lane); unsigned run = ebase + incl - cnt; ebase += __shfl(incl, 63);
#pragma unroll
            for (int i = 0; i < 4; ++i) { const bool e = key[j][i] == T; if (key[j][i] > T || (e && run < need)) nb |= 1u << i; run += e ? 1u : 0u; }
        }
        nib[j] = nb;
    }
    if (MODE == 0) {
        mwords[lane] = 0u; LDS_WAIT();
#pragma unroll
        for (int j = 0; j < 8; ++j) if (nib[j]) __hip_atomic_fetch_or(&mwords[(lane & 1) * 32 + 4 * j + (lane >> 4)], nib[j] << (4 * ((lane & 15) >> 1)), __ATOMIC_RELAXED, __HIP_MEMORY_SCOPE_WORKGROUP);
        LDS_WAIT();
        const unsigned wv = mwords[lane];
        mout[((lane & 31) * 2 + (lane >> 5)) * 32 + q32] = wv;
        LDS_WAIT();
    } else {
        unsigned base = 0u;
#pragma unroll
        for (int j = 0; j < NJ; ++j) { const unsigned cnt = __builtin_popcount(nib[j]); const unsigned incl = wave_incl_scan(cnt, lane); unsigned pos = base + incl - cnt; base += __shfl(incl, 63);
#pragma unroll
            for (int i = 0; i < 4; ++i) if ((nib[j] >> i) & 1u) { if (pos < 256u) list[pos] = (unsigned)(256 * j + 4 * lane + i); ++pos; } }
    }
}
__device__ __forceinline__ float dpp_sum8(float v) {
    v += __uint_as_float(__builtin_amdgcn_update_dpp(0u, __float_as_uint(v), 0xB1, 0xf, 0xf, true));
    v += __uint_as_float(__builtin_amdgcn_update_dpp(0u, __float_as_uint(v), 0x4E, 0xf, 0xf, true));
    v += __uint_as_float(__builtin_amdgcn_update_dpp(0u, __float_as_uint(v), 0x141, 0xf, 0xf, true));
    return v;
}
__device__ __forceinline__ float dpp_sum16(float v) {
    v = dpp_sum8(v);
    v += __uint_as_float(__builtin_amdgcn_update_dpp(0u, __float_as_uint(v), 0x140, 0xf, 0xf, true));
    return v;
}
__device__ __forceinline__ float dpp_max16(float v) {
    v = fmaxf(v, __uint_as_float(__builtin_amdgcn_update_dpp(0u, __float_as_uint(v), 0xB1, 0xf, 0xf, true)));
    v = fmaxf(v, __uint_as_float(__builtin_amdgcn_update_dpp(0u, __float_as_uint(v), 0x4E, 0xf, 0xf, true)));
    v = fmaxf(v, __uint_as_float(__builtin_amdgcn_update_dpp(0u, __float_as_uint(v), 0x141, 0xf, 0xf, true)));
    v = fmaxf(v, __uint_as_float(__builtin_amdgcn_update_dpp(0u, __float_as_uint(v), 0x140, 0xf, 0xf, true)));
    return v;
}
constexpr float IDX_SCALE = 0.125f * 0.35355339059327373f;
constexpr int QIL_PITCH = 1040;
__device__ __forceinline__ void idx_unit_prompt(Frame& F, int b, int qb) {
    const int lane = F.lane, w = F.wave, r32 = lane & 31, hi = lane >> 5;
    const int R0 = b * 2048 + 32 * qb;
    const bf16* QI = WSP(bf16, WS_QI); const bf16* KI = WSP(bf16, WS_KI); float* SC = WSP(float, WS_SCP);
    LAS unsigned char* qil = F.lds;
    LAS unsigned* hist = (LAS unsigned*)(F.lds + 40960) + w * 256;
    LAS unsigned* mw = (LAS unsigned*)(F.lds + 49152) + w * 64;
    { const int row = F.tid >> 4, ch = F.tid & 15; const v4u* src = (const v4u*)(QI + (size_t)(R0 + row) * 512) + ch * 4;
#pragma unroll
      for (int i = 0; i < 4; ++i) *(LAS v4u*)(qil + row * QIL_PITCH + (ch * 4 + i) * 16) = src[i]; }
    float wq[8];
    { const f32x4 a = *(const f32x4*)(WSP(float, WS_WI) + (size_t)(R0 + r32) * 8), c = *(const f32x4*)(WSP(float, WS_WI) + (size_t)(R0 + r32) * 8 + 4);
#pragma unroll
      for (int h = 0; h < 4; ++h) { wq[h] = a[h] * IDX_SCALE; wq[4 + h] = c[h] * IDX_SCALE; } }
    __syncthreads();
    for (int kb = w; kb <= qb; kb += 8) {
        bf16x8 af[4];
#pragma unroll
        for (int ks = 0; ks < 4; ++ks) af[ks] = *(const bf16x8*)(KI + (size_t)(b * 2048 + 32 * kb + r32) * 64 + 16 * ks + 8 * hi);
        f32x16 sc = {};
#pragma unroll 1
        for (int h = 0; h < 8; ++h) {
            f32x16 acc = {}; const float wqh = wq[h];
#pragma unroll
            for (int ks = 0; ks < 4; ++ks) { const bf16x8 bfr = *(const LAS bf16x8*)(qil + r32 * QIL_PITCH + h * 128 + ks * 32 + hi * 16); acc = MFMA32(af[ks], bfr, acc); }
#pragma unroll
            for (int r = 0; r < 16; ++r) sc[r] += fmaxf(acc[r], 0.f) * wqh;
        }
#pragma unroll
        for (int k4 = 0; k4 < 4; ++k4) *(f32x4*)(SC + (size_t)(R0 + r32) * 2048 + 32 * kb + 8 * k4 + 4 * hi) = (f32x4){sc[4 * k4], sc[4 * k4 + 1], sc[4 * k4 + 2], sc[4 * k4 + 3]};
    }
    VM_WAIT(); __syncthreads();
    unsigned* mout = WSP(unsigned, WS_MASK) + (size_t)(b * 64 + qb) * 2048;
    for (int qq = w; qq < 32; qq += 8) select_query<0>(SC + (size_t)(R0 + qq) * 2048, 32 * qb + qq + 1, hist, mw, mout, qq, nullptr, lane);
    __syncthreads();
}
__device__ __forceinline__ void idx_unit_sample(Frame& F, int b) {
    const int lane = F.lane, w = F.wave, r32 = lane & 31, hi = lane >> 5, t = r32 >> 3, h = r32 & 7;
    const bf16* QI = WSP(bf16, WS_QI); const bf16* KI = WSP(bf16, WS_KI); float* SC = WSP(float, WS_SCS);
    LAS unsigned* hist = (LAS unsigned*)(F.lds + 40960) + w * 256;
    const int* PTB = (const int*)F.in[8] + b * 16;
    bf16x8 bfr[4];
#pragma unroll
    for (int ks = 0; ks < 4; ++ks) bfr[ks] = *(const bf16x8*)(QI + (size_t)(MP + 4 * b + t) * 512 + h * 64 + 16 * ks + 8 * hi);
    const float wq = WSP(float, WS_WI)[(size_t)(MP + 4 * b + t) * 8 + h] * IDX_SCALE;
    for (int kb = w; kb < 65; kb += 8) {
        bf16x8 af[4];
        if (kb < 64) {
            const int kv = 32 * kb + r32, page = PTB[kv >> 7];
            const float* src = INF(4) + ((size_t)page * 128 + (kv & 127)) * 64 + 8 * hi;
#pragma unroll
            for (int ks = 0; ks < 4; ++ks) { const f32x4 a = *(const f32x4*)(src + 16 * ks), c = *(const f32x4*)(src + 16 * ks + 4); const v4u pk = pack8(a, c); af[ks] = __builtin_bit_cast(bf16x8, pk); }
        } else {
#pragma unroll
            for (int ks = 0; ks < 4; ++ks) { v4u z = {0u, 0u, 0u, 0u}; if (r32 < 4) z = *(const v4u*)(KI + (size_t)(MP + 4 * b + r32) * 64 + 16 * ks + 8 * hi); af[ks] = __builtin_bit_cast(bf16x8, z); }
        }
        f32x16 acc = {};
#pragma unroll
        for (int ks = 0; ks < 4; ++ks) acc = MFMA32(af[ks], bfr[ks], acc);
        float v[16];
#pragma unroll
        for (int r = 0; r < 16; ++r) v[r] = dpp_sum8(fmaxf(acc[r], 0.f) * wq);
        f32x4 o = {v[0], v[1], v[2], v[3]};
        if (h == 1) o = (f32x4){v[4], v[5], v[6], v[7]}; else if (h == 2) o = (f32x4){v[8], v[9], v[10], v[11]}; else if (h == 3) o = (f32x4){v[12], v[13], v[14], v[15]};
        if (h < 4) *(f32x4*)(SC + (size_t)(4 * b + t) * SCS_PITCH + 32 * kb + 8 * h + 4 * hi) = o;
    }
    VM_WAIT(); __syncthreads();
    if (w < 4) select_query<1>(SC + (size_t)(4 * b + w) * SCS_PITCH, 2049 + w, hist, nullptr, nullptr, 0, WSP(unsigned, WS_LIST) + (size_t)(4 * b + w) * 256, lane);
    __syncthreads();
}

__device__ __forceinline__ void sattn_unit(Frame& F, int b, int t) {
    const int lane = F.lane, w = F.wave, n = lane >> 4, d4 = lane & 15;
    const int rs = 4 * b + t, row = MP + rs;
    const bf16* Q = WSP(bf16, WS_Q);
    LAS float* xm = (LAS float*)(F.lds);
    LAS float* xs = (LAS float*)(F.lds + 512);
    LAS float* pl = (LAS float*)(F.lds + 1024) + w * 512;
    LAS float* ored = (LAS float*)(F.lds + 1024 + 16384);
    float qv[4][4];
#pragma unroll
    for (int j = 0; j < 4; ++j) { const v2u qw = *(const v2u*)(Q + (size_t)row * 1024 + (4 * n + j) * 64 + 4 * d4); qv[j][0] = bflo(qw.x); qv[j][1] = bfhi(qw.x); qv[j][2] = bflo(qw.y); qv[j][3] = bfhi(qw.y); }
    const unsigned kvl = WSP(unsigned, WS_LIST)[(size_t)rs * 256 + 32 * w + (lane & 31)];
    const int page = ((const int*)F.in[8])[b * 16 + ((kvl < 2048u ? kvl : 0u) >> 7)];
    const unsigned long long coff = ((unsigned long long)page * 128ull + (kvl & 127u)) * 256ull;
    const unsigned long long noff = (unsigned long long)(4 * b + (int)(kvl < 2048u ? 0u : kvl - 2048u)) * 256ull;
    const bool isnew = kvl >= 2048u;
    float sv[4][2];
#pragma unroll
    for (int j = 0; j < 4; ++j) { sv[j][0] = 0.f; sv[j][1] = 0.f; }
#pragma unroll 1
    for (int half = 0; half < 2; ++half) {
        f32x4 kvec[16];
#pragma unroll
        for (int k = 0; k < 16; ++k) { const int e = 16 * half + k; const bool nw = __shfl((int)isnew, e) != 0; const unsigned long long o = nw ? __shfl(noff, e) : __shfl(coff, e);
            const float* base = nw ? (F.out + O_KS) : INF(2); kvec[k] = *(const f32x4*)(base + o + 4 * lane); }
#pragma unroll
        for (int k = 0; k < 16; ++k)
#pragma unroll
            for (int j = 0; j < 4; ++j) { float p = qv[j][0] * kvec[k][0] + qv[j][1] * kvec[k][1] + qv[j][2] * kvec[k][2] + qv[j][3] * kvec[k][3]; p = dpp_sum16(p); if (d4 == k) { if (half == 0) sv[j][0] = p; else sv[j][1] = p; } }
    }
    float mj[4], sj[4];
#pragma unroll
    for (int j = 0; j < 4; ++j) { mj[j] = dpp_max16(fmaxf(sv[j][0], sv[j][1])); if (d4 == 0) xm[w * 16 + 4 * n + j] = mj[j]; }
    __syncthreads();
#pragma unroll
    for (int j = 0; j < 4; ++j) { float m = xm[4 * n + j];
#pragma unroll
        for (int ww = 1; ww < 8; ++ww) m = fmaxf(m, xm[ww * 16 + 4 * n + j]);
        const float p0 = __builtin_amdgcn_exp2f(sv[j][0] - m), p1 = __builtin_amdgcn_exp2f(sv[j][1] - m);
        pl[d4 * 16 + 4 * n + j] = p0; pl[(16 + d4) * 16 + 4 * n + j] = p1;
        sj[j] = dpp_sum16(p0 + p1); if (d4 == 0) xs[w * 16 + 4 * n + j] = sj[j]; }
    LDS_WAIT();
    float o[4][4] = {};
#pragma unroll 1
    for (int half = 0; half < 2; ++half) {
        f32x4 vvec[16];
#pragma unroll
        for (int k = 0; k < 16; ++k) { const int e = 16 * half + k; const bool nw = __shfl((int)isnew, e) != 0; const unsigned long long of = nw ? __shfl(noff, e) : __shfl(coff, e);
            const float* base = nw ? (F.out + O_VS) : INF(3); vvec[k] = *(const f32x4*)(base + of + 4 * lane); }
#pragma unroll
        for (int k = 0; k < 16; ++k) { const f32x4 pj = *(const LAS f32x4*)(pl + (16 * half + k) * 16 + 4 * n);
#pragma unroll
            for (int j = 0; j < 4; ++j)
#pragma unroll
                for (int c = 0; c < 4; ++c) o[j][c] += pj[j] * vvec[k][c]; }
    }
#pragma unroll
    for (int j = 0; j < 4; ++j)
#pragma unroll
        for (int c = 0; c < 4; ++c) ored[(w * 16 + j * 4 + c) * 64 + lane] = o[j][c];
    __syncthreads();
    {
        const int part = w, j = part >> 1, c0 = 2 * (part & 1);
        float tot = 0.f;
#pragma unroll
        for (int ww = 0; ww < 8; ++ww) tot += xs[ww * 16 + 4 * n + j];
        float a0 = 0.f, a1 = 0.f;
#pragma unroll
        for (int ww = 0; ww < 8; ++ww) { a0 += ored[(ww * 16 + j * 4 + c0) * 64 + lane]; a1 += ored[(ww * 16 + j * 4 + c0 + 1) * 64 + lane]; }
        const float inv = 1.0f / tot;
        *(unsigned*)(WSP(bf16, WS_Q) + (size_t)row * 1024 + (4 * n + j) * 64 + 4 * d4 + c0) = pk2(a0 * inv, a1 * inv);
    }
    __syncthreads();
}

__device__ __forceinline__ void p7_convgate(Frame& F) {
    const int gw = F.vcu * 8 + F.wave, NGW = F.G * 8;
    const bf16* UP = WSP(bf16, WS_UP); bf16* ACT = WSP(bf16, WS_ACT);
    const float* cw = INF(24); const float* cb = INF(25); const float* cst = INF(7);
    for (int it = gw; it < (MROWS / 32) * 11; it += NGW) {
        const int rb = it / 11, cg = it % 11, c = cg * 512 + F.lane * 8;
        const size_t ucol = (size_t)(c >> 7) * 256 + (c & 127);
        float wg[3][8], wv[3][8], bg[8], bv[8];
#pragma unroll
        for (int j = 0; j < 3; ++j)
#pragma unroll
            for (int e = 0; e < 8; ++e) { wg[j][e] = cw[(size_t)j * DFF2 + c + e]; wv[j][e] = cw[(size_t)j * DFF2 + DFF + c + e]; }
#pragma unroll
        for (int e = 0; e < 8; ++e) { bg[e] = cb[c + e]; bv[e] = cb[DFF + c + e]; }
        f32x4 g2[2], g1[2], v2[2], v1[2];
        const int r0 = rb * 32;
#define loadrow(r_, g_, v_) do { const v4u a_ = *(const v4u*)(UP + (size_t)(r_) * DFF2 + ucol), bb_ = *(const v4u*)(UP + (size_t)(r_) * DFF2 + ucol + 128); unpack8(a_, g_[0], g_[1]); unpack8(bb_, v_[0], v_[1]); } while (0)
        if (r0 < MP && (r0 & 2047) != 0) { loadrow(r0 - 2, g2, v2); loadrow(r0 - 1, g1, v1); }
        else { g2[0] = g2[1] = g1[0] = g1[1] = v2[0] = v2[1] = v1[0] = v1[1] = (f32x4){0.f, 0.f, 0.f, 0.f}; }
        for (int rr = 0; rr < 32; ++rr) {
            const int r = r0 + rr;
            if (r >= MP && ((r - MP) & 3) == 0) {
                const float* s0 = cst + (size_t)((r - MP) >> 2) * 2 * DFF2; const float* s1 = s0 + DFF2;
                g2[0] = *(const f32x4*)(s0 + c); g2[1] = *(const f32x4*)(s0 + c + 4); v2[0] = *(const f32x4*)(s0 + DFF + c); v2[1] = *(const f32x4*)(s0 + DFF + c + 4);
                g1[0] = *(const f32x4*)(s1 + c); g1[1] = *(const f32x4*)(s1 + c + 4); v1[0] = *(const f32x4*)(s1 + DFF + c); v1[1] = *(const f32x4*)(s1 + DFF + c + 4);
            }
            f32x4 g0[2], v0[2]; loadrow(r, g0, v0);
            float o[8];
#pragma unroll
            for (int e = 0; e < 8; ++e) { const int hh = e >> 2, ee = e & 3;
                const float gm = bg[e] + wg[0][e] * g2[hh][ee] + wg[1][e] * g1[hh][ee] + wg[2][e] * g0[hh][ee];
                const float vm = bv[e] + wv[0][e] * v2[hh][ee] + wv[1][e] * v1[hh][ee] + wv[2][e] * v0[hh][ee];
                o[e] = gm * sigmoidf_(gm) * vm; }
            v4u ow; ow.x = pk2(o[0], o[1]); ow.y = pk2(o[2], o[3]); ow.z = pk2(o[4], o[5]); ow.w = pk2(o[6], o[7]);
            *(v4u*)(ACT + (size_t)r * DFF + c) = ow;
            g2[0] = g1[0]; g2[1] = g1[1]; v2[0] = v1[0]; v2[1] = v1[1]; g1[0] = g0[0]; g1[1] = g0[1]; v1[0] = v0[0]; v1[1] = v0[1];
        }
    }
}
#undef loadrow
__device__ __forceinline__ void p9_final(Frame& F) {
    const int gw = F.vcu * 8 + F.wave, NGW = F.G * 8;
    const float* gf = INF(27); const float* SS2 = WSP(float, WS_SS2);
    for (int m = gw; m < MROWS; m += NGW) {
        const float rs = row_rs(SS2 + (size_t)m * 32);
        GAS f32x4* yr = (GAS f32x4*)(F.out + (size_t)m * 2048) + F.lane; const f32x4* gr = (const f32x4*)gf + F.lane;
#pragma unroll
        for (int j = 0; j < 8; ++j) { const f32x4 v = yr[64 * j]; yr[64 * j] = v * rs * gr[64 * j]; }
    }
}

constexpr int NPHASE = 10;
__global__ void __launch_bounds__(512, 2) hybrid_fwd(Args args) {
    extern __shared__ __attribute__((aligned(16))) unsigned char lds[];
    Frame F;
    F.lds = (LAS unsigned char*)lds;
    F.MISC = (volatile LAS unsigned*)(F.lds + MISC_OFF);
    F.tid = threadIdx.x; F.lane = F.tid & 63; F.wave = __builtin_amdgcn_readfirstlane(F.tid >> 6);
    F.G = gridDim.x; { const int bx = blockIdx.x; F.vcu = (F.G % 8 == 0) ? (bx % 8) * (F.G / 8) + bx / 8 : bx; }
    F.in = args.in; F.out = args.out; F.ws = args.ws; F.ctl = (gu32*)(args.ws + WS_CTL);
    for (int u = F.tid; u < 128; u += 512) ((LAS unsigned*)(F.lds + MISC_OFF))[u] = 0u;
    __syncthreads();
    const int lo = args.ph_lo, hi = args.ph_hi;
    const bool multi = (hi - lo) > 1;
    XcdBarrier bar; bar.bar = (unsigned*)(F.ctl + CW_BAR); bar.x = 0; bar.st = nullptr;
    if (multi) bar = xcd_barrier_post((unsigned*)(F.ctl + CW_BAR), F.MISC + 8);
#ifndef PH_MASK
#define PH_MASK 0x3ff
#endif
#define IN(k) (((PH_MASK >> (k)) & 1) && lo <= (k) && (k) < hi)
#define SEAM(k) do { if (IN(k) && IN((k) + 1)) xcd_barrier(bar); } while (0)
    const int c = (int)blockIdx.x;

    if (IN(0)) { p0_prologue(F); SEAM(0); }

    if (IN(1)) {
        pg8::Gemm g{WSP(bf16, WS_XB), WSP(bf16, WS_WIN), 2048, 2048, 2048}; pg8::StaticOrder S; S.init(MROWS, NIN, F.G, c);
        EpiIn E{WSP(bf16, WS_Q), WSP(bf16, WS_KB), WSP(bf16, WS_VB), WSP(bf16, WS_QI), WSP(bf16, WS_KI), WSP(bf16, WS_U), WSP(bf16, WS_SGA), WSP(bf16, WS_SGB), WSP(float, WS_WI), WSP(float, WS_RS0), F.out};
        pg8::gemm_phase<EpiIn, pg8::StaticOrder, true, true>(F.lds + RING_OFF, g, S, E);
        SEAM(1);
    }

    if (IN(2)) {
#ifndef P2_MASK
#define P2_MASK 7
#endif
        if (P2_MASK & 1) for (;;) { const int u = queue_pop(F, 0); if (u >= 128) break; s5_unit(F, u & 1, u >> 1); }
        if (P2_MASK & 2) for (;;) { const int u = queue_pop(F, 1); if (u >= 256) break; idx_unit_prompt(F, u & 3, 63 - (u >> 2)); }
        if (P2_MASK & 4) for (;;) { const int u = queue_pop(F, 2); if (u >= 128) break; idx_unit_sample(F, u); }
        SEAM(2);
    }

    if (IN(3)) {
        const attn_body::bf16* Qp = (const attn_body::bf16*)WSP(bf16, WS_Q);
        const int bh = F.vcu >> 2, s = F.vcu & 3;
#ifndef P3_MASK
#define P3_MASK 3
#endif
        if (F.G == 256 && (P3_MASK & 1)) {
            if (c & 1) { sattn_unit(F, c >> 2, c & 3); }
            for (int i = 0; i < 2; ++i)
                attn_body::attn_unit<8>(bh >> 4, bh & 15, i == 0 ? 7 - s : s, Qp, (const attn_body::bf16*)WSP(bf16, WS_KB), (const attn_body::bf16*)WSP(bf16, WS_VB), (attn_body::bf16*)WSP(bf16, WS_Q),
                                        WSP(unsigned, WS_MASK), (char*)lds + RING_OFF, (char*)lds + AMASK_OFF);
        }
        if (P3_MASK & 2) for (int v = c; v < 512; v += F.G) { if (F.G == 256 && (c & 1) && v == c) continue; sattn_unit(F, v >> 2, v & 3); }
        SEAM(3);
    }

    if (IN(4)) {
        { pg8::Gemm g{WSP(bf16, WS_Z), WSP(bf16, WS_WG), 1024, 1024, 1024}; OrderGlu S{c}; EpiGlu E{WSP(bf16, WS_SGB), WSP(bf16, WS_MRG)};
          pg8::gemm_phase<EpiGlu, OrderGlu, true, true>(F.lds + RING_OFF, g, S, E); }
        { pg8::Gemm g{WSP(bf16, WS_Q), WSP(bf16, WS_WP), 1024, 1024, 1024}; OrderProj S{c}; EpiProj E{WSP(bf16, WS_SGA), WSP(bf16, WS_MRG)};
          pg8::gemm_phase<EpiProj, OrderProj, true, true>(F.lds + RING_OFF, g, S, E); }
        SEAM(4);
    }

    if (IN(5)) {
        pg8::Gemm g{WSP(bf16, WS_MRG), WSP(bf16, WS_WO), 2048, 2048, 2048}; pg8::StaticOrder S; S.init(MROWS, 2048, F.G, c);
        EpiOut E{INF(0), INF(1), F.out, WSP(bf16, WS_XB), WSP(float, WS_SS1)};
        pg8::gemm_phase<EpiOut, pg8::StaticOrder, true, true>(F.lds + RING_OFF, g, S, E);
        SEAM(5);
    }

    if (IN(6)) {
        pg8::Gemm g{WSP(bf16, WS_XB), WSP(bf16, WS_WUP), 2048, 2048, 2048}; pg8::StaticOrder S; S.init(MROWS, DFF2, F.G, c);
        EpiUp E{WSP(float, WS_SS1), WSP(bf16, WS_UP), F.out};
        pg8::gemm_phase<EpiUp, pg8::StaticOrder, true, true>(F.lds + RING_OFF, g, S, E);
        SEAM(6);
    }

    if (IN(7)) { p7_convgate(F); SEAM(7); }

    if (IN(8)) {
        pg8::Gemm g{WSP(bf16, WS_ACT), WSP(bf16, WS_WDN), DFF, DFF, DFF}; pg8::StaticOrder S; S.init(MROWS, 2048, F.G, c);
        EpiDown E{F.out, WSP(float, WS_SS2)};
        pg8::gemm_phase<EpiDown, pg8::StaticOrder, true, true>(F.lds + RING_OFF, g, S, E);
        SEAM(8);
    }

    if (IN(9)) { p9_final(F); }
#undef IN
#undef SEAM
}

#ifndef MK_N_LAUNCHES
#define MK_N_LAUNCHES 1
#endif
extern "C" void kernel_launch(void* const* d_in, const int* in_sizes, int n_in, void* d_out, int out_size, void* d_ws, size_t ws_size, hipStream_t stream) {
    static int grid = 0;
    if (grid == 0) {
        if (n_in != 28 || (size_t)out_size != O_END || ws_size < WS_END) { fprintf(stderr, "kernel_launch: unexpected shapes: n_in %d out %d ws %zu (want 28, %zu, >= %zu)\n", n_in, out_size, ws_size, (size_t)O_END, (size_t)WS_END); grid = -1; return; }
        int dev = 0, cus = 0, per_cu = 0;
        if (hipGetDevice(&dev) != hipSuccess || hipDeviceGetAttribute(&cus, hipDeviceAttributeMultiprocessorCount, dev) != hipSuccess) { grid = -1; return; }
        if (hipFuncSetAttribute((const void*)hybrid_fwd, hipFuncAttributeMaxDynamicSharedMemorySize, LDS_BYTES) != hipSuccess) { fprintf(stderr, "kernel_launch: hipFuncSetAttribute failed\n"); grid = -1; return; }
        if (hipOccupancyMaxActiveBlocksPerMultiprocessor(&per_cu, (const void*)hybrid_fwd, 512, LDS_BYTES) != hipSuccess || per_cu < 1) fprintf(stderr, "kernel_launch: occupancy query reports %d\n", per_cu);
        (void)hipGetLastError();
        grid = cus;
        if (grid != 256) fprintf(stderr, "kernel_launch: %d CUs (built for 256)\n", grid);
    }
    if (grid < 0) return;
    (void)hipMemsetAsync((char*)d_ws + WS_CTL, 0, CTL_ZERO_BYTES, stream);
    Args a{};
    for (int i = 0; i < 28; ++i) a.in[i] = d_in[i];
    a.out = (float*)d_out; a.ws = (unsigned char*)d_ws;
    if (MK_N_LAUNCHES == 1) { a.ph_lo = 0; a.ph_hi = NPHASE; hipLaunchKernelGGL(hybrid_fwd, dim3(grid), dim3(512), LDS_BYTES, stream, a); }
    else for (int p = 0; p < NPHASE; ++p) { a.ph_lo = p; a.ph_hi = p + 1; hipLaunchKernelGGL(hybrid_fwd, dim3(grid), dim3(512), LDS_BYTES, stream, a); }
}
```

```cpp
#include <hip/hip_runtime.h>
#include <cstdio>
#include <cstdint>
namespace pg8 {
#define PG8_LAS __attribute__((address_space(3)))
typedef unsigned short bf16_t;
typedef short bf16x8 __attribute__((ext_vector_type(8)));
typedef float f32x4 __attribute__((ext_vector_type(4)));
typedef unsigned u32x4 __attribute__((ext_vector_type(4)));
typedef unsigned u32x2 __attribute__((ext_vector_type(2)));
constexpr int BM = 256, BK = 64, HALF = 128, HTB = HALF * BK * 2  , STAGE_BYTES = 8 * HTB, NXCD = 8, WGM = 8;
__host__ __device__ __forceinline__ int lds_byte(int r, int c) { const int st = (r >> 4) * 2 + (c >> 5), rr = r & 15, cc = c & 31, ob = rr * 64 + cc * 2; return st * 1024 + (ob ^ (((ob >> 9) & 1) << 5)); }
__host__ __device__ __forceinline__ void stage_rc(int b, int& R, int& C) { const int st = b / 1024, sb = b % 1024, swz = sb ^ (((sb >> 9) & 1) << 5); R = (st >> 1) * 16 + swz / 64; C = (st & 1) * 32 + (swz % 64) / 2; }
__host__ __device__ __forceinline__ int perm32(int rho) { const int n = rho >> 4, i = rho & 15; return 8 * (i >> 2) + 4 * n + (i & 3); }

struct Unit { int pm, pn, kofs; };
struct Gemm { const bf16_t* A; const bf16_t* Bt; int lda, ldb, K; };

struct StaticOrder {
    int nM, nN, nwg, G, c;
    __host__ __device__ void init(int M, int N, int G_, int c_) { nM = M / BM; nN = N / BM; nwg = nM * nN; G = G_; c = c_; }
    __host__ __device__ bool next(int i, Unit& u) const {
        const long L = (long)i * G + c; if (L >= nwg) return false;
        int wgid = (int)L; { const int q = nwg / NXCD, r = nwg % NXCD, xcd = wgid % NXCD, off = wgid / NXCD; wgid = (xcd < r ? xcd * (q + 1) : r * (q + 1) + (xcd - r) * q) + off; }
        const int nig = WGM * nN, gid = wgid / nig, fm = gid * WGM, gsz = (nM - fm) < WGM ? (nM - fm) : WGM;
        u.pm = fm + ((wgid % nig) % gsz); u.pn = (wgid % nig) / gsz; u.kofs = 0; return true;
    }
    __device__ __forceinline__ void a_ready(const Unit&) const {}
    __device__ __forceinline__ void done(const Unit&) const {}
};
__device__ __forceinline__ unsigned cvt_pk_bf16(float lo, float hi) { unsigned r; asm volatile("v_cvt_pk_bf16_f32 %0, %1, %2" : "=v"(r) : "v"(lo), "v"(hi)); return r; }
__device__ __forceinline__ float bf_lo(unsigned w) { return __uint_as_float(w << 16); }
__device__ __forceinline__ float bf_hi(unsigned w) { return __uint_as_float(w & 0xffff0000u); }
__device__ __forceinline__ float sigmoidf_(float v) { return __builtin_amdgcn_rcpf(1.0f + __builtin_amdgcn_exp2f(-1.4426950408889634f * v)); }
template <class Epi, class Sched, bool ALIGN_EPI = false, bool SP2 = false>
__device__ __forceinline__ void gemm_phase(PG8_LAS unsigned char* lds, const Gemm g, const Sched& S, const Epi& E) {
    const int tid = threadIdx.x, wid = __builtin_amdgcn_readfirstlane(tid >> 6), lane = tid & 63, wr = wid >> 2, wc = wid & 3, fr = lane & 15, fq = lane >> 4;
    const int nt = g.K / BK, lda = g.lda, ldb = g.ldb;
    unsigned voffA[2], voffB[2];
#pragma unroll
    for (int i = 0; i < 2; ++i) { int R, C; stage_rc(tid * 16 + i * 8192, R, C); const int Rb = Epi::PERM ? ((R & ~31) + perm32(R & 31)) : R;
        voffA[i] = (unsigned)(R * lda + C) * 2u; voffB[i] = (unsigned)(Rb * ldb + C) * 2u; }
    const size_t kstep = (size_t)(BK * 2);
    const size_t hstepA = (size_t)HALF * lda * 2, hstepB = (size_t)HALF * ldb * 2;
    const size_t tstepA = 2 * hstepA, tstepB = 2 * hstepB;
    const unsigned ldsw = (unsigned)wid * 1024u;
    const int aoff = lds_byte(wr * 64 + fr, fq * 8), boff = lds_byte(wc * 32 + fr, fq * 8);
#define PG8_SA(b, h) (((b) * 2 + (h)) * HTB)
#define PG8_SB(b, h) ((4 + (b) * 2 + (h)) * HTB)
#define PG8_STAGE(bufoff, gbase, voff) do { _Pragma("unroll") for (int _i = 0; _i < 2; ++_i) \
        __builtin_amdgcn_global_load_lds((const unsigned*)((const char*)(gbase) + (voff)[_i]), (PG8_LAS unsigned*)(lds + (bufoff) + ldsw + _i * 8192), 16, 0, 0); } while (0)
#define PG8_LDA(dst, b, h) do { _Pragma("unroll") for (int m = 0; m < 4; ++m) _Pragma("unroll") for (int k = 0; k < 2; ++k) dst[m][k] = *(const PG8_LAS bf16x8*)(lds + PG8_SA(b, h) + aoff + m * 2048 + k * 1024); } while (0)
#define PG8_LDB(dst, b, h) do { _Pragma("unroll") for (int n = 0; n < 2; ++n) _Pragma("unroll") for (int k = 0; k < 2; ++k) dst[n][k] = *(const PG8_LAS bf16x8*)(lds + PG8_SB(b, h) + boff + n * 2048 + k * 1024); } while (0)
#define PG8_MMA(ai, bj, At, Bt) do { __builtin_amdgcn_s_setprio(1); _Pragma("unroll") for (int m = 0; m < 4; ++m) _Pragma("unroll") for (int n = 0; n < 2; ++n) _Pragma("unroll") for (int k = 0; k < 2; ++k) \
        acc[ai][bj][m][n] = __builtin_amdgcn_mfma_f32_16x16x32_bf16(Bt[n][k], At[m][k], acc[ai][bj][m][n], 0, 0, 0); __builtin_amdgcn_s_setprio(0); } while (0)
#define PG8_WAIT_V(n) asm volatile("s_waitcnt vmcnt(" #n ")" ::: "memory")
#define PG8_WAIT_L(n) asm volatile("s_waitcnt lgkmcnt(" #n ")" ::: "memory")
#define PG8_BAR __builtin_amdgcn_s_barrier()
#define PG8_SCHED __builtin_amdgcn_sched_barrier(0)
    Unit cur, nxt; int ui = 0;
    if (!S.next(0, cur)) return;
    f32x4 acc[2][2][4][2];
#pragma unroll
    for (int a = 0; a < 2; ++a)
#pragma unroll
        for (int b = 0; b < 2; ++b)
#pragma unroll
            for (int m = 0; m < 4; ++m)
#pragma unroll
                for (int n = 0; n < 2; ++n) acc[a][b][m][n] = (f32x4){0.f, 0.f, 0.f, 0.f};
    bf16x8 At[4][2], B0[2][2], B1[2][2];
    const char* cA = (const char*)g.A + (size_t)cur.pm * tstepA + (size_t)cur.kofs * 2; const char* cB = (const char*)g.Bt + (size_t)cur.pn * tstepB + (size_t)cur.kofs * 2;
    S.a_ready(cur);
    if constexpr (SP2) {
        PG8_STAGE(PG8_SB(0, 0), cB, voffB); PG8_STAGE(PG8_SB(0, 1), cB + hstepB, voffB); PG8_STAGE(PG8_SA(0, 0), cA, voffA); PG8_STAGE(PG8_SA(0, 1), cA + hstepA, voffA);
        if (wr == 1) PG8_BAR;
        PG8_WAIT_V(2); PG8_BAR;
        PG8_STAGE(PG8_SB(1, 0), cB + kstep, voffB); PG8_STAGE(PG8_SA(1, 0), cA + kstep, voffA); PG8_STAGE(PG8_SB(1, 1), cB + hstepB + kstep, voffB);
        PG8_WAIT_V(6); PG8_BAR;
    } else {
        PG8_STAGE(PG8_SB(0, 0), cB, voffB); PG8_STAGE(PG8_SA(0, 0), cA, voffA); PG8_STAGE(PG8_SB(0, 1), cB + hstepB, voffB); PG8_STAGE(PG8_SA(0, 1), cA + hstepA, voffA);
        if (wr == 1) PG8_BAR;
        PG8_WAIT_V(4); PG8_BAR;
        PG8_STAGE(PG8_SB(1, 0), cB + kstep, voffB); PG8_STAGE(PG8_SA(1, 0), cA + kstep, voffA); PG8_STAGE(PG8_SB(1, 1), cB + hstepB + kstep, voffB);
        PG8_WAIT_V(6); PG8_BAR;
    }
    for (;;) {
        const bool has_next = S.next(ui + 1, nxt);
        const char* nA = has_next ? (const char*)g.A + (size_t)nxt.pm * tstepA + (size_t)nxt.kofs * 2 : cA; const char* nB = has_next ? (const char*)g.Bt + (size_t)nxt.pn * tstepB + (size_t)nxt.kofs * 2 : cB;
        for (int t = 0; t < nt; t += 2) {
            const bool last = (t == nt - 2);
            const char* a1 = cA + (size_t)(t + 1) * kstep;
            const char* a2 = last ? nA : cA + (size_t)(t + 2) * kstep; const char* b2 = last ? nB : cB + (size_t)(t + 2) * kstep;
            const char* a3 = a2 + kstep; const char* b3 = b2 + kstep;
            if (last && has_next) S.a_ready(nxt);
            if constexpr (SP2) {
            PG8_LDB(B0, 0, 0); PG8_LDB(B1, 0, 1); PG8_SCHED; PG8_LDA(At, 0, 0); PG8_STAGE(PG8_SA(1, 1), a1 + hstepA, voffA);
            PG8_WAIT_V(8); PG8_WAIT_L(0); PG8_BAR; PG8_MMA(0, 0, At, B0); PG8_MMA(0, 1, At, B1); PG8_BAR; PG8_SCHED;
            PG8_LDA(At, 0, 1); PG8_STAGE(PG8_SB(0, 0), b2, voffB); PG8_STAGE(PG8_SB(0, 1), b2 + hstepB, voffB); PG8_STAGE(PG8_SA(0, 0), a2, voffA);
            PG8_WAIT_V(8); PG8_WAIT_L(0); PG8_BAR; PG8_MMA(1, 0, At, B0); PG8_MMA(1, 1, At, B1); PG8_BAR; PG8_SCHED;
            PG8_LDB(B0, 1, 0); PG8_LDB(B1, 1, 1); PG8_SCHED; PG8_LDA(At, 1, 0); PG8_STAGE(PG8_SA(0, 1), a2 + hstepA, voffA);
            PG8_WAIT_V(8); PG8_WAIT_L(0); PG8_BAR; PG8_MMA(0, 0, At, B0); PG8_MMA(0, 1, At, B1); PG8_BAR; PG8_SCHED;
            PG8_LDA(At, 1, 1); PG8_STAGE(PG8_SB(1, 0), b3, voffB); PG8_STAGE(PG8_SB(1, 1), b3 + hstepB, voffB); PG8_STAGE(PG8_SA(1, 0), a3, voffA);
            PG8_WAIT_V(8); PG8_WAIT_L(0); PG8_BAR; PG8_MMA(1, 0, At, B0); PG8_MMA(1, 1, At, B1); PG8_BAR; PG8_SCHED;
            } else {
            PG8_LDB(B0, 0, 0); PG8_SCHED; PG8_LDA(At, 0, 0); PG8_STAGE(PG8_SA(1, 1), a1 + hstepA, voffA);
            PG8_WAIT_L(8); PG8_BAR; PG8_WAIT_L(0); PG8_MMA(0, 0, At, B0); PG8_BAR; PG8_SCHED;
            PG8_LDB(B1, 0, 1); PG8_STAGE(PG8_SB(0, 0), b2, voffB);
            PG8_BAR; PG8_WAIT_L(0); PG8_MMA(0, 1, At, B1); PG8_BAR;
            PG8_LDA(At, 0, 1); PG8_STAGE(PG8_SA(0, 0), a2, voffA);
            PG8_BAR; PG8_WAIT_L(0); PG8_MMA(1, 0, At, B0); PG8_BAR; PG8_SCHED;
            PG8_STAGE(PG8_SB(0, 1), b2 + hstepB, voffB);
            PG8_WAIT_V(6); PG8_BAR; PG8_MMA(1, 1, At, B1); PG8_BAR;
            PG8_LDB(B0, 1, 0); PG8_SCHED; PG8_LDA(At, 1, 0); PG8_STAGE(PG8_SA(0, 1), a2 + hstepA, voffA);
            PG8_WAIT_L(8); PG8_BAR; PG8_WAIT_L(0); PG8_MMA(0, 0, At, B0); PG8_BAR; PG8_SCHED;
            PG8_LDB(B1, 1, 1); PG8_STAGE(PG8_SB(1, 0), b3, voffB);
            PG8_BAR; PG8_WAIT_L(0); PG8_MMA(0, 1, At, B1); PG8_BAR;
            PG8_LDA(At, 1, 1); PG8_STAGE(PG8_SA(1, 0), a3, voffA);
            PG8_BAR; PG8_WAIT_L(0); PG8_MMA(1, 0, At, B0); PG8_BAR; PG8_SCHED;
            PG8_STAGE(PG8_SB(1, 1), b3 + hstepB, voffB);
            PG8_WAIT_V(6); PG8_BAR; PG8_MMA(1, 1, At, B1); PG8_BAR;
            }
        }
        if constexpr (ALIGN_EPI) { if (wr == 0) PG8_BAR; }
        if constexpr (!Epi::AFTER_DRAIN) { E(acc, cur, wr, wc, fr, fq); S.done(cur); }
        if (!has_next) break;
#pragma unroll
        for (int a = 0; a < 2; ++a)
#pragma unroll
            for (int b = 0; b < 2; ++b)
#pragma unroll
                for (int m = 0; m < 4; ++m)
#pragma unroll
                    for (int n = 0; n < 2; ++n) acc[a][b][m][n] = (f32x4){0.f, 0.f, 0.f, 0.f};
        cur = nxt; cA = nA; cB = nB; ++ui;
        if constexpr (ALIGN_EPI) { if (wr == 1) PG8_BAR; }
    }
    PG8_WAIT_V(0);
    if constexpr (!ALIGN_EPI) { if (wr == 0) PG8_BAR; }
    PG8_BAR;
    if constexpr (Epi::AFTER_DRAIN) { E.fused(acc, cur, wr, wc, fr, fq, lds, wid, lane); S.done(cur); }
#undef PG8_SA
#undef PG8_SB
#undef PG8_STAGE
#undef PG8_LDA
#undef PG8_LDB
#undef PG8_MMA
#undef PG8_WAIT_V
#undef PG8_WAIT_L
#undef PG8_BAR
#undef PG8_SCHED
}
}
#include <hip/hip_bf16.h>
#include <cmath>
namespace attn_body {
using bf16=__hip_bfloat16;
using bf16x8=__attribute__((ext_vector_type(8)))short;
using s16x4=__attribute__((ext_vector_type(4)))short;
using f32x16=__attribute__((ext_vector_type(16)))float;
using u32x4=__attribute__((ext_vector_type(4)))unsigned;
constexpr int BATCH=4,NHEAD=16,SEQ=2048,D=64,DM=NHEAD*D,KP=256;
constexpr int NW=8,QBLK=32,QB=QBLK*NW,KVBLK=64,NQB=SEQ/QB;
constexpr int ATTN_PITCH=DM, ATTN_UNIT_ROWS=QB;
__device__ __forceinline__ int crow(int r,int hi){return (r&3)+8*(r>>2)+4*hi;}
#define SBAR() __builtin_amdgcn_sched_barrier(0)
__device__ __forceinline__ void amask(f32x16&p0,f32x16&p1,unsigned mw){
  #pragma unroll
  for(int r=0;r<16;++r){
    const unsigned m0=(unsigned)__builtin_amdgcn_sbfe((int)mw,r,1), m1=(unsigned)__builtin_amdgcn_sbfe((int)mw,16+r,1);
    p0[r]=__uint_as_float((__float_as_uint(p0[r])&m0)|(0xff800000u&~m0));
    p1[r]=__uint_as_float((__float_as_uint(p1[r])&m1)|(0xff800000u&~m1));}
}
constexpr int NSLOT=3, SLOTB=8192;
constexpr int LDS_K=0, LDS_V=NSLOT*SLOTB, LDS_WS=2*NSLOT*SLOTB, LDS_OST=LDS_WS+NW*64*4, LDS_BYTES=LDS_OST+NW*4096;
constexpr float C2=0.125f*1.4426950408889634f;
__device__ __forceinline__ void glds16(const void*gsrc,unsigned lds_dst){unsigned keep;
  asm volatile("s_mov_b32 %0, m0\n\ts_mov_b32 m0, %2\n\ts_nop 0\n\tglobal_load_lds_dwordx4 %1, off\n\ts_mov_b32 m0, %0":"=&s"(keep):"v"(gsrc),"s"(lds_dst):"memory");}
__device__ __forceinline__ float max3f(float a,float b,float c){float r;asm("v_max3_f32 %0, %1, %2, %3":"=v"(r):"v"(a),"v"(b),"v"(c));return r;}
__device__ __forceinline__ float max2f(float a,float b){float r;asm("v_max_f32_e32 %0, %1, %2":"=v"(r):"v"(a),"v"(b));return r;}
__device__ __forceinline__ float fadd_s(float a,float b){float r;asm("v_add_f32_e32 %0, %1, %2":"=v"(r):"v"(a),"v"(b));return r;}
__device__ __forceinline__ float fsub_s(float a,float b){float r;asm("v_sub_f32_e32 %0, %1, %2":"=v"(r):"v"(a),"v"(b));return r;}
typedef float f32x2_t __attribute__((ext_vector_type(2))); typedef __bf16 bf16x2_t __attribute__((ext_vector_type(2)));
__device__ __forceinline__ unsigned cvtpk_s(float lo,float hi){f32x2_t v={lo,hi};bf16x2_t b=__builtin_convertvector(v,bf16x2_t);return __builtin_bit_cast(unsigned,b);}
#define WAIT_BAR(N) asm volatile("s_waitcnt vmcnt(" #N ") lgkmcnt(0)\n\ts_barrier":::"memory")

__device__ __forceinline__ void qkt(f32x16&p0,f32x16&p1,const char*Kslot,const bf16x8*qr,const f32x16&negm,int r32,int hi){
  const char*kb=Kslot+hi*1024+r32*16;
  #pragma unroll
  for(int d0=0;d0<4;++d0){
    const bf16x8 b0=*reinterpret_cast<const bf16x8*>(kb+d0*2048);
    const bf16x8 b1=*reinterpret_cast<const bf16x8*>(kb+d0*2048+512);
    if(d0==0){p0=__builtin_amdgcn_mfma_f32_32x32x16_bf16(b0,qr[0],negm,0,0,0);p1=__builtin_amdgcn_mfma_f32_32x32x16_bf16(b1,qr[0],negm,0,0,0);}
    else{p0=__builtin_amdgcn_mfma_f32_32x32x16_bf16(b0,qr[d0],p0,0,0,0);p1=__builtin_amdgcn_mfma_f32_32x32x16_bf16(b1,qr[d0],p1,0,0,0);}}
}
typedef __attribute__((address_space(3))) const char* lds_cptr;
typedef short v4i16_t __attribute__((ext_vector_type(4)));
__device__ __forceinline__ void kload8(bf16x8*kf,lds_cptr kp){
  kf[0]=*(const __attribute__((address_space(3))) bf16x8*)(kp);      kf[1]=*(const __attribute__((address_space(3))) bf16x8*)(kp+512);
  kf[2]=*(const __attribute__((address_space(3))) bf16x8*)(kp+2048); kf[3]=*(const __attribute__((address_space(3))) bf16x8*)(kp+2560);
  kf[4]=*(const __attribute__((address_space(3))) bf16x8*)(kp+4096); kf[5]=*(const __attribute__((address_space(3))) bf16x8*)(kp+4608);
  kf[6]=*(const __attribute__((address_space(3))) bf16x8*)(kp+6144); kf[7]=*(const __attribute__((address_space(3))) bf16x8*)(kp+6656);
}
__device__ __forceinline__ void kload2(bf16x8*kf,lds_cptr kp,int j){ kf[2*j]=*(const __attribute__((address_space(3))) bf16x8*)(kp+j*2048); kf[2*j+1]=*(const __attribute__((address_space(3))) bf16x8*)(kp+j*2048+512); }
__device__ __forceinline__ s16x4 vtr(lds_cptr p){ return __builtin_bit_cast(s16x4,__builtin_amdgcn_ds_read_tr16_b64_v4i16((__attribute__((address_space(3))) v4i16_t*)p)); }
__device__ __forceinline__ float rowmax(const f32x16&p0,const f32x16&p1){
  float a=max3f(p0[0],p0[1],p1[0]),b=max3f(p0[2],p0[3],p1[1]);a=max3f(a,p1[2],p1[3]);
  #pragma unroll
  for(int r=4;r<16;r+=4){a=max3f(a,p0[r],p0[r+1]);b=max3f(b,p0[r+2],p0[r+3]);a=max3f(a,p1[r],p1[r+1]);b=max3f(b,p1[r+2],p1[r+3]);}
  const float m=max2f(a,b);
  auto rr=__builtin_amdgcn_permlane32_swap(__float_as_uint(m),__float_as_uint(m),false,false);
  return max2f(__uint_as_float(rr[0]),__uint_as_float(rr[1]));
}
__device__ __forceinline__ void pv(f32x16*o,int vb,bf16x8 pa0,bf16x8 pa1,bf16x8 pa2,bf16x8 pa3){
  #pragma unroll
  for(int d0=0;d0<2;++d0){s16x4 lo[4],hi[4];
    #pragma unroll
    for(int ks=0;ks<4;++ks){
      asm volatile("ds_read_b64_tr_b16 %0,%1 offset:%c2":"=&v"(lo[ks]):"v"(vb),"i"(d0*4096+ks*1024):"memory");
      asm volatile("ds_read_b64_tr_b16 %0,%1 offset:%c2":"=&v"(hi[ks]):"v"(vb),"i"(d0*4096+ks*1024+512):"memory");}
    asm volatile("s_waitcnt lgkmcnt(0)":::"memory");SBAR();
    #define PK(k) (bf16x8){lo[k][0],lo[k][1],lo[k][2],lo[k][3],hi[k][0],hi[k][1],hi[k][2],hi[k][3]}
    o[d0]=__builtin_amdgcn_mfma_f32_32x32x16_bf16(pa0,PK(0),o[d0],0,0,0);
    o[d0]=__builtin_amdgcn_mfma_f32_32x32x16_bf16(pa1,PK(1),o[d0],0,0,0);
    o[d0]=__builtin_amdgcn_mfma_f32_32x32x16_bf16(pa2,PK(2),o[d0],0,0,0);
    o[d0]=__builtin_amdgcn_mfma_f32_32x32x16_bf16(pa3,PK(3),o[d0],0,0,0);
    #undef PK
  }
}

#ifndef ATTN_STORE16
#define ATTN_STORE16(p,v) (*(u32x4*)(p)=(v))
#endif
template<int THRL> __device__ __forceinline__ void attn_unit(int b,int h,int qb,const bf16*Q,const bf16*__restrict__ K,const bf16*__restrict__ V,bf16*O,const unsigned*__restrict__ MG,char*shm,char*mshm){
  const int tid=threadIdx.x,lane=tid&63,r32=lane&31,hi=lane>>5; const int wid=__builtin_amdgcn_readfirstlane(tid>>6);
  const long rowbase=(long)b*SEQ; const int q0=qb*QB;
  const bf16*Qw=Q+(rowbase+q0+wid*QBLK)*DM+h*D;
  const bf16*Kh=K+rowbase*KP+(h>>2)*D,*Vh=V+rowbase*KP+(h>>2)*D;
  const unsigned lds0=(unsigned)(uintptr_t)shm;
  float*wsf=(float*)(shm+LDS_WS)+wid*64;
  const bf16*ksrc=Kh+(long)lane*KP+wid*8;
  const bf16*vsrc=Vh+(long)(16*(wid&3)+(lane>>2))*KP+(wid>>2)*32+(lane&3)*8;
  const unsigned kdst=lds0+LDS_K+wid*1024, vdst=lds0+LDS_V+wid*1024;
  #define DMA_K(t,slot) glds16(ksrc+(long)(t)*KVBLK*KP,(unsigned)__builtin_amdgcn_readfirstlane(kdst+(slot)))
  #define DMA_V(t,slot) glds16(vsrc+(long)(t)*KVBLK*KP,(unsigned)__builtin_amdgcn_readfirstlane(vdst+(slot)))
  const int vb0=(int)(lds0+LDS_V)+((lane>>4)&1)*32+(lane&3)*8+(4*hi+((lane&15)>>2))*64;
  const char*Kbase=shm+LDS_K; bf16x8 kf[8];
  const lds_cptr shm3=(lds_cptr)shm; const lds_cptr kp0=shm3+LDS_K+hi*1024+r32*16; const lds_cptr vp0=shm3+LDS_V+((lane>>4)&1)*32+(lane&3)*8+(4*hi+((lane&15)>>2))*64;
  const int NT=(q0+QB)/KVBLK;
  unsigned*mwv=(unsigned*)(mshm+wid*8192);
  { const u32x4*msrc=(const u32x4*)(MG+(size_t)((b*(SEQ/QBLK))+qb*NW+wid)*2048);
    #pragma unroll
    for(int i=0;i<8;++i){ if(i<=qb){ const u32x4 v_=msrc[i*64+lane]; *(u32x4*)(mwv+(i*64+lane)*4)=v_; } } }
  const unsigned*mldsw=mwv+hi*32+r32;
  asm volatile("s_waitcnt vmcnt(0) lgkmcnt(0)":::"memory");
  DMA_K(0,0);DMA_V(0,0);DMA_K(1,SLOTB);
  bf16x8 qr[4];
  #pragma unroll
  for(int d0=0;d0<4;++d0)qr[d0]=*reinterpret_cast<const bf16x8*>(&Qw[(long)r32*DM+d0*16+hi*8]);
  float mhat=0.f,l_reg=0.f;f32x16 o[2];o[0]=f32x16{};o[1]=f32x16{};const f32x16 negm=f32x16{};
  const int qrel=wid*QBLK+r32;
  #define CMASK(P0,P1,t) do{ _Pragma("unroll") for(int r_=0;r_<16;++r_){P0[r_]-=mhat;P1[r_]-=mhat;} amask(P0,P1,mldsw[(t)*64]); }while(0)
  bool resc=false;
  #define START(P0,P1) do{ const float rm=rowmax(P0,P1); resc=false; \
    { const float dl=(rm<-3.0e38f)?0.f:rm; mhat=fadd_s(mhat,dl); \
      _Pragma("unroll") for(int r=0;r<16;++r){P0[r]=fsub_s(P0[r],dl);P1[r]=fsub_s(P1[r],dl);} \
    } \
    _Pragma("unroll") for(int r=0;r<16;++r)P0[r]=__builtin_amdgcn_exp2f(P0[r]); }while(0)
  #define RESC() do{ if(resc){ asm volatile("s_waitcnt lgkmcnt(0)":::"memory"); \
      _Pragma("unroll") for(int d_=0;d_<2;++d_) _Pragma("unroll") for(int r=0;r<16;++r)o[d_][r]*=wsf[crow(r,hi)]; } }while(0)
  f32x16 pA0,pA1,pB0,pB1;
  int sl_prev=0,sl_cur=0,sl_next=SLOTB;
  #define ROT() do{sl_prev=sl_cur;sl_cur=sl_next;sl_next=(sl_next==(NSLOT-1)*SLOTB)?0:sl_next+SLOTB;}while(0)
  DMA_K(2,2*SLOTB);
  WAIT_BAR(3);
  qkt(pA0,pA1,Kbase,qr,negm,r32,hi);asm volatile("s_nop 15\n\ts_nop 7":"+v"(pA0),"+v"(pA1));CMASK(pA0,pA1,0);
  START(pA0,pA1);
  _Pragma("unroll") for(int r=0;r<16;++r)pA1[r]=__builtin_amdgcn_exp2f(pA1[r]);
  WAIT_BAR(0);
  DMA_K(3,0);DMA_V(1,SLOTB);
  ROT();
  kload8(kf,kp0+sl_cur);
  WAIT_BAR(2);
  s16x4 vlo[8],vhi[8]; u32x4 pw0,pw1,pw2,pw3;
  #define PKW(P,B) cvtpk_s(P[B],P[B+1])
  #define PAF(k) __builtin_bit_cast(bf16x8,pw##k)
  #define VFR(i) (bf16x8){vlo[i][0],vlo[i][1],vlo[i][2],vlo[i][3],vhi[i][0],vhi[i][1],vhi[i][2],vhi[i][3]}
  #define PIN(x) asm volatile("":"+v"(x))
  #define MX3(a,b,c) __builtin_fmaxf(__builtin_fmaxf((a),(b)),(c))
  #define GAPA(MF,A0,A1,A2,A3,W0,W1,PW) do{ MF; sacc+=A0; sacc+=A1; sacc+=A2; sacc+=A3; PIN(sacc); W0; W1; PIN(PW); SBAR(); }while(0)
  #define EX(v) __builtin_amdgcn_exp2f(v)
  #define GAPB(MF,X,B) do{ MF; X[B]=EX(X[B]); X[B+1]=EX(X[B+1]); X[B+2]=EX(X[B+2]); X[B+3]=EX(X[B+3]); PIN(X); SBAR(); }while(0)
  #define VRD(i) do{ vlo[i]=vtr(vp_+(((i)>>2)*4096+((i)&3)*1024)); vhi[i]=vtr(vp_+(((i)>>2)*4096+((i)&3)*1024+512)); }while(0)
  #define KRD(G,j) do{ if(G){ kload2(kf,kp0+sl_next,j); SBAR(); } }while(0)
  #define STEP(C0,C1,P0,P1,t,GK,GV,GL) do{ SBAR(); \
    const lds_cptr vp_=vp0+sl_prev; \
    VRD(0); SBAR(); float sacc=(P0[0]+P0[1]); \
    GAPA(C0=__builtin_amdgcn_mfma_f32_32x32x16_bf16(kf[0],qr[0],f32x16{},0,0,0), P0[2],P0[3],P0[4],P0[5],     pw0[0]=PKW(P0,0), pw0[1]=PKW(P0,2), pw0); \
    VRD(4); SBAR(); GAPA(C1=__builtin_amdgcn_mfma_f32_32x32x16_bf16(kf[1],qr[0],f32x16{},0,0,0), P0[6],P0[7],P0[8],P0[9],     pw0[2]=PKW(P0,4), pw0[3]=PKW(P0,6), pw0); \
    VRD(1); SBAR(); GAPA(C0=__builtin_amdgcn_mfma_f32_32x32x16_bf16(kf[2],qr[1],C0,0,0,0),   P0[10],P0[11],P0[12],P0[13], pw1[0]=PKW(P0,8), pw1[1]=PKW(P0,10), pw1); \
    VRD(5); SBAR(); GAPA(C1=__builtin_amdgcn_mfma_f32_32x32x16_bf16(kf[3],qr[1],C1,0,0,0),   P0[14],P0[15],P1[0],P1[1],   pw1[2]=PKW(P0,12),pw1[3]=PKW(P0,14), pw1); \
    VRD(2); SBAR(); GAPA(C0=__builtin_amdgcn_mfma_f32_32x32x16_bf16(kf[4],qr[2],C0,0,0,0),   P1[2],P1[3],P1[4],P1[5],     pw2[0]=PKW(P1,0), pw2[1]=PKW(P1,2), pw2); \
    VRD(6); SBAR(); GAPA(C1=__builtin_amdgcn_mfma_f32_32x32x16_bf16(kf[5],qr[2],C1,0,0,0),   P1[6],P1[7],P1[8],P1[9],     pw2[2]=PKW(P1,4), pw2[3]=PKW(P1,6), pw2); \
    VRD(3); SBAR(); GAPA(C0=__builtin_amdgcn_mfma_f32_32x32x16_bf16(kf[6],qr[3],C0,0,0,0),   P1[10],P1[11],P1[12],P1[13], pw3[0]=PKW(P1,8), pw3[1]=PKW(P1,10), pw3); \
    VRD(7); SBAR(); GAPA(C1=__builtin_amdgcn_mfma_f32_32x32x16_bf16(kf[7],qr[3],C1,0,0,0),   P1[14],P1[15],0.f,0.f,       pw3[2]=PKW(P1,12),pw3[3]=PKW(P1,14), pw3); \
    l_reg+=sacc; \
    if(GK){DMA_K((t)+3,sl_cur);} if(GV){DMA_V((t)+1,sl_next);} \
    CMASK(C0,C1,t); \
    { float a=MX3(C0[0],C0[1],C1[0]),b=MX3(C0[2],C0[3],C1[1]); a=MX3(a,C1[2],C1[3]); \
      _Pragma("unroll") for(int r=4;r<16;r+=4){a=MX3(a,C0[r],C0[r+1]);b=MX3(b,C0[r+2],C0[r+3]);a=MX3(a,C1[r],C1[r+1]);b=MX3(b,C1[r+2],C1[r+3]);} \
      float rm=__builtin_fmaxf(a,b); { auto rr=__builtin_amdgcn_permlane32_swap(__float_as_uint(rm),__float_as_uint(rm),false,false); rm=__builtin_fmaxf(__uint_as_float(rr[0]),__uint_as_float(rr[1])); } \
      resc=false; \
      if(__builtin_expect(__any(rm>(float)THRL),0)){ const float dl=__builtin_fmaxf(rm,0.f); mhat+=dl; \
        _Pragma("unroll") for(int r=0;r<16;++r){C0[r]-=dl;C1[r]-=dl;} \
        const float f=__builtin_amdgcn_exp2f(-dl); l_reg*=f; if(hi==0)wsf[r32]=f; resc=true; } } \
    SBAR(); \
    GAPB(o[0]=__builtin_amdgcn_mfma_f32_32x32x16_bf16(PAF(0),VFR(0),o[0],0,0,0), C0,0); \
    GAPB(o[1]=__builtin_amdgcn_mfma_f32_32x32x16_bf16(PAF(0),VFR(4),o[1],0,0,0), C0,4); \
    KRD(GL,0); GAPB(o[0]=__builtin_amdgcn_mfma_f32_32x32x16_bf16(PAF(1),VFR(1),o[0],0,0,0), C0,8); \
    KRD(GL,1); GAPB(o[1]=__builtin_amdgcn_mfma_f32_32x32x16_bf16(PAF(1),VFR(5),o[1],0,0,0), C0,12); \
    KRD(GL,2); GAPB(o[0]=__builtin_amdgcn_mfma_f32_32x32x16_bf16(PAF(2),VFR(2),o[0],0,0,0), C1,0); \
    KRD(GL,3); GAPB(o[1]=__builtin_amdgcn_mfma_f32_32x32x16_bf16(PAF(2),VFR(6),o[1],0,0,0), C1,4); \
    GAPB(o[0]=__builtin_amdgcn_mfma_f32_32x32x16_bf16(PAF(3),VFR(3),o[0],0,0,0), C1,8); \
    GAPB(o[1]=__builtin_amdgcn_mfma_f32_32x32x16_bf16(PAF(3),VFR(7),o[1],0,0,0), C1,12); \
    }while(0)
  int t=1;
  for(;t+5<NT;t+=2){
    STEP(pB0,pB1,pA0,pA1,t,true,true,true);     WAIT_BAR(2); RESC(); ROT();
    STEP(pA0,pA1,pB0,pB1,t+1,true,true,true);   WAIT_BAR(2); RESC(); ROT();
  }
  #undef CMASK
  #define CMASK(P0,P1,t) do{ _Pragma("unroll") for(int r_=0;r_<16;++r_){P0[r_]-=mhat;P1[r_]-=mhat;} amask(P0,P1,mldsw[(t)*64]); }while(0)
  #define ENDW(tt) do{ if((tt)+3<NT){WAIT_BAR(2);} else if((tt)+2<NT){WAIT_BAR(1);} else {WAIT_BAR(0);} }while(0)
  for(;t+1<NT;t+=2){
    STEP(pB0,pB1,pA0,pA1,t,(t+3<NT),(t+1<NT),(t+1<NT));       ENDW(t);   RESC(); ROT();
    STEP(pA0,pA1,pB0,pB1,t+1,(t+4<NT),(t+2<NT),(t+2<NT));     ENDW(t+1); RESC(); ROT();
  }
  STEP(pB0,pB1,pA0,pA1,NT-1,false,false,false); RESC();
  { float sacc=pB0[0]+pB0[1]; _Pragma("unroll") for(int r=2;r<16;++r)sacc+=pB0[r]; _Pragma("unroll") for(int r=0;r<16;++r)sacc+=pB1[r]; l_reg+=sacc;
    pw0=(u32x4){PKW(pB0,0),PKW(pB0,2),PKW(pB0,4),PKW(pB0,6)};pw1=(u32x4){PKW(pB0,8),PKW(pB0,10),PKW(pB0,12),PKW(pB0,14)};pw2=(u32x4){PKW(pB1,0),PKW(pB1,2),PKW(pB1,4),PKW(pB1,6)};pw3=(u32x4){PKW(pB1,8),PKW(pB1,10),PKW(pB1,12),PKW(pB1,14)};
    SBAR(); pv(o,vb0+sl_cur,PAF(0),PAF(1),PAF(2),PAF(3)); }
  #undef PKW
  #undef PAF
  #undef VFR
  #undef PIN
  #undef MX3
  #undef GAPA
  #undef GAPB
  #undef EX
  #undef VRD
  #undef KRD
  #undef STEP
  #undef ENDW
  {auto rr=__builtin_amdgcn_permlane32_swap(__float_as_uint(l_reg),__float_as_uint(l_reg),false,false);l_reg=__uint_as_float(rr[0])+__uint_as_float(rr[1]);}
  if(hi==0)wsf[32+r32]=l_reg;asm volatile("s_waitcnt lgkmcnt(0)":::"memory");
  float rli[16];
  #pragma unroll
  for(int r=0;r<16;++r)rli[r]=__builtin_amdgcn_rcpf(wsf[32+crow(r,hi)]);
  bf16*Ow=O+(rowbase+q0+wid*QBLK)*DM+h*D;
  { bf16*stg=(bf16*)(shm+LDS_OST)+wid*2048;
    #pragma unroll
    for(int r=0;r<16;++r){const int orow=crow(r,hi);
      #pragma unroll
      for(int d0=0;d0<2;++d0)stg[orow*64+d0*32+r32]=__float2bfloat16(o[d0][r]*rli[r]);}
    asm volatile("s_waitcnt lgkmcnt(0)":::"memory");
    #pragma unroll
    for(int i=0;i<4;++i){const int row=i*8+(lane>>3),ch=lane&7; const u32x4 v=*(const u32x4*)(stg+row*64+ch*8); ATTN_STORE16(Ow+(long)row*DM+ch*8,v);} }
  asm volatile("s_waitcnt lgkmcnt(0)\n\ts_barrier":::"memory");
  #undef DMA_K
  #undef DMA_V
  #undef CMASK
  #undef START
  #undef RESC
  #undef ROT
}
constexpr int ATTN_LDS_BYTES=LDS_BYTES;
struct AttnTensors { const bf16* Q; const bf16* K; const bf16* V; bf16* O; };
struct AttnUnit { int bh; int qb; };
struct StaticOrder {
  int vcu;
  __device__ __forceinline__ explicit StaticOrder(int grid,int block):vcu((block%8)*(grid/8)+block/8){}
  __device__ __forceinline__ bool next(int i,AttnUnit&u)const{ if(i>=4)return false; const int s=vcu&7; u.bh=vcu>>3; u.qb=(i==0)?s:(i==1)?15-s:(i==2)?16+s:31-s; return true; }
  __device__ __forceinline__ void a_ready(const AttnUnit&)const{}
  __device__ __forceinline__ void done(const AttnUnit&)const{}
};
#undef SBAR
#undef WAIT_BAR
}

constexpr int DM_ = 2048, PB = 4, PT_ = 2048, SB_ = 128, ST_ = 4, NPAGES = 16, PAGE = 128;
constexpr int MP = PB * PT_;
constexpr int MS = SB_ * ST_;
constexpr int MROWS = MP + MS;
constexpr int NIN = 7424;
constexpr int DFF = 5632, DFF2 = 11264;
constexpr float EPS_ = 1e-6f;
constexpr float C2 = 0.125f * 1.4426950408889634f;
constexpr size_t O_YP = 0, O_YS = O_YP + (size_t)MP * DM_, O_KP = O_YS + (size_t)MS * DM_, O_VP = O_KP + (size_t)MP * 256, O_KIP = O_VP + (size_t)MP * 256,
                 O_SRP = O_KIP + (size_t)MP * 64, O_SIP = O_SRP + 4 * 64 * 64, O_CP = O_SIP + 4 * 64 * 64, O_KS = O_CP + (size_t)4 * 2 * DFF2, O_VS = O_KS + (size_t)MS * 256,
                 O_KIS = O_VS + (size_t)MS * 256, O_SRS = O_KIS + (size_t)MS * 64, O_SIS = O_SRS + (size_t)128 * 64 * 64, O_CS = O_SIS + (size_t)128 * 64 * 64, O_END = O_CS + (size_t)128 * 2 * DFF2;
constexpr size_t MiB = 1u << 20;
constexpr size_t WS_CTL = 0, CTL_ZERO_BYTES = 1 * MiB;
constexpr size_t WS_WIN = 1 * MiB, WS_WP = 30 * MiB, WS_WG = 34 * MiB, WS_WO = 42 * MiB, WS_WUP = 50 * MiB, WS_WDN = 94 * MiB;
constexpr size_t WS_XB = 116 * MiB, WS_Q = 150 * MiB, WS_KB = 167 * MiB, WS_VB = 172 * MiB, WS_QI = 177 * MiB, WS_KI = 186 * MiB, WS_WI = 188 * MiB, WS_RS0 = 189 * MiB;
constexpr size_t WS_U = 190 * MiB, WS_SGA = 207 * MiB, WS_SGB = 241 * MiB, WS_Z = 275 * MiB, WS_MRG = 292 * MiB, WS_SS1 = 326 * MiB, WS_SS2 = 328 * MiB;
constexpr size_t WS_MASK = 330 * MiB, WS_LIST = 332 * MiB, WS_SCP = 333 * MiB, WS_SCS = 397 * MiB, WS_UP = 402 * MiB, WS_ACT = 590 * MiB, WS_O = WS_Q  , WS_END = 684 * MiB;
constexpr int SCS_PITCH = 2304;
constexpr int CW_BAR = 4096;
constexpr int CW_QUEUE = 16384;
constexpr int RING_OFF = 0, RING_BYTES = 131072;
constexpr int AMASK_OFF = 86016;
constexpr int MISC_OFF = 151552;
constexpr int LDS_BYTES = 155648;
static_assert(AMASK_OFF >= attn_body::ATTN_LDS_BYTES && AMASK_OFF + 65536 <= MISC_OFF && MISC_OFF + 512 <= LDS_BYTES, "LDS map");

#define GAS __attribute__((address_space(1)))
#define LAS __attribute__((address_space(3)))
typedef unsigned short bf16;
typedef unsigned v4u __attribute__((ext_vector_type(4)));
typedef unsigned v2u __attribute__((ext_vector_type(2)));
typedef float f32x4 __attribute__((ext_vector_type(4)));
typedef float f32x16 __attribute__((ext_vector_type(16)));
typedef short bf16x8 __attribute__((ext_vector_type(8)));
typedef short s16x4 __attribute__((ext_vector_type(4)));
typedef GAS unsigned gu32;
#define RLX_AGENT __ATOMIC_RELAXED, __HIP_MEMORY_SCOPE_AGENT
#define LDS_WAIT() asm volatile("s_waitcnt lgkmcnt(0)" ::: "memory")
#define VM_WAIT() asm volatile("s_waitcnt vmcnt(0)" ::: "memory")
__device__ __forceinline__ unsigned f2bf(float f) { unsigned u = __builtin_bit_cast(unsigned, f); return (u + 0x7fffu + ((u >> 16) & 1u)) >> 16; }
__device__ __forceinline__ unsigned pk2(float lo, float hi) { return pg8::cvt_pk_bf16(lo, hi); }
__device__ __forceinline__ float bflo(unsigned w) { return __uint_as_float(w << 16); }
__device__ __forceinline__ float bfhi(unsigned w) { return __uint_as_float(w & 0xffff0000u); }
using pg8::sigmoidf_;

#define XB_TMO      128
#define XB_XCNT(j)  (256  + 64 * (j))
#define XB_XSUB(j)  (1280 + 64 * (j))
#define XB_XGEN(j)  (2304 + 64 * (j))
#define XB_TOP      3328
#define XB_TOPGEN   3392
#define XCD_BAR_WORDS 3456
#define XB_SPIN_CAP (1u << 18)
__device__ __forceinline__ unsigned xb_ld(unsigned* p)              { return __hip_atomic_load(p, __ATOMIC_RELAXED, __HIP_MEMORY_SCOPE_AGENT); }
__device__ __forceinline__ unsigned xb_add(unsigned* p, unsigned v) { return __hip_atomic_fetch_add(p, v, __ATOMIC_RELAXED, __HIP_MEMORY_SCOPE_AGENT); }
__device__ __forceinline__ unsigned xb_xcc_id() { return (unsigned)__builtin_amdgcn_s_getreg((3 << 11) | 20) & 0xFu; }
#define XB_SPIN(cond, bar) do { unsigned _sp = 0; while (cond) { __builtin_amdgcn_s_sleep(1); \
    if ((++_sp & 255u) == 0u) { if (xb_ld(&(bar)[XB_TMO])) break; if (_sp > XB_SPIN_CAP) { atomicAdd(&(bar)[XB_TMO], 1u); break; } } } } while (0)
struct XcdBarrier { unsigned* bar; unsigned x; volatile LAS unsigned* st; };
__device__ __forceinline__ XcdBarrier xcd_barrier_post(unsigned* bar, volatile LAS unsigned* st) {
    XcdBarrier b; b.bar = bar; b.x = xb_xcc_id(); b.st = st;
    if (threadIdx.x == 0) (void)xb_add(&bar[XB_XCNT(b.x)], 1u);
    return b;
}
__device__ __forceinline__ void xcd_barrier_complete(unsigned* bar, unsigned x, unsigned& nloc, unsigned& nx) {
    const unsigned G = gridDim.x * gridDim.y * gridDim.z;
    unsigned sum, cnt, mine, sp = 0u;
    for (;;) {
        sum = 0u; cnt = 0u; mine = 0u;
#pragma unroll
        for (unsigned j = 0; j < 16; ++j) { const unsigned c = xb_ld(&bar[XB_XCNT(j)]); sum += c; cnt += (c > 0u) ? 1u : 0u; mine = (j == x) ? c : mine; }
        if (sum == G) break;
        __builtin_amdgcn_s_sleep(1);
        if ((++sp & 255u) == 0u) { if (xb_ld(&bar[XB_TMO])) break; if (sp > XB_SPIN_CAP) { atomicAdd(&bar[XB_TMO], 1u); break; } }
    }
    nloc = mine > 0u ? mine : 1u; nx = cnt > 0u ? cnt : 1u;
}
__device__ __forceinline__ void xcd_barrier(const XcdBarrier& b) {
    asm volatile("s_waitcnt vmcnt(0)" ::: "memory");
    __syncthreads();
    if (threadIdx.x == 0) {
        unsigned* bar = b.bar;
        __builtin_amdgcn_s_waitcnt(0);
        unsigned nloc = b.st[0], nx = b.st[1];
        if (nloc == 0u) { xcd_barrier_complete(bar, b.x, nloc, nx); b.st[0] = nloc; b.st[1] = nx; }
        const unsigned old = xb_add(&bar[XB_XSUB(b.x)], 1u);
        const unsigned gen = old / nloc;
        if (old + 1u == (gen + 1u) * nloc) {
            __builtin_amdgcn_fence(__ATOMIC_RELEASE, "agent");
            asm volatile("s_waitcnt vmcnt(0)" ::: "memory");
            const unsigned og = xb_add(&bar[XB_TOP], 1u);
            const unsigned tg = og / nx;
            if (og + 1u == (tg + 1u) * nx) xb_add(&bar[XB_TOPGEN], 1u);
            else XB_SPIN(xb_ld(&bar[XB_TOPGEN]) == tg, bar);
            __builtin_amdgcn_fence(__ATOMIC_ACQUIRE, "agent");
            xb_add(&bar[XB_XGEN(b.x)], 1u);
            asm volatile("s_waitcnt vmcnt(0)" ::: "memory");
        } else {
            XB_SPIN(xb_ld(&bar[XB_XGEN(b.x)]) == gen, bar);
            __builtin_amdgcn_fence(__ATOMIC_ACQUIRE, "agent");
            asm volatile("s_waitcnt vmcnt(0)" ::: "memory");
        }
    }
    __syncthreads();
}

struct Args { const void* in[28]; float* out; unsigned char* ws; int ph_lo, ph_hi, li, qoff; };
struct Frame {
    LAS unsigned char* lds;
    volatile LAS unsigned* MISC;
    gu32* ctl;
    int tid, lane, wave, vcu, G;
    const void* const* in; float* out; unsigned char* ws;
};
#define INF(k) ((const float*)F.in[k])
#define WSP(T, off) ((T*)(F.ws + (off)))
__device__ __forceinline__ float wave_sum(float v) {
#pragma unroll
    for (int o = 1; o < 64; o <<= 1) v += __shfl_xor(v, o);
    return v;
}
__device__ __forceinline__ int queue_pop(Frame& F, int q) {
    __syncthreads();
    if (F.tid == 0) F.MISC[16] = __hip_atomic_fetch_add(F.ctl + CW_QUEUE + 64 * q, 1u, RLX_AGENT);
    __syncthreads();
    return (int)F.MISC[16];
}

using pg8::Unit;
#define EPI_ARGS const f32x4 (&acc)[2][2][4][2], const Unit& u, int wr, int wc, int fr, int fq
__device__ __forceinline__ v4u pack8(f32x4 a, f32x4 b) { v4u w; w.x = pk2(a[0], a[1]); w.y = pk2(a[2], a[3]); w.z = pk2(b[0], b[1]); w.w = pk2(b[2], b[3]); return w; }
__device__ __forceinline__ void unpack8(v4u w, f32x4& a, f32x4& b) { a = (f32x4){bflo(w.x), bfhi(w.x), bflo(w.y), bfhi(w.y)}; b = (f32x4){bflo(w.z), bfhi(w.z), bflo(w.w), bfhi(w.w)}; }
__device__ __forceinline__ f32x4 sig4(f32x4 v) { return (f32x4){sigmoidf_(v[0]), sigmoidf_(v[1]), sigmoidf_(v[2]), sigmoidf_(v[3])}; }

struct EpiIn {
    static constexpr bool PERM = true, AFTER_DRAIN = false;
    bf16 *Q, *KB, *VB, *QI, *KI, *U, *SGA, *SGB; float* WI; const float* RS0; float* out;
    __device__ __forceinline__ void operator()(EPI_ARGS) const {
        const int row0 = u.pm * 256 + wr * 64 + fr, cl = wc * 32 + 8 * fq, pn = u.pn;
        if (pn < 4 || pn == 6 || pn == 7 || (pn >= 9 && pn < 13)) {
            bf16* base; int ldc, colt; float sc = 1.f;
            if (pn < 4) { base = Q; ldc = 1024; colt = pn * 256; sc = C2; } else if (pn < 8) { base = QI; ldc = 512; colt = (pn - 6) * 256; } else { base = U; ldc = 1024; colt = (pn - 9) * 256; }
#pragma unroll
            for (int ai = 0; ai < 2; ++ai)
#pragma unroll
                for (int m = 0; m < 4; ++m) { const int r = row0 + ai * 128 + m * 16; const float s = RS0[r] * sc; bf16* rowp = base + (size_t)r * ldc + colt + cl;
#pragma unroll
                    for (int bj = 0; bj < 2; ++bj) *(v4u*)(rowp + bj * 128) = pack8(acc[ai][bj][m][0] * s, acc[ai][bj][m][1] * s); }
        } else if (pn >= 13) {
            bf16* base = pn < 21 ? SGA : SGB; const int colt = (pn - (pn < 21 ? 13 : 21)) * 256;
#pragma unroll
            for (int ai = 0; ai < 2; ++ai)
#pragma unroll
                for (int m = 0; m < 4; ++m) { const int r = row0 + ai * 128 + m * 16; const float s = RS0[r]; bf16* rowp = base + (size_t)r * 2048 + colt + cl;
#pragma unroll
                    for (int bj = 0; bj < 2; ++bj) *(v4u*)(rowp + bj * 128) = pack8(sig4(acc[ai][bj][m][0] * s), sig4(acc[ai][bj][m][1] * s)); }
        } else if (pn == 4 || pn == 5) {
            bf16* cb = pn == 4 ? KB : VB; float* oP = out + (pn == 4 ? O_KP : O_VP); float* oS = out + (pn == 4 ? O_KS : O_VS);
#pragma unroll
            for (int ai = 0; ai < 2; ++ai)
#pragma unroll
                for (int m = 0; m < 4; ++m) { const int r = row0 + ai * 128 + m * 16; const float s = RS0[r]; float* orow = (r < MP ? oP + (size_t)r * 256 : oS + (size_t)(r - MP) * 256) + cl; bf16* crow_ = cb + (size_t)r * 256 + cl;
#pragma unroll
                    for (int bj = 0; bj < 2; ++bj) { const f32x4 v0 = acc[ai][bj][m][0] * s, v1 = acc[ai][bj][m][1] * s; *(f32x4*)(orow + bj * 128) = v0; *(f32x4*)(orow + bj * 128 + 4) = v1; *(v4u*)(crow_ + bj * 128) = pack8(v0, v1); } }
        } else if (pn == 8) {
            float* oP = out + O_KIP; float* oS = out + O_KIS;
#pragma unroll
            for (int ai = 0; ai < 2; ++ai)
#pragma unroll
                for (int m = 0; m < 4; ++m) { const int r = row0 + ai * 128 + m * 16; const float s = RS0[r]; const f32x4 v0 = acc[ai][0][m][0] * s, v1 = acc[ai][0][m][1] * s;
                    if (cl < 64) { float* orow = (r < MP ? oP + (size_t)r * 64 : oS + (size_t)(r - MP) * 64) + cl; *(f32x4*)orow = v0; *(f32x4*)(orow + 4) = v1; *(v4u*)(KI + (size_t)r * 64 + cl) = pack8(v0, v1); }
                    else if (cl == 64) { *(f32x4*)(WI + (size_t)r * 8) = v0; *(f32x4*)(WI + (size_t)r * 8 + 4) = v1; } }
        }
    }
};
struct EpiGlu {
    static constexpr bool PERM = true, AFTER_DRAIN = false;
    const bf16* SGB; bf16* MRG;
    __device__ __forceinline__ void operator()(EPI_ARGS) const {
        const int row0 = u.pm * 256 + wr * 64 + fr, col = u.pn * 128 + wc * 32 + 8 * fq;
#pragma unroll
        for (int ai = 0; ai < 2; ++ai)
#pragma unroll
            for (int m = 0; m < 4; ++m) { const size_t off = (size_t)(row0 + ai * 128 + m * 16) * 2048 + col; f32x4 g0, g1; unpack8(*(const v4u*)(SGB + off), g0, g1);
                const f32x4 y0 = acc[ai][0][m][0] * sig4(acc[ai][1][m][0]) * g0, y1 = acc[ai][0][m][1] * sig4(acc[ai][1][m][1]) * g1;
                *(v4u*)(MRG + off) = pack8(y0, y1); }
    }
};
struct EpiProj {
    static constexpr bool PERM = true, AFTER_DRAIN = false;
    const bf16* SGA; bf16* MRG;
    __device__ __forceinline__ void operator()(EPI_ARGS) const {
        const int row0 = u.pm * 256 + wr * 64 + fr, col = u.pn * 256 + wc * 32 + 8 * fq;
#pragma unroll
        for (int ai = 0; ai < 2; ++ai)
#pragma unroll
            for (int m = 0; m < 4; ++m)
#pragma unroll
                for (int bj = 0; bj < 2; ++bj) { const size_t off = (size_t)(row0 + ai * 128 + m * 16) * 2048 + col + bj * 128; f32x4 g0, g1, p0, p1; unpack8(*(const v4u*)(SGA + off), g0, g1); unpack8(*(const v4u*)(MRG + off), p0, p1);
                    *(v4u*)(MRG + off) = pack8(p0 + g0 * acc[ai][bj][m][0], p1 + g1 * acc[ai][bj][m][1]); }
    }
};
struct EpiOut {
    static constexpr bool PERM = true, AFTER_DRAIN = false;
    const float *xP, *xS; float* out; bf16* X1B; float* SS1;
    __device__ __forceinline__ void operator()(EPI_ARGS) const {
        const int row0 = u.pm * 256 + wr * 64 + fr, col = u.pn * 256 + wc * 32 + 8 * fq;
#pragma unroll
        for (int ai = 0; ai < 2; ++ai)
#pragma unroll
            for (int m = 0; m < 4; ++m) { const int r = row0 + ai * 128 + m * 16; const float* xrow = (r < MP ? xP + (size_t)r * 2048 : xS + (size_t)(r - MP) * 2048) + col; float* yrow = out + (size_t)r * 2048 + col;
                float ss = 0.f;
#pragma unroll
                for (int bj = 0; bj < 2; ++bj) { const f32x4 v0 = *(const f32x4*)(xrow + bj * 128) + acc[ai][bj][m][0], v1 = *(const f32x4*)(xrow + bj * 128 + 4) + acc[ai][bj][m][1];
                    *(f32x4*)(yrow + bj * 128) = v0; *(f32x4*)(yrow + bj * 128 + 4) = v1; *(v4u*)(X1B + (size_t)r * 2048 + col + bj * 128) = pack8(v0, v1);
                    ss += (v0[0] * v0[0] + v0[1] * v0[1]) + (v0[2] * v0[2] + v0[3] * v0[3]) + (v1[0] * v1[0] + v1[1] * v1[1]) + (v1[2] * v1[2] + v1[3] * v1[3]); }
                ss += __shfl_xor(ss, 16); ss += __shfl_xor(ss, 32);
                if (fq == 0) SS1[(size_t)r * 32 + u.pn * 4 + wc] = ss; }
    }
};
__device__ __forceinline__ float row_rs(const float* part) {
    const f32x4* p = (const f32x4*)part; float s = 0.f;
#pragma unroll
    for (int i = 0; i < 8; ++i) { const f32x4 v = p[i]; s += (v[0] + v[1]) + (v[2] + v[3]); }
    return 1.0f / sqrtf(s * (1.0f / 2048.0f) + EPS_);
}
struct EpiUp {
    static constexpr bool PERM = true, AFTER_DRAIN = false;
    const float* SS1; bf16* UP; float* out;
    __device__ __forceinline__ void operator()(EPI_ARGS) const {
        const int row0 = u.pm * 256 + wr * 64 + fr, cl = wc * 32 + 8 * fq;
#pragma unroll
        for (int ai = 0; ai < 2; ++ai)
#pragma unroll
            for (int m = 0; m < 4; ++m) { const int r = row0 + ai * 128 + m * 16; const float s = row_rs(SS1 + (size_t)r * 32); bf16* rowp = UP + (size_t)r * DFF2 + u.pn * 256 + cl;
                float* cdst = nullptr;
                if (r < MP) { const int t = r & 2047; if (t >= 2046) cdst = out + O_CP + (size_t)((r >> 11) * 2 + (t - 2046)) * DFF2; }
                else { const int t = (r - MP) & 3; if (t >= 2) cdst = out + O_CS + (size_t)(((r - MP) >> 2) * 2 + (t - 2)) * DFF2; }
#pragma unroll
                for (int bj = 0; bj < 2; ++bj) { const f32x4 v0 = acc[ai][bj][m][0] * s, v1 = acc[ai][bj][m][1] * s; *(v4u*)(rowp + bj * 128) = pack8(v0, v1);
                    if (cdst) { float* d = cdst + (bj ? DFF : 0) + u.pn * 128 + cl; *(f32x4*)d = v0; *(f32x4*)(d + 4) = v1; } } }
    }
};
struct EpiDown {
    static constexpr bool PERM = true, AFTER_DRAIN = false;
    float* out; float* SS2;
    __device__ __forceinline__ void operator()(EPI_ARGS) const {
        const int row0 = u.pm * 256 + wr * 64 + fr, col = u.pn * 256 + wc * 32 + 8 * fq;
#pragma unroll
        for (int ai = 0; ai < 2; ++ai)
#pragma unroll
            for (int m = 0; m < 4; ++m) { const int r = row0 + ai * 128 + m * 16; float* yrow = out + (size_t)r * 2048 + col; float ss = 0.f;
#pragma unroll
                for (int bj = 0; bj < 2; ++bj) { const f32x4 v0 = *(const f32x4*)(yrow + bj * 128) + acc[ai][bj][m][0], v1 = *(const f32x4*)(yrow + bj * 128 + 4) + acc[ai][bj][m][1];
                    *(f32x4*)(yrow + bj * 128) = v0; *(f32x4*)(yrow + bj * 128 + 4) = v1;
                    ss += (v0[0] * v0[0] + v0[1] * v0[1]) + (v0[2] * v0[2] + v0[3] * v0[3]) + (v1[0] * v1[0] + v1[1] * v1[1]) + (v1[2] * v1[2] + v1[3] * v1[3]); }
                ss += __shfl_xor(ss, 16); ss += __shfl_xor(ss, 32);
                if (fq == 0) SS2[(size_t)r * 32 + u.pn * 4 + wc] = ss; }
    }
};
struct OrderGlu {
    int c;
    __device__ __forceinline__ bool next(int i, Unit& u) const {
        if (i < 2) { const int x = c & 7, ii = c >> 3; u.pm = 4 * x + (ii >> 3); u.pn = 2 * (ii & 7) + i; u.kofs = 0; return true; }
        if (i < 4 && c < 16) { u.pm = 32 + (c >> 3); u.pn = 2 * (c & 7) + (i - 2); u.kofs = 0; return true; }
        return false; }
    __device__ __forceinline__ void a_ready(const Unit&) const {}
    __device__ __forceinline__ void done(const Unit&) const {}
};
struct OrderProj {
    int c;
    __device__ __forceinline__ bool next(int i, Unit& u) const {
        if (i == 0) { const int x = c & 7, ii = c >> 3; u.pm = 4 * x + (ii >> 3); u.pn = ii & 7; u.kofs = 0; return true; }
        if (i == 1 && c < 16) { u.pm = 32 + (c >> 3); u.pn = c & 7; u.kofs = 0; return true; }
        return false; }
    __device__ __forceinline__ void a_ready(const Unit&) const {}
    __device__ __forceinline__ void done(const Unit&) const {}
};

template <int MAT> __device__ __forceinline__ int colmap(int n) {
    if (MAT == 0) return n < 2120 ? n : (n < 2304 ? -1 : n - 184);
    if (MAT == 2) { const int j = n >> 8, i = n & 255; return i < 128 ? 128 * j + i : 2048 + 128 * j + (i - 128); }
    if (MAT == 4) { const int j = n >> 8, i = n & 255; return i < 128 ? 128 * j + i : DFF + 128 * j + (i - 128); }
    return n;
}
template <int MAT> __device__ __forceinline__ void p0_transpose_item(const float* W, int K, int Nsrc, int Nrows, const float* gain, bf16* WT, LAS float* scr, int item, int lane) {
    const int nblk = Nrows / 64, kb = item / nblk, nb = item % nblk, k0 = 64 * kb, n0 = 64 * nb;
    const int c4 = lane & 15, kr = lane >> 4;
    const int nc = colmap<MAT>(n0 + 4 * c4);
    f32x4 v[16];
#pragma unroll
    for (int i = 0; i < 16; ++i) { const int kk = 4 * i + kr; v[i] = (f32x4){0.f, 0.f, 0.f, 0.f}; if (nc >= 0) v[i] = *(const f32x4*)(W + (size_t)(k0 + kk) * Nsrc + nc); }
#pragma unroll
    for (int i = 0; i < 16; ++i) { const int kk = 4 * i + kr; f32x4 t = v[i]; if (gain) t = t * gain[k0 + kk];
        scr[kk * 65 + 4 * c4 + 0] = t[0]; scr[kk * 65 + 4 * c4 + 1] = t[1]; scr[kk * 65 + 4 * c4 + 2] = t[2]; scr[kk * 65 + 4 * c4 + 3] = t[3]; }
    LDS_WAIT(); asm volatile("" ::: "memory");
    const int c = lane & 7;
#pragma unroll
    for (int j = 0; j < 8; ++j) { const int n = (lane >> 3) + 8 * j; const LAS float* s = scr + (8 * c) * 65 + n;
        v4u o; o.x = pk2(s[0 * 65], s[1 * 65]); o.y = pk2(s[2 * 65], s[3 * 65]); o.z = pk2(s[4 * 65], s[5 * 65]); o.w = pk2(s[6 * 65], s[7 * 65]);
        *(GAS v4u*)(WT + (size_t)(n0 + n) * K + k0 + 8 * c) = o; }
    LDS_WAIT(); asm volatile("" ::: "memory");
}
__device__ __forceinline__ void p0_prologue(Frame& F) {
    LAS float* scr = (LAS float*)(F.lds + RING_OFF + F.wave * 17408);
    const int gw = F.vcu * 8 + F.wave, NGW = F.G * 8;
    constexpr int I0 = 32 * (NIN / 64), I1 = 16 * 32, I2 = 16 * 64, I3 = 32 * 32, I4 = 32 * (DFF2 / 64), I5 = 88 * 32;
    constexpr int NITEMS = I0 + I1 + I2 + I3 + I4 + I5;
    for (int m = gw; m < MROWS; m += NGW) {
        const float* xrow = m < MP ? INF(0) + (size_t)m * 2048 : INF(1) + (size_t)(m - MP) * 2048;
        const GAS f32x4* xr = (const GAS f32x4*)xrow + F.lane; f32x4 v[8]; float s = 0.f;
#pragma unroll
        for (int j = 0; j < 8; ++j) { v[j] = xr[64 * j]; s += (v[j][0] * v[j][0] + v[j][1] * v[j][1]) + (v[j][2] * v[j][2] + v[j][3] * v[j][3]); }
        s = wave_sum(s);
        GAS v2u* o8 = (GAS v2u*)(WSP(bf16, WS_XB) + (size_t)m * 2048) + F.lane;
#pragma unroll
        for (int j = 0; j < 8; ++j) { v2u w; w.x = pk2(v[j][0], v[j][1]); w.y = pk2(v[j][2], v[j][3]); o8[64 * j] = w; }
        if (F.lane == 0) WSP(float, WS_RS0)[m] = 1.0f / sqrtf(s * (1.0f / 2048.0f) + EPS_);
    }
    for (int it = gw; it < NITEMS; it += NGW) {
        int r = it;
        if (r < I0) { p0_transpose_item<0>(INF(10), 2048, 7240, NIN, INF(9), WSP(bf16, WS_WIN), scr, r, F.lane); continue; } r -= I0;
        if (r < I1) { p0_transpose_item<1>(INF(11), 1024, 2048, 2048, nullptr, WSP(bf16, WS_WP), scr, r, F.lane); continue; } r -= I1;
        if (r < I2) { p0_transpose_item<2>(INF(20), 1024, 4096, 4096, nullptr, WSP(bf16, WS_WG), scr, r, F.lane); continue; } r -= I2;
        if (r < I3) { p0_transpose_item<3>(INF(21), 2048, 2048, 2048, nullptr, WSP(bf16, WS_WO), scr, r, F.lane); continue; } r -= I3;
        if (r < I4) { p0_transpose_item<4>(INF(23), 2048, DFF2, DFF2, INF(22), WSP(bf16, WS_WUP), scr, r, F.lane); continue; } r -= I4;
        p0_transpose_item<5>(INF(26), DFF, 2048, 2048, nullptr, WSP(bf16, WS_WDN), scr, r, F.lane);
    }
}

#define MFMA32(a, b, c) __builtin_amdgcn_mfma_f32_32x32x16_bf16((a), (b), (c), 0, 0, 0)
__device__ __forceinline__ s16x4 tr_read(unsigned lds_addr) { s16x4 r; asm volatile("ds_read_b64_tr_b16 %0, %1\n\ts_waitcnt lgkmcnt(0)" : "=&v"(r) : "v"(lds_addr) : "memory"); return r; }
__device__ __forceinline__ float gelu_tanh(float x) {
    const float t = 1.5957691216057308f * (x + 0.044715f * x * x * x);
    return x * sigmoidf_(t);
}
struct S5Const { bf16x8 Bf[2][2]; bf16x8 Cf[8]; bf16x8 Df; float lbr[2], lbi[2]; };
__device__ __forceinline__ void s5_consts(Frame& F, int g, S5Const& C) {
    const int r32 = F.lane & 31, hi = F.lane >> 5;
    const float step = expf(INF(14)[g]);
#pragma unroll
    for (int pg = 0; pg < 2; ++pg) {
        const int p = 32 * pg + r32; const float ar = INF(12)[g * 64 + p], ai = INF(13)[g * 64 + p];
        const float e = expf(ar * step), lr = e * cosf(ai * step), li = e * sinf(ai * step);
        C.lbr[pg] = lr; C.lbi[pg] = li;
        const float den = 1.0f / (ar * ar + ai * ai), cr = ((lr - 1.f) * ar + li * ai) * den, ci = (li * ar - (lr - 1.f) * ai) * den;
        const float* bre = INF(15) + (size_t)(g * 64 + p) * 16 + 8 * hi; const float* bim = INF(16) + (size_t)(g * 64 + p) * 16 + 8 * hi;
#pragma unroll
        for (int j = 0; j < 8; ++j) { const float br = bre[j], bi = bim[j]; C.Bf[pg][0][j] = (short)f2bf(cr * br - ci * bi); C.Bf[pg][1][j] = (short)f2bf(cr * bi + ci * br); }
    }
#pragma unroll
    for (int s = 0; s < 8; ++s)
#pragma unroll
        for (int j = 0; j < 8; ++j) { const int kap = 16 * s + 8 * hi + j, blk = kap >> 5, p = 32 * (blk & 1) + (kap & 31); float v = 0.f;
            if (r32 < 16) v = (blk < 2) ? INF(17)[(size_t)(g * 16 + r32) * 64 + p] : -INF(18)[(size_t)(g * 16 + r32) * 64 + p];
            C.Cf[s][j] = (short)f2bf(v); }
#pragma unroll
    for (int j = 0; j < 8; ++j) C.Df[j] = (short)((r32 < 16 && 8 * hi + j == r32) ? f2bf(INF(19)[g * 16 + r32]) : 0u);
}
__device__ __forceinline__ f32x16 s5_ytile(const f32x16 (&x)[4], const bf16x8& ua, const S5Const& C, LAS unsigned char* img, int lane) {
    const int r32 = lane & 31, hi = lane >> 5;
#pragma unroll
    for (int blk = 0; blk < 4; ++blk)
#pragma unroll
        for (int g4 = 0; g4 < 4; ++g4) { v2u w; w.x = pk2(x[blk][4 * g4], x[blk][4 * g4 + 1]); w.y = pk2(x[blk][4 * g4 + 2], x[blk][4 * g4 + 3]);
            *(LAS v2u*)(img + (32 * blk + r32) * 64 + 8 * (2 * g4 + hi)) = w; }
    LDS_WAIT(); asm volatile("" ::: "memory");
    const unsigned base = (unsigned)(size_t)img;
    const int i16 = lane & 15, q = i16 >> 2, p = i16 & 3, bk = (lane >> 4) & 1;
    f32x16 y = {};
#pragma unroll
    for (int s = 0; s < 8; ++s) {
        const s16x4 lo = tr_read(base + (16 * s + 8 * hi + q) * 64 + 8 * (4 * bk + p));
        const s16x4 hh = tr_read(base + (16 * s + 8 * hi + 4 + q) * 64 + 8 * (4 * bk + p));
        const bf16x8 xa = __builtin_shufflevector(lo, hh, 0, 1, 2, 3, 4, 5, 6, 7);
        y = MFMA32(xa, C.Cf[s], y);
    }
    y = MFMA32(ua, C.Df, y);
    return y;
}
__device__ __forceinline__ void s5_unit(Frame& F, int bp, int g) {
    const int lane = F.lane, w = F.wave, r32 = lane & 31, hi = lane >> 5;
    LAS unsigned char* img = F.lds + w * 8192;
    LAS float* EL = (LAS float*)(F.lds + 65536);
    S5Const C; s5_consts(F, g, C);
    const bf16* U = WSP(bf16, WS_U); bf16* Z = WSP(bf16, WS_Z);
    const int rho = r32, rb = 2 * bp + ((rho >> 2) & 1), rtau = (rho & 3) + 4 * (rho >> 3);
    const bf16* ubase = U + (size_t)(rb * 2048 + 256 * w + rtau) * 1024 + g * 16 + 8 * hi;
    float xr[2] = {0.f, 0.f}, xi[2] = {0.f, 0.f};
    for (int tt = 0; tt < 16; ++tt) {
        const bf16x8 ua = *(const bf16x8*)(ubase + (size_t)tt * 16 * 1024);
        f32x16 acc[4];
#pragma unroll
        for (int blk = 0; blk < 4; ++blk) acc[blk] = MFMA32(ua, C.Bf[blk & 1][blk >> 1], (f32x16){});
#pragma unroll
        for (int pg = 0; pg < 2; ++pg)
#pragma unroll
            for (int r = 0; r < 16; ++r) { const float nr = C.lbr[pg] * xr[pg] - C.lbi[pg] * xi[pg] + acc[pg][r], ni = C.lbr[pg] * xi[pg] + C.lbi[pg] * xr[pg] + acc[2 + pg][r]; xr[pg] = nr; xi[pg] = ni; }
    }
#pragma unroll
    for (int pg = 0; pg < 2; ++pg) { EL[(w * 4 + pg * 2 + 0) * 64 + lane] = xr[pg]; EL[(w * 4 + pg * 2 + 1) * 64 + lane] = xi[pg]; }
    __syncthreads();
#pragma unroll
    for (int pg = 0; pg < 2; ++pg) {
        float pr = C.lbr[pg], pi = C.lbi[pg];
#pragma unroll
        for (int k = 0; k < 8; ++k) { const float nr = pr * pr - pi * pi, ni = 2.f * pr * pi; pr = nr; pi = ni; }
        float cr = 0.f, ci = 0.f;
        for (int ww = 0; ww < w; ++ww) { const float er = EL[(ww * 4 + pg * 2 + 0) * 64 + lane], ei = EL[(ww * 4 + pg * 2 + 1) * 64 + lane];
            const float nr = pr * cr - pi * ci + er, ni = pr * ci + pi * cr + ei; cr = nr; ci = ni; }
        xr[pg] = cr; xi[pg] = ci;
    }
    for (int tt = 0; tt < 16; ++tt) {
        const bf16x8 ua = *(const bf16x8*)(ubase + (size_t)tt * 16 * 1024);
        f32x16 acc[4];
#pragma unroll
        for (int blk = 0; blk < 4; ++blk) acc[blk] = MFMA32(ua, C.Bf[blk & 1][blk >> 1], (f32x16){});
#pragma unroll
        for (int pg = 0; pg < 2; ++pg)
#pragma unroll
            for (int r = 0; r < 16; ++r) { const float nr = C.lbr[pg] * xr[pg] - C.lbi[pg] * xi[pg] + acc[pg][r], ni = C.lbr[pg] * xi[pg] + C.lbi[pg] * xr[pg] + acc[2 + pg][r]; xr[pg] = nr; xi[pg] = ni; acc[pg][r] = nr; acc[2 + pg][r] = ni; }
        const f32x16 y = s5_ytile(acc, ua, C, img, lane);
        if (r32 < 16) {
#pragma unroll
            for (int r = 0; r < 16; ++r) { const int orho = (r & 3) + 8 * (r >> 2) + 4 * hi, ob = 2 * bp + ((orho >> 2) & 1), otau = (orho & 3) + 4 * (orho >> 3);
                Z[(size_t)(ob * 2048 + 256 * w + 16 * tt + otau) * 1024 + g * 16 + r32] = (bf16)f2bf(gelu_tanh(y[r])); }
        }
        LDS_WAIT(); asm volatile("" ::: "memory");
    }
    if (w == 7) {
#pragma unroll
        for (int pg = 0; pg < 2; ++pg) { const size_t o = (size_t)((2 * bp + hi) * 64 + g) * 64 + 32 * pg + r32; F.out[O_SRP + o] = xr[pg]; F.out[O_SIP + o] = xi[pg]; }
    }
    {
        const int T = 8 * bp + w;
        const bf16x8 ua = *(const bf16x8*)(U + (size_t)(MP + 32 * T + r32) * 1024 + g * 16 + 8 * hi);
        f32x16 acc[4];
#pragma unroll
        for (int blk = 0; blk < 4; ++blk) acc[blk] = MFMA32(ua, C.Bf[blk & 1][blk >> 1], (f32x16){});
#pragma unroll
        for (int pg = 0; pg < 2; ++pg)
#pragma unroll
            for (int k4 = 0; k4 < 4; ++k4) { const size_t so = (size_t)((8 * T + 2 * k4 + hi) * 64 + g) * 64 + 32 * pg + r32; float sr = INF(5)[so], si = INF(6)[so];
#pragma unroll
                for (int t = 0; t < 4; ++t) { const int r = 4 * k4 + t; const float nr = C.lbr[pg] * sr - C.lbi[pg] * si + acc[pg][r], ni = C.lbr[pg] * si + C.lbi[pg] * sr + acc[2 + pg][r]; sr = nr; si = ni; acc[pg][r] = nr; acc[2 + pg][r] = ni; }
                F.out[O_SRS + so] = sr; F.out[O_SIS + so] = si; }
        const f32x16 y = s5_ytile(acc, ua, C, img, lane);
        if (r32 < 16) {
#pragma unroll
            for (int r = 0; r < 16; ++r) { const int orho = (r & 3) + 8 * (r >> 2) + 4 * hi; Z[(size_t)(MP + 32 * T + orho) * 1024 + g * 16 + r32] = (bf16)f2bf(gelu_tanh(y[r])); }
        }
        LDS_WAIT();
    }
    __syncthreads();
}

__device__ __forceinline__ unsigned wave_incl_scan(unsigned v, int lane) {
#pragma unroll
    for (int o = 1; o < 64; o <<= 1) { const unsigned t = __shfl_up(v, o); if (lane >= o) v += t; }
    return v;
}
__device__ __forceinline__ unsigned fkey(float f) { const unsigned u = __float_as_uint(f); return (u & 0x80000000u) ? ~u : (u | 0x80000000u); }
template <int MODE> __device__ __forceinline__ void select_query(const float* row, int n_valid, LAS unsigned* hist  , LAS unsigned* mwords  , unsigned* mout, int q32, unsigned* list, int lane) {
    constexpr int NJ = MODE == 0 ? 8 : 9;
    const int L = (n_valid + 255) >> 8;
    unsigned key[NJ][4];
#pragma unroll
    for (int j = 0; j < NJ; ++j) {
        f32x4 v = {0.f, 0.f, 0.f, 0.f};
        if (j < L) v = *(const f32x4*)(row + 256 * j + 4 * lane);
#pragma unroll
        for (int i = 0; i < 4; ++i) { const int kv = 256 * j + 4 * lane + i; key[j][i] = (j < L && kv < n_valid) ? fkey(v[i]) : 0u; }
    }
    unsigned T = 0u, need = 256u; bool all = (n_valid <= 256);
    if (!all) {
#pragma unroll 1
        for (int lvl = 3; lvl >= 0; --lvl) {
            const int sh = 8 * lvl;
            hist[lane] = 0u; hist[64 + lane] = 0u; hist[128 + lane] = 0u; hist[192 + lane] = 0u;
            LDS_WAIT();
            const unsigned pmask = lvl == 3 ? 0u : (0xffffffffu << (sh + 8));
#pragma unroll
            for (int j = 0; j < NJ; ++j) if (j < L) {
#pragma unroll
                for (int i = 0; i < 4; ++i) { const unsigned k = key[j][i]; if (k != 0u && ((k ^ T) & pmask) == 0u) __hip_atomic_fetch_add(&hist[(k >> sh) & 255u], 1u, __ATOMIC_RELAXED, __HIP_MEMORY_SCOPE_WORKGROUP); } }
            LDS_WAIT();
            const unsigned c0 = hist[4 * lane], c1 = hist[4 * lane + 1], c2 = hist[4 * lane + 2], c3 = hist[4 * lane + 3];
            const unsigned tl = c0 + c1 + c2 + c3, incl = wave_incl_scan(tl, lane), tot = __shfl(incl, 63);
            unsigned run = tot - incl;
            int fb = -1; unsigned fab = 0u;
            if (run < need && need <= run + c3) { fb = 4 * lane + 3; fab = run; } run += c3;
            if (fb < 0 && run < need && need <= run + c2) { fb = 4 * lane + 2; fab = run; } run += c2;
            if (fb < 0 && run < need && need <= run + c1) { fb = 4 * lane + 1; fab = run; } run += c1;
            if (fb < 0 && run < need && need <= run + c0) { fb = 4 * lane + 0; fab = run; }
            const unsigned long long bal = __ballot(fb >= 0);
            const int src = bal ? (int)__builtin_ctzll(bal) : 0;
            const int bsel = __shfl(fb, src); const unsigned above = __shfl(fab, src);
            T |= ((unsigned)(bsel < 0 ? 0 : bsel)) << sh; need -= above;
            LDS_WAIT();
        }
    }
    unsigned eqtot = 0u;
    if (!all) { unsigned c = 0u;
#pragma unroll
        for (int j = 0; j < NJ; ++j)
#pragma unroll
            for (int i = 0; i < 4; ++i) c += (key[j][i] == T) ? 1u : 0u;
        eqtot = __shfl(wave_incl_scan(c, lane), 63); }
    const bool ties = !all && eqtot != need;
    unsigned nib[NJ]; unsigned ebase = 0u;
#pragma unroll
    for (int j = 0; j < NJ; ++j) {
        unsigned nb = 0u;
        if (all) {
#pragma unroll
            for (int i = 0; i < 4; ++i) nb |= (key[j][i] != 0u) ? (1u << i) : 0u;
        } else if (!ties) {
#pragma unroll
            for (int i = 0; i < 4; ++i) nb |= (key[j][i] >= T && key[j][i] != 0u) ? (1u << i) : 0u;
        } else {
            unsigned cnt = 0u;
#pragma unroll
            for (int i = 0; i < 4; ++i) cnt += (key[j][i] == T) ? 1u : 0u;
            const unsigned incl = wave_incl_scan(cnt, lane); unsigned run = ebase + incl - cnt; ebase += __shfl(incl, 63);
#pragma unroll
            for (int i = 0; i < 4; ++i) { const bool e = key[j][i] == T; if (key[j][i] > T || (e && run < need)) nb |= 1u << i; run += e ? 1u : 0u; }
        }
        nib[j] = nb;
    }
    if (MODE == 0) {
        mwords[lane] = 0u; LDS_WAIT();
#pragma unroll
        for (int j = 0; j < 8; ++j) if (nib[j]) __hip_atomic_fetch_or(&mwords[(lane & 1) * 32 + 4 * j + (lane >> 4)], nib[j] << (4 * ((lane & 15) >> 1)), __ATOMIC_RELAXED, __HIP_MEMORY_SCOPE_WORKGROUP);
        LDS_WAIT();
        const unsigned wv = mwords[lane];
        mout[((lane & 31) * 2 + (lane >> 5)) * 32 + q32] = wv;
        LDS_WAIT();
    } else {
        unsigned base = 0u;
#pragma unroll
        for (int j = 0; j < NJ; ++j) { const unsigned cnt = __builtin_popcount(nib[j]); const unsigned incl = wave_incl_scan(cnt, lane); unsigned pos = base + incl - cnt; base += __shfl(incl, 63);
#pragma unroll
            for (int i = 0; i < 4; ++i) if ((nib[j] >> i) & 1u) { if (pos < 256u) list[pos] = (unsigned)(256 * j + 4 * lane + i); ++pos; } }
    }
}
__device__ __forceinline__ float dpp_sum8(float v) {
    v += __uint_as_float(__builtin_amdgcn_update_dpp(0u, __float_as_uint(v), 0xB1, 0xf, 0xf, true));
    v += __uint_as_float(__builtin_amdgcn_update_dpp(0u, __float_as_uint(v), 0x4E, 0xf, 0xf, true));
    v += __uint_as_float(__builtin_amdgcn_update_dpp(0u, __float_as_uint(v), 0x141, 0xf, 0xf, true));
    return v;
}
__device__ __forceinline__ float dpp_sum16(float v) {
    v = dpp_sum8(v);
    v += __uint_as_float(__builtin_amdgcn_update_dpp(0u, __float_as_uint(v), 0x140, 0xf, 0xf, true));
    return v;
}
__device__ __forceinline__ float dpp_max16(float v) {
    v = fmaxf(v, __uint_as_float(__builtin_amdgcn_update_dpp(0u, __float_as_uint(v), 0xB1, 0xf, 0xf, true)));
    v = fmaxf(v, __uint_as_float(__builtin_amdgcn_update_dpp(0u, __float_as_uint(v), 0x4E, 0xf, 0xf, true)));
    v = fmaxf(v, __uint_as_float(__builtin_amdgcn_update_dpp(0u, __float_as_uint(v), 0x141, 0xf, 0xf, true)));
    v = fmaxf(v, __uint_as_float(__builtin_amdgcn_update_dpp(0u, __float_as_uint(v), 0x140, 0xf, 0xf, true)));
    return v;
}
constexpr float IDX_SCALE = 0.125f * 0.35355339059327373f;
constexpr int QIL_PITCH = 1040;
__device__ __forceinline__ void idx_unit_prompt(Frame& F, int b, int qb) {
    const int lane = F.lane, w = F.wave, r32 = lane & 31, hi = lane >> 5;
    const int R0 = b * 2048 + 32 * qb;
    const bf16* QI = WSP(bf16, WS_QI); const bf16* KI = WSP(bf16, WS_KI); float* SC = WSP(float, WS_SCP);
    LAS unsigned char* qil = F.lds;
    LAS unsigned* hist = (LAS unsigned*)(F.lds + 40960) + w * 256;
    LAS unsigned* mw = (LAS unsigned*)(F.lds + 49152) + w * 64;
    { const int row = F.tid >> 4, ch = F.tid & 15; const v4u* src = (const v4u*)(QI + (size_t)(R0 + row) * 512) + ch * 4;
#pragma unroll
      for (int i = 0; i < 4; ++i) *(LAS v4u*)(qil + row * QIL_PITCH + (ch * 4 + i) * 16) = src[i]; }
    float wq[8];
    { const f32x4 a = *(const f32x4*)(WSP(float, WS_WI) + (size_t)(R0 + r32) * 8), c = *(const f32x4*)(WSP(float, WS_WI) + (size_t)(R0 + r32) * 8 + 4);
#pragma unroll
      for (int h = 0; h < 4; ++h) { wq[h] = a[h] * IDX_SCALE; wq[4 + h] = c[h] * IDX_SCALE; } }
    __syncthreads();
    for (int kb = w; kb <= qb; kb += 8) {
        bf16x8 af[4];
#pragma unroll
        for (int ks = 0; ks < 4; ++ks) af[ks] = *(const bf16x8*)(KI + (size_t)(b * 2048 + 32 * kb + r32) * 64 + 16 * ks + 8 * hi);
        f32x16 sc = {};
#pragma unroll 1
        for (int h = 0; h < 8; ++h) {
            f32x16 acc = {}; const float wqh = wq[h];
#pragma unroll
            for (int ks = 0; ks < 4; ++ks) { const bf16x8 bfr = *(const LAS bf16x8*)(qil + r32 * QIL_PITCH + h * 128 + ks * 32 + hi * 16); acc = MFMA32(af[ks], bfr, acc); }
#pragma unroll
            for (int r = 0; r < 16; ++r) sc[r] += fmaxf(acc[r], 0.f) * wqh;
        }
#pragma unroll
        for (int k4 = 0; k4 < 4; ++k4) *(f32x4*)(SC + (size_t)(R0 + r32) * 2048 + 32 * kb + 8 * k4 + 4 * hi) = (f32x4){sc[4 * k4], sc[4 * k4 + 1], sc[4 * k4 + 2], sc[4 * k4 + 3]};
    }
    VM_WAIT(); __syncthreads();
    unsigned* mout = WSP(unsigned, WS_MASK) + (size_t)(b * 64 + qb) * 2048;
    for (int qq = w; qq < 32; qq += 8) select_query<0>(SC + (size_t)(R0 + qq) * 2048, 32 * qb + qq + 1, hist, mw, mout, qq, nullptr, lane);
    __syncthreads();
}
__device__ __forceinline__ void idx_unit_sample(Frame& F, int b) {
    const int lane = F.lane, w = F.wave, r32 = lane & 31, hi = lane >> 5, t = r32 >> 3, h = r32 & 7;
    const bf16* QI = WSP(bf16, WS_QI); const bf16* KI = WSP(bf16, WS_KI); float* SC = WSP(float, WS_SCS);
    LAS unsigned* hist = (LAS unsigned*)(F.lds + 40960) + w * 256;
    const int* PTB = (const int*)F.in[8] + b * 16;
    bf16x8 bfr[4];
#pragma unroll
    for (int ks = 0; ks < 4; ++ks) bfr[ks] = *(const bf16x8*)(QI + (size_t)(MP + 4 * b + t) * 512 + h * 64 + 16 * ks + 8 * hi);
    const float wq = WSP(float, WS_WI)[(size_t)(MP + 4 * b + t) * 8 + h] * IDX_SCALE;
    for (int kb = w; kb < 65; kb += 8) {
        bf16x8 af[4];
        if (kb < 64) {
            const int kv = 32 * kb + r32, page = PTB[kv >> 7];
            const float* src = INF(4) + ((size_t)page * 128 + (kv & 127)) * 64 + 8 * hi;
#pragma unroll
            for (int ks = 0; ks < 4; ++ks) { const f32x4 a = *(const f32x4*)(src + 16 * ks), c = *(const f32x4*)(src + 16 * ks + 4); const v4u pk = pack8(a, c); af[ks] = __builtin_bit_cast(bf16x8, pk); }
        } else {
#pragma unroll
            for (int ks = 0; ks < 4; ++ks) { v4u z = {0u, 0u, 0u, 0u}; if (r32 < 4) z = *(const v4u*)(KI + (size_t)(MP + 4 * b + r32) * 64 + 16 * ks + 8 * hi); af[ks] = __builtin_bit_cast(bf16x8, z); }
        }
        f32x16 acc = {};
#pragma unroll
        for (int ks = 0; ks < 4; ++ks) acc = MFMA32(af[ks], bfr[ks], acc);
        float v[16];
#pragma unroll
        for (int r = 0; r < 16; ++r) v[r] = dpp_sum8(fmaxf(acc[r], 0.f) * wq);
        f32x4 o = {v[0], v[1], v[2], v[3]};
        if (h == 1) o = (f32x4){v[4], v[5], v[6], v[7]}; else if (h == 2) o = (f32x4){v[8], v[9], v[10], v[11]}; else if (h == 3) o = (f32x4){v[12], v[13], v[14], v[15]};
        if (h < 4) *(f32x4*)(SC + (size_t)(4 * b + t) * SCS_PITCH + 32 * kb + 8 * h + 4 * hi) = o;
    }
    VM_WAIT(); __syncthreads();
    if (w < 4) select_query<1>(SC + (size_t)(4 * b + w) * SCS_PITCH, 2049 + w, hist, nullptr, nullptr, 0, WSP(unsigned, WS_LIST) + (size_t)(4 * b + w) * 256, lane);
    __syncthreads();
}

__device__ __forceinline__ void sattn_unit(Frame& F, int b, int t) {
    const int lane = F.lane, w = F.wave, n = lane >> 4, d4 = lane & 15;
    const int rs = 4 * b + t, row = MP + rs;
    const bf16* Q = WSP(bf16, WS_Q);
    LAS float* xm = (LAS float*)(F.lds);
    LAS float* xs = (LAS float*)(F.lds + 512);
    LAS float* pl = (LAS float*)(F.lds + 1024) + w * 512;
    LAS float* ored = (LAS float*)(F.lds + 1024 + 16384);
    float qv[4][4];
#pragma unroll
    for (int j = 0; j < 4; ++j) { const v2u qw = *(const v2u*)(Q + (size_t)row * 1024 + (4 * n + j) * 64 + 4 * d4); qv[j][0] = bflo(qw.x); qv[j][1] = bfhi(qw.x); qv[j][2] = bflo(qw.y); qv[j][3] = bfhi(qw.y); }
    const unsigned kvl = WSP(unsigned, WS_LIST)[(size_t)rs * 256 + 32 * w + (lane & 31)];
    const int page = ((const int*)F.in[8])[b * 16 + ((kvl < 2048u ? kvl : 0u) >> 7)];
    const unsigned long long coff = ((unsigned long long)page * 128ull + (kvl & 127u)) * 256ull;
    const unsigned long long noff = (unsigned long long)(4 * b + (int)(kvl < 2048u ? 0u : kvl - 2048u)) * 256ull;
    const bool isnew = kvl >= 2048u;
    float sv[4][2];
#pragma unroll
    for (int j = 0; j < 4; ++j) { sv[j][0] = 0.f; sv[j][1] = 0.f; }
#pragma unroll 1
    for (int half = 0; half < 2; ++half) {
        f32x4 kvec[16];
#pragma unroll
        for (int k = 0; k < 16; ++k) { const int e = 16 * half + k; const bool nw = __shfl((int)isnew, e) != 0; const unsigned long long o = nw ? __shfl(noff, e) : __shfl(coff, e);
            const float* base = nw ? (F.out + O_KS) : INF(2); kvec[k] = *(const f32x4*)(base + o + 4 * lane); }
#pragma unroll
        for (int k = 0; k < 16; ++k)
#pragma unroll
            for (int j = 0; j < 4; ++j) { float p = qv[j][0] * kvec[k][0] + qv[j][1] * kvec[k][1] + qv[j][2] * kvec[k][2] + qv[j][3] * kvec[k][3]; p = dpp_sum16(p); if (d4 == k) { if (half == 0) sv[j][0] = p; else sv[j][1] = p; } }
    }
    float mj[4], sj[4];
#pragma unroll
    for (int j = 0; j < 4; ++j) { mj[j] = dpp_max16(fmaxf(sv[j][0], sv[j][1])); if (d4 == 0) xm[w * 16 + 4 * n + j] = mj[j]; }
    __syncthreads();
#pragma unroll
    for (int j = 0; j < 4; ++j) { float m = xm[4 * n + j];
#pragma unroll
        for (int ww = 1; ww < 8; ++ww) m = fmaxf(m, xm[ww * 16 + 4 * n + j]);
        const float p0 = __builtin_amdgcn_exp2f(sv[j][0] - m), p1 = __builtin_amdgcn_exp2f(sv[j][1] - m);
        pl[d4 * 16 + 4 * n + j] = p0; pl[(16 + d4) * 16 + 4 * n + j] = p1;
        sj[j] = dpp_sum16(p0 + p1); if (d4 == 0) xs[w * 16 + 4 * n + j] = sj[j]; }
    LDS_WAIT();
    float o[4][4] = {};
#pragma unroll 1
    for (int half = 0; half < 2; ++half) {
        f32x4 vvec[16];
#pragma unroll
        for (int k = 0; k < 16; ++k) { const int e = 16 * half + k; const bool nw = __shfl((int)isnew, e) != 0; const unsigned long long of = nw ? __shfl(noff, e) : __shfl(coff, e);
            const float* base = nw ? (F.out + O_VS) : INF(3); vvec[k] = *(const f32x4*)(base + of + 4 * lane); }
#pragma unroll
        for (int k = 0; k < 16; ++k) { const f32x4 pj = *(const LAS f32x4*)(pl + (16 * half + k) * 16 + 4 * n);
#pragma unroll
            for (int j = 0; j < 4; ++j)
#pragma unroll
                for (int c = 0; c < 4; ++c) o[j][c] += pj[j] * vvec[k][c]; }
    }
#pragma unroll
    for (int j = 0; j < 4; ++j)
#pragma unroll
        for (int c = 0; c < 4; ++c) ored[(w * 16 + j * 4 + c) * 64 + lane] = o[j][c];
    __syncthreads();
    {
        const int part = w, j = part >> 1, c0 = 2 * (part & 1);
        float tot = 0.f;
#pragma unroll
        for (int ww = 0; ww < 8; ++ww) tot += xs[ww * 16 + 4 * n + j];
        float a0 = 0.f, a1 = 0.f;
#pragma unroll
        for (int ww = 0; ww < 8; ++ww) { a0 += ored[(ww * 16 + j * 4 + c0) * 64 + lane]; a1 += ored[(ww * 16 + j * 4 + c0 + 1) * 64 + lane]; }
        const float inv = 1.0f / tot;
        *(unsigned*)(WSP(bf16, WS_O) + (size_t)row * 1024 + (4 * n + j) * 64 + 4 * d4 + c0) = pk2(a0 * inv, a1 * inv);
    }
    __syncthreads();
}

__device__ __forceinline__ void p7_convgate(Frame& F) {
    const int gw = F.vcu * 8 + F.wave, NGW = F.G * 8;
    const bf16* UP = WSP(bf16, WS_UP); bf16* ACT = WSP(bf16, WS_ACT);
    const float* cw = INF(24); const float* cb = INF(25); const float* cst = INF(7);
    for (int it = gw; it < (MROWS / 32) * 11; it += NGW) {
        const int rb = it / 11, cg = it % 11, c = cg * 512 + F.lane * 8;
        const size_t ucol = (size_t)(c >> 7) * 256 + (c & 127);
        float wg[3][8], wv[3][8], bg[8], bv[8];
#pragma unroll
        for (int j = 0; j < 3; ++j)
#pragma unroll
            for (int e = 0; e < 8; ++e) { wg[j][e] = cw[(size_t)j * DFF2 + c + e]; wv[j][e] = cw[(size_t)j * DFF2 + DFF + c + e]; }
#pragma unroll
        for (int e = 0; e < 8; ++e) { bg[e] = cb[c + e]; bv[e] = cb[DFF + c + e]; }
        f32x4 g2[2], g1[2], v2[2], v1[2];
        const int r0 = rb * 32;
#define loadrow(r_, g_, v_) do { const v4u a_ = *(const v4u*)(UP + (size_t)(r_) * DFF2 + ucol), bb_ = *(const v4u*)(UP + (size_t)(r_) * DFF2 + ucol + 128); unpack8(a_, g_[0], g_[1]); unpack8(bb_, v_[0], v_[1]); } while (0)
        if (r0 < MP && (r0 & 2047) != 0) { loadrow(r0 - 2, g2, v2); loadrow(r0 - 1, g1, v1); }
        else { g2[0] = g2[1] = g1[0] = g1[1] = v2[0] = v2[1] = v1[0] = v1[1] = (f32x4){0.f, 0.f, 0.f, 0.f}; }
        for (int rr = 0; rr < 32; ++rr) {
            const int r = r0 + rr;
            if (r >= MP && ((r - MP) & 3) == 0) {
                const float* s0 = cst + (size_t)((r - MP) >> 2) * 2 * DFF2; const float* s1 = s0 + DFF2;
                g2[0] = *(const f32x4*)(s0 + c); g2[1] = *(const f32x4*)(s0 + c + 4); v2[0] = *(const f32x4*)(s0 + DFF + c); v2[1] = *(const f32x4*)(s0 + DFF + c + 4);
                g1[0] = *(const f32x4*)(s1 + c); g1[1] = *(const f32x4*)(s1 + c + 4); v1[0] = *(const f32x4*)(s1 + DFF + c); v1[1] = *(const f32x4*)(s1 + DFF + c + 4);
            }
            f32x4 g0[2], v0[2]; loadrow(r, g0, v0);
            float o[8];
#pragma unroll
            for (int e = 0; e < 8; ++e) { const int hh = e >> 2, ee = e & 3;
                const float gm = bg[e] + wg[0][e] * g2[hh][ee] + wg[1][e] * g1[hh][ee] + wg[2][e] * g0[hh][ee];
                const float vm = bv[e] + wv[0][e] * v2[hh][ee] + wv[1][e] * v1[hh][ee] + wv[2][e] * v0[hh][ee];
                o[e] = gm * sigmoidf_(gm) * vm; }
            v4u ow; ow.x = pk2(o[0], o[1]); ow.y = pk2(o[2], o[3]); ow.z = pk2(o[4], o[5]); ow.w = pk2(o[6], o[7]);
            *(v4u*)(ACT + (size_t)r * DFF + c) = ow;
            g2[0] = g1[0]; g2[1] = g1[1]; v2[0] = v1[0]; v2[1] = v1[1]; g1[0] = g0[0]; g1[1] = g0[1]; v1[0] = v0[0]; v1[1] = v0[1];
        }
    }
}
#undef loadrow
__device__ __forceinline__ void p9_final(Frame& F) {
    const int gw = F.vcu * 8 + F.wave, NGW = F.G * 8;
    const float* gf = INF(27); const float* SS2 = WSP(float, WS_SS2);
    for (int m = gw; m < MROWS; m += NGW) {
        const float rs = row_rs(SS2 + (size_t)m * 32);
        GAS f32x4* yr = (GAS f32x4*)(F.out + (size_t)m * 2048) + F.lane; const f32x4* gr = (const f32x4*)gf + F.lane;
#pragma unroll
        for (int j = 0; j < 8; ++j) { const f32x4 v = yr[64 * j]; yr[64 * j] = v * rs * gr[64 * j]; }
    }
}

constexpr int NPHASE = 10;
__global__ void __launch_bounds__(512, 2) hybrid_fwd(Args args) {
    extern __shared__ __attribute__((aligned(16))) unsigned char lds[];
    Frame F;
    F.lds = (LAS unsigned char*)lds;
    F.MISC = (volatile LAS unsigned*)(F.lds + MISC_OFF);
    F.tid = threadIdx.x; F.lane = F.tid & 63; F.wave = __builtin_amdgcn_readfirstlane(F.tid >> 6);
    F.G = gridDim.x; { const int bx = blockIdx.x; F.vcu = (F.G % 8 == 0) ? (bx % 8) * (F.G / 8) + bx / 8 : bx; }
    F.in = args.in; F.out = args.out; F.ws = args.ws; F.ctl = (gu32*)(args.ws + WS_CTL);
    for (int u = F.tid; u < 128; u += 512) ((LAS unsigned*)(F.lds + MISC_OFF))[u] = 0u;
    __syncthreads();
    const int lo = args.ph_lo, hi = args.ph_hi;
    const bool multi = (hi - lo) > 1;
    XcdBarrier bar; bar.bar = (unsigned*)(F.ctl + CW_BAR) + args.li * XCD_BAR_WORDS; bar.x = 0; bar.st = nullptr;
    if (multi) bar = xcd_barrier_post((unsigned*)(F.ctl + CW_BAR) + args.li * XCD_BAR_WORDS, F.MISC + 8);
#ifndef PH_MASK
#define PH_MASK 0x3ff
#endif
#define IN(k) (((PH_MASK >> (k)) & 1) && lo <= (k) && (k) < hi)
#define SEAM(k) do { if (IN(k) && IN((k) + 1)) xcd_barrier(bar); } while (0)
    const int c = (int)blockIdx.x;

    if (IN(0)) { p0_prologue(F); SEAM(0); }

    if (IN(1)) {
        pg8::Gemm g{WSP(bf16, WS_XB), WSP(bf16, WS_WIN), 2048, 2048, 2048}; pg8::StaticOrder S; S.init(MROWS, NIN, F.G, c);
        EpiIn E{WSP(bf16, WS_Q), WSP(bf16, WS_KB), WSP(bf16, WS_VB), WSP(bf16, WS_QI), WSP(bf16, WS_KI), WSP(bf16, WS_U), WSP(bf16, WS_SGA), WSP(bf16, WS_SGB), WSP(float, WS_WI), WSP(float, WS_RS0), F.out};
        pg8::gemm_phase<EpiIn, pg8::StaticOrder, true, true>(F.lds + RING_OFF, g, S, E);
        SEAM(1);
    }

    if (IN(2)) {
#ifndef P2_MASK
#define P2_MASK 7
#endif
        const int qb0 = args.qoff;
        if (P2_MASK & 1) for (;;) { const int u = queue_pop(F, qb0 + 0); if (u >= 128) break; s5_unit(F, u & 1, u >> 1); }
        if (P2_MASK & 2) for (;;) { const int u = queue_pop(F, qb0 + 1); if (u >= 256) break; idx_unit_prompt(F, u & 3, 63 - (u >> 2)); }
        if (P2_MASK & 4) for (;;) { const int u = queue_pop(F, qb0 + 2); if (u >= 128) break; idx_unit_sample(F, u); }
        SEAM(2);
    }

    if (IN(3)) {
        {
        const attn_body::bf16* Qp = (const attn_body::bf16*)WSP(bf16, WS_Q);
        const int bh = F.vcu >> 2, s = F.vcu & 3;
#ifndef P3_MASK
#define P3_MASK 3
#endif
        if (F.G == 256 && (P3_MASK & 1)) {
            if (c & 1) { sattn_unit(F, c >> 2, c & 3); }
            for (int i = 0; i < 2; ++i)
                attn_body::attn_unit<8>(bh >> 4, bh & 15, i == 0 ? 7 - s : s, Qp, (const attn_body::bf16*)WSP(bf16, WS_KB), (const attn_body::bf16*)WSP(bf16, WS_VB), (attn_body::bf16*)WSP(bf16, WS_O),
                                        WSP(unsigned, WS_MASK), (char*)lds + RING_OFF, (char*)lds + AMASK_OFF);
        }
        if (P3_MASK & 2) for (int v = c; v < 512; v += F.G) { if (F.G == 256 && (c & 1) && v == c) continue; sattn_unit(F, v >> 2, v & 3); }
        }
        SEAM(3);
    }

    if (IN(4)) {
        { pg8::Gemm g{WSP(bf16, WS_Z), WSP(bf16, WS_WG), 1024, 1024, 1024}; OrderGlu S{c}; EpiGlu E{WSP(bf16, WS_SGB), WSP(bf16, WS_MRG)};
          pg8::gemm_phase<EpiGlu, OrderGlu, true, true>(F.lds + RING_OFF, g, S, E); }
        { pg8::Gemm g{WSP(bf16, WS_O), WSP(bf16, WS_WP), 1024, 1024, 1024}; OrderProj S{c}; EpiProj E{WSP(bf16, WS_SGA), WSP(bf16, WS_MRG)};
          pg8::gemm_phase<EpiProj, OrderProj, true, true>(F.lds + RING_OFF, g, S, E); }
        SEAM(4);
    }

    if (IN(5)) {
        pg8::Gemm g{WSP(bf16, WS_MRG), WSP(bf16, WS_WO), 2048, 2048, 2048}; pg8::StaticOrder S; S.init(MROWS, 2048, F.G, c);
        EpiOut E{INF(0), INF(1), F.out, WSP(bf16, WS_XB), WSP(float, WS_SS1)};
        pg8::gemm_phase<EpiOut, pg8::StaticOrder, true, true>(F.lds + RING_OFF, g, S, E);
        SEAM(5);
    }

    if (IN(6)) {
        pg8::Gemm g{WSP(bf16, WS_XB), WSP(bf16, WS_WUP), 2048, 2048, 2048}; pg8::StaticOrder S; S.init(MROWS, DFF2, F.G, c);
        EpiUp E{WSP(float, WS_SS1), WSP(bf16, WS_UP), F.out};
        pg8::gemm_phase<EpiUp, pg8::StaticOrder, true, true>(F.lds + RING_OFF, g, S, E);
        SEAM(6);
    }

    if (IN(7)) { p7_convgate(F); SEAM(7); }

    if (IN(8)) {
        pg8::Gemm g{WSP(bf16, WS_ACT), WSP(bf16, WS_WDN), DFF, DFF, DFF}; pg8::StaticOrder S; S.init(MROWS, 2048, F.G, c);
        EpiDown E{F.out, WSP(float, WS_SS2)};
        pg8::gemm_phase<EpiDown, pg8::StaticOrder, true, true>(F.lds + RING_OFF, g, S, E);
        SEAM(8);
    }

    if (IN(9)) { p9_final(F); }
#undef IN
#undef SEAM
}

#ifndef MK_N_LAUNCHES
#define MK_N_LAUNCHES 1
#endif
extern "C" void kernel_launch(void* const* d_in, const int* in_sizes, int n_in, void* d_out, int out_size, void* d_ws, size_t ws_size, hipStream_t stream) {
    static int grid = 0;
    if (grid == 0) {
        if (n_in != 28 || (size_t)out_size != O_END || ws_size < WS_END) { fprintf(stderr, "kernel_launch: unexpected shapes: n_in %d out %d ws %zu (want 28, %zu, >= %zu)\n", n_in, out_size, ws_size, (size_t)O_END, (size_t)WS_END); grid = -1; return; }
        int dev = 0, cus = 0, per_cu = 0;
        if (hipGetDevice(&dev) != hipSuccess || hipDeviceGetAttribute(&cus, hipDeviceAttributeMultiprocessorCount, dev) != hipSuccess) { grid = -1; return; }
        if (hipFuncSetAttribute((const void*)hybrid_fwd, hipFuncAttributeMaxDynamicSharedMemorySize, LDS_BYTES) != hipSuccess) { fprintf(stderr, "kernel_launch: hipFuncSetAttribute failed\n"); grid = -1; return; }
        if (hipOccupancyMaxActiveBlocksPerMultiprocessor(&per_cu, (const void*)hybrid_fwd, 512, LDS_BYTES) != hipSuccess || per_cu < 1) fprintf(stderr, "kernel_launch: occupancy query reports %d\n", per_cu);
        (void)hipGetLastError();
        grid = cus;
        if (grid != 256) fprintf(stderr, "kernel_launch: %d CUs (built for 256)\n", grid);
    }
    if (grid < 0) return;
    (void)hipMemsetAsync((char*)d_ws + WS_CTL, 0, CTL_ZERO_BYTES, stream);
    Args a{};
    for (int i = 0; i < 28; ++i) a.in[i] = d_in[i];
    a.out = (float*)d_out; a.ws = (unsigned char*)d_ws;
#ifdef PROBE_PHASE
    { const int k = PROBE_PHASE; const int cuts[4] = {0, k + 1, k + 1, NPHASE}; const int los[3] = {0, k, k + 1};
      for (int li = 0; li < 3; ++li) { a.ph_lo = los[li]; a.ph_hi = (li == 1) ? k + 1 : cuts[li == 0 ? 1 : 3]; a.li = li; a.qoff = (li == 1) ? 3 : 0; if (a.ph_lo < a.ph_hi) hipLaunchKernelGGL(hybrid_fwd, dim3(grid), dim3(512), LDS_BYTES, stream, a); } }
#else
    if (MK_N_LAUNCHES == 1) { a.ph_lo = 0; a.ph_hi = NPHASE; hipLaunchKernelGGL(hybrid_fwd, dim3(grid), dim3(512), LDS_BYTES, stream, a); }
    else for (int p = 0; p < NPHASE; ++p) { a.ph_lo = p; a.ph_hi = p + 1; hipLaunchKernelGGL(hybrid_fwd, dim3(grid), dim3(512), LDS_BYTES, stream, a); }
#endif
}
```

```cpp
#include <hip/hip_runtime.h>
#include <cstdio>
#include <cstdint>
namespace pg8 {
#define PG8_LAS __attribute__((address_space(3)))
typedef unsigned short bf16_t;
typedef short bf16x8 __attribute__((ext_vector_type(8)));
typedef float f32x4 __attribute__((ext_vector_type(4)));
typedef unsigned u32x4 __attribute__((ext_vector_type(4)));
typedef unsigned u32x2 __attribute__((ext_vector_type(2)));
constexpr int BM = 256, BK = 64, HALF = 128, HTB = HALF * BK * 2  , STAGE_BYTES = 8 * HTB, NXCD = 8, WGM = 8;
__host__ __device__ __forceinline__ int lds_byte(int r, int c) { const int st = (r >> 4) * 2 + (c >> 5), rr = r & 15, cc = c & 31, ob = rr * 64 + cc * 2; return st * 1024 + (ob ^ (((ob >> 9) & 1) << 5)); }
__host__ __device__ __forceinline__ void stage_rc(int b, int& R, int& C) { const int st = b / 1024, sb = b % 1024, swz = sb ^ (((sb >> 9) & 1) << 5); R = (st >> 1) * 16 + swz / 64; C = (st & 1) * 32 + (swz % 64) / 2; }
__host__ __device__ __forceinline__ int perm32(int rho) { const int n = rho >> 4, i = rho & 15; return 8 * (i >> 2) + 4 * n + (i & 3); }

struct Unit { int pm, pn, kofs; };
struct Gemm { const bf16_t* A; const bf16_t* Bt; int lda, ldb, K; };

struct StaticOrder {
    int nM, nN, nwg, G, c;
    __host__ __device__ void init(int M, int N, int G_, int c_) { nM = M / BM; nN = N / BM; nwg = nM * nN; G = G_; c = c_; }
    __host__ __device__ bool next(int i, Unit& u) const {
        const long L = (long)i * G + c; if (L >= nwg) return false;
        int wgid = (int)L; { const int q = nwg / NXCD, r = nwg % NXCD, xcd = wgid % NXCD, off = wgid / NXCD; wgid = (xcd < r ? xcd * (q + 1) : r * (q + 1) + (xcd - r) * q) + off; }
        const int nig = WGM * nN, gid = wgid / nig, fm = gid * WGM, gsz = (nM - fm) < WGM ? (nM - fm) : WGM;
        u.pm = fm + ((wgid % nig) % gsz); u.pn = (wgid % nig) / gsz; u.kofs = 0; return true;
    }
    __device__ __forceinline__ void a_ready(const Unit&) const {}
    __device__ __forceinline__ void done(const Unit&) const {}
};
__device__ __forceinline__ unsigned cvt_pk_bf16(float lo, float hi) { unsigned r; asm volatile("v_cvt_pk_bf16_f32 %0, %1, %2" : "=v"(r) : "v"(lo), "v"(hi)); return r; }
__device__ __forceinline__ float bf_lo(unsigned w) { return __uint_as_float(w << 16); }
__device__ __forceinline__ float bf_hi(unsigned w) { return __uint_as_float(w & 0xffff0000u); }
__device__ __forceinline__ float sigmoidf_(float v) { return __builtin_amdgcn_rcpf(1.0f + __builtin_amdgcn_exp2f(-1.4426950408889634f * v)); }
template <class Epi, class Sched, bool ALIGN_EPI = false, bool SP2 = false>
__device__ __forceinline__ void gemm_phase(PG8_LAS unsigned char* lds, const Gemm g, const Sched& S, const Epi& E) {
    const int tid = threadIdx.x, wid = __builtin_amdgcn_readfirstlane(tid >> 6), lane = tid & 63, wr = wid >> 2, wc = wid & 3, fr = lane & 15, fq = lane >> 4;
    const int nt = g.K / BK, lda = g.lda, ldb = g.ldb;
    unsigned voffA[2], voffB[2];
#pragma unroll
    for (int i = 0; i < 2; ++i) { int R, C; stage_rc(tid * 16 + i * 8192, R, C); const int Rb = Epi::PERM ? ((R & ~31) + perm32(R & 31)) : R;
        voffA[i] = (unsigned)(R * lda + C) * 2u; voffB[i] = (unsigned)(Rb * ldb + C) * 2u; }
    const size_t kstep = (size_t)(BK * 2);
    const size_t hstepA = (size_t)HALF * lda * 2, hstepB = (size_t)HALF * ldb * 2;
    const size_t tstepA = 2 * hstepA, tstepB = 2 * hstepB;
    const unsigned ldsw = (unsigned)wid * 1024u;
    const int aoff = lds_byte(wr * 64 + fr, fq * 8), boff = lds_byte(wc * 32 + fr, fq * 8);
#define PG8_SA(b, h) (((b) * 2 + (h)) * HTB)
#define PG8_SB(b, h) ((4 + (b) * 2 + (h)) * HTB)
#define PG8_STAGE(bufoff, gbase, voff) do { _Pragma("unroll") for (int _i = 0; _i < 2; ++_i) \
        __builtin_amdgcn_global_load_lds((const unsigned*)((const char*)(gbase) + (voff)[_i]), (PG8_LAS unsigned*)(lds + (bufoff) + ldsw + _i * 8192), 16, 0, 0); } while (0)
#define PG8_LDA(dst, b, h) do { _Pragma("unroll") for (int m = 0; m < 4; ++m) _Pragma("unroll") for (int k = 0; k < 2; ++k) dst[m][k] = *(const PG8_LAS bf16x8*)(lds + PG8_SA(b, h) + aoff + m * 2048 + k * 1024); } while (0)
#define PG8_LDB(dst, b, h) do { _Pragma("unroll") for (int n = 0; n < 2; ++n) _Pragma("unroll") for (int k = 0; k < 2; ++k) dst[n][k] = *(const PG8_LAS bf16x8*)(lds + PG8_SB(b, h) + boff + n * 2048 + k * 1024); } while (0)
#define PG8_MMA(ai, bj, At, Bt) do { __builtin_amdgcn_s_setprio(1); _Pragma("unroll") for (int m = 0; m < 4; ++m) _Pragma("unroll") for (int n = 0; n < 2; ++n) _Pragma("unroll") for (int k = 0; k < 2; ++k) \
        acc[ai][bj][m][n] = __builtin_amdgcn_mfma_f32_16x16x32_bf16(Bt[n][k], At[m][k], acc[ai][bj][m][n], 0, 0, 0); __builtin_amdgcn_s_setprio(0); } while (0)
#define PG8_WAIT_V(n) asm volatile("s_waitcnt vmcnt(" #n ")" ::: "memory")
#define PG8_WAIT_L(n) asm volatile("s_waitcnt lgkmcnt(" #n ")" ::: "memory")
#define PG8_BAR __builtin_amdgcn_s_barrier()
#define PG8_SCHED __builtin_amdgcn_sched_barrier(0)
    Unit cur, nxt; int ui = 0;
    if (!S.next(0, cur)) return;
    f32x4 acc[2][2][4][2];
#pragma unroll
    for (int a = 0; a < 2; ++a)
#pragma unroll
        for (int b = 0; b < 2; ++b)
#pragma unroll
            for (int m = 0; m < 4; ++m)
#pragma unroll
                for (int n = 0; n < 2; ++n) acc[a][b][m][n] = (f32x4){0.f, 0.f, 0.f, 0.f};
    bf16x8 At[4][2], B0[2][2], B1[2][2];
    const char* cA = (const char*)g.A + (size_t)cur.pm * tstepA + (size_t)cur.kofs * 2; const char* cB = (const char*)g.Bt + (size_t)cur.pn * tstepB + (size_t)cur.kofs * 2;
    S.a_ready(cur);
    if constexpr (SP2) {
        PG8_STAGE(PG8_SB(0, 0), cB, voffB); PG8_STAGE(PG8_SB(0, 1), cB + hstepB, voffB); PG8_STAGE(PG8_SA(0, 0), cA, voffA); PG8_STAGE(PG8_SA(0, 1), cA + hstepA, voffA);
        if (wr == 1) PG8_BAR;
        PG8_WAIT_V(2); PG8_BAR;
        PG8_STAGE(PG8_SB(1, 0), cB + kstep, voffB); PG8_STAGE(PG8_SA(1, 0), cA + kstep, voffA); PG8_STAGE(PG8_SB(1, 1), cB + hstepB + kstep, voffB);
        PG8_WAIT_V(6); PG8_BAR;
    } else {
        PG8_STAGE(PG8_SB(0, 0), cB, voffB); PG8_STAGE(PG8_SA(0, 0), cA, voffA); PG8_STAGE(PG8_SB(0, 1), cB + hstepB, voffB); PG8_STAGE(PG8_SA(0, 1), cA + hstepA, voffA);
        if (wr == 1) PG8_BAR;
        PG8_WAIT_V(4); PG8_BAR;
        PG8_STAGE(PG8_SB(1, 0), cB + kstep, voffB); PG8_STAGE(PG8_SA(1, 0), cA + kstep, voffA); PG8_STAGE(PG8_SB(1, 1), cB + hstepB + kstep, voffB);
        PG8_WAIT_V(6); PG8_BAR;
    }
    for (;;) {
        const bool has_next = S.next(ui + 1, nxt);
        const char* nA = has_next ? (const char*)g.A + (size_t)nxt.pm * tstepA + (size_t)nxt.kofs * 2 : cA; const char* nB = has_next ? (const char*)g.Bt + (size_t)nxt.pn * tstepB + (size_t)nxt.kofs * 2 : cB;
        for (int t = 0; t < nt; t += 2) {
            const bool last = (t == nt - 2);
            const char* a1 = cA + (size_t)(t + 1) * kstep;
            const char* a2 = last ? nA : cA + (size_t)(t + 2) * kstep; const char* b2 = last ? nB : cB + (size_t)(t + 2) * kstep;
            const char* a3 = a2 + kstep; const char* b3 = b2 + kstep;
            if (last && has_next) S.a_ready(nxt);
            if constexpr (SP2) {
            PG8_LDB(B0, 0, 0); PG8_LDB(B1, 0, 1); PG8_SCHED; PG8_LDA(At, 0, 0); PG8_STAGE(PG8_SA(1, 1), a1 + hstepA, voffA);
            PG8_WAIT_V(8); PG8_WAIT_L(0); PG8_BAR; PG8_MMA(0, 0, At, B0); PG8_MMA(0, 1, At, B1); PG8_BAR; PG8_SCHED;
            PG8_LDA(At, 0, 1); PG8_STAGE(PG8_SB(0, 0), b2, voffB); PG8_STAGE(PG8_SB(0, 1), b2 + hstepB, voffB); PG8_STAGE(PG8_SA(0, 0), a2, voffA);
            PG8_WAIT_V(8); PG8_WAIT_L(0); PG8_BAR; PG8_MMA(1, 0, At, B0); PG8_MMA(1, 1, At, B1); PG8_BAR; PG8_SCHED;
            PG8_LDB(B0, 1, 0); PG8_LDB(B1, 1, 1); PG8_SCHED; PG8_LDA(At, 1, 0); PG8_STAGE(PG8_SA(0, 1), a2 + hstepA, voffA);
            PG8_WAIT_V(8); PG8_WAIT_L(0); PG8_BAR; PG8_MMA(0, 0, At, B0); PG8_MMA(0, 1, At, B1); PG8_BAR; PG8_SCHED;
            PG8_LDA(At, 1, 1); PG8_STAGE(PG8_SB(1, 0), b3, voffB); PG8_STAGE(PG8_SB(1, 1), b3 + hstepB, voffB); PG8_STAGE(PG8_SA(1, 0), a3, voffA);
            PG8_WAIT_V(8); PG8_WAIT_L(0); PG8_BAR; PG8_MMA(1, 0, At, B0); PG8_MMA(1, 1, At, B1); PG8_BAR; PG8_SCHED;
            } else {
            PG8_LDB(B0, 0, 0); PG8_SCHED; PG8_LDA(At, 0, 0); PG8_STAGE(PG8_SA(1, 1), a1 + hstepA, voffA);
            PG8_WAIT_L(8); PG8_BAR; PG8_WAIT_L(0); PG8_MMA(0, 0, At, B0); PG8_BAR; PG8_SCHED;
            PG8_LDB(B1, 0, 1); PG8_STAGE(PG8_SB(0, 0), b2, voffB);
            PG8_BAR; PG8_WAIT_L(0); PG8_MMA(0, 1, At, B1); PG8_BAR;
            PG8_LDA(At, 0, 1); PG8_STAGE(PG8_SA(0, 0), a2, voffA);
            PG8_BAR; PG8_WAIT_L(0); PG8_MMA(1, 0, At, B0); PG8_BAR; PG8_SCHED;
            PG8_STAGE(PG8_SB(0, 1), b2 + hstepB, voffB);
            PG8_WAIT_V(6); PG8_BAR; PG8_MMA(1, 1, At, B1); PG8_BAR;
            PG8_LDB(B0, 1, 0); PG8_SCHED; PG8_LDA(At, 1, 0); PG8_STAGE(PG8_SA(0, 1), a2 + hstepA, voffA);
            PG8_WAIT_L(8); PG8_BAR; PG8_WAIT_L(0); PG8_MMA(0, 0, At, B0); PG8_BAR; PG8_SCHED;
            PG8_LDB(B1, 1, 1); PG8_STAGE(PG8_SB(1, 0), b3, voffB);
            PG8_BAR; PG8_WAIT_L(0); PG8_MMA(0, 1, At, B1); PG8_BAR;
            PG8_LDA(At, 1, 1); PG8_STAGE(PG8_SA(1, 0), a3, voffA);
            PG8_BAR; PG8_WAIT_L(0); PG8_MMA(1, 0, At, B0); PG8_BAR; PG8_SCHED;
            PG8_STAGE(PG8_SB(1, 1), b3 + hstepB, voffB);
            PG8_WAIT_V(6); PG8_BAR; PG8_MMA(1, 1, At, B1); PG8_BAR;
            }
        }
        if constexpr (ALIGN_EPI) { if (wr == 0) PG8_BAR; }
        if constexpr (!Epi::AFTER_DRAIN) { E(acc, cur, wr, wc, fr, fq); S.done(cur); }
        if (!has_next) break;
#pragma unroll
        for (int a = 0; a < 2; ++a)
#pragma unroll
            for (int b = 0; b < 2; ++b)
#pragma unroll
                for (int m = 0; m < 4; ++m)
#pragma unroll
                    for (int n = 0; n < 2; ++n) acc[a][b][m][n] = (f32x4){0.f, 0.f, 0.f, 0.f};
        cur = nxt; cA = nA; cB = nB; ++ui;
        if constexpr (ALIGN_EPI) { if (wr == 1) PG8_BAR; }
    }
    PG8_WAIT_V(0);
    if constexpr (!ALIGN_EPI) { if (wr == 0) PG8_BAR; }
    PG8_BAR;
    if constexpr (Epi::AFTER_DRAIN) { E.fused(acc, cur, wr, wc, fr, fq, lds, wid, lane); S.done(cur); }
#undef PG8_SA
#undef PG8_SB
#undef PG8_STAGE
#undef PG8_LDA
#undef PG8_LDB
#undef PG8_MMA
#undef PG8_WAIT_V
#undef PG8_WAIT_L
#undef PG8_BAR
#undef PG8_SCHED
}
}
#include <hip/hip_bf16.h>
#include <cmath>
namespace attn_body {
using bf16=__hip_bfloat16;
using bf16x8=__attribute__((ext_vector_type(8)))short;
using s16x4=__attribute__((ext_vector_type(4)))short;
using f32x16=__attribute__((ext_vector_type(16)))float;
using u32x4=__attribute__((ext_vector_type(4)))unsigned;
constexpr int BATCH=4,NHEAD=16,SEQ=2048,D=64,DM=NHEAD*D,KP=256;
constexpr int NW=8,QBLK=32,QB=QBLK*NW,KVBLK=64,NQB=SEQ/QB;
constexpr int ATTN_PITCH=DM, ATTN_UNIT_ROWS=QB;
__device__ __forceinline__ int crow(int r,int hi){return (r&3)+8*(r>>2)+4*hi;}
#define SBAR() __builtin_amdgcn_sched_barrier(0)
__device__ __forceinline__ void amask(f32x16&p0,f32x16&p1,unsigned mw){
  #pragma unroll
  for(int r=0;r<16;++r){
    const unsigned m0=(unsigned)__builtin_amdgcn_sbfe((int)mw,r,1), m1=(unsigned)__builtin_amdgcn_sbfe((int)mw,16+r,1);
    p0[r]=__uint_as_float((__float_as_uint(p0[r])&m0)|(0xff800000u&~m0));
    p1[r]=__uint_as_float((__float_as_uint(p1[r])&m1)|(0xff800000u&~m1));}
}
constexpr int NSLOT=3, SLOTB=8192;
constexpr int LDS_K=0, LDS_V=NSLOT*SLOTB, LDS_WS=2*NSLOT*SLOTB, LDS_OST=LDS_WS+NW*64*4, LDS_BYTES=LDS_OST+NW*4096;
constexpr float C2=0.125f*1.4426950408889634f;
__device__ __forceinline__ void glds16(const void*gsrc,unsigned lds_dst){unsigned keep;
  asm volatile("s_mov_b32 %0, m0\n\ts_mov_b32 m0, %2\n\ts_nop 0\n\tglobal_load_lds_dwordx4 %1, off\n\ts_mov_b32 m0, %0":"=&s"(keep):"v"(gsrc),"s"(lds_dst):"memory");}
__device__ __forceinline__ float max3f(float a,float b,float c){float r;asm("v_max3_f32 %0, %1, %2, %3":"=v"(r):"v"(a),"v"(b),"v"(c));return r;}
__device__ __forceinline__ float max2f(float a,float b){float r;asm("v_max_f32_e32 %0, %1, %2":"=v"(r):"v"(a),"v"(b));return r;}
__device__ __forceinline__ float fadd_s(float a,float b){float r;asm("v_add_f32_e32 %0, %1, %2":"=v"(r):"v"(a),"v"(b));return r;}
__device__ __forceinline__ float fsub_s(float a,float b){float r;asm("v_sub_f32_e32 %0, %1, %2":"=v"(r):"v"(a),"v"(b));return r;}
typedef float f32x2_t __attribute__((ext_vector_type(2))); typedef __bf16 bf16x2_t __attribute__((ext_vector_type(2)));
__device__ __forceinline__ unsigned cvtpk_s(float lo,float hi){f32x2_t v={lo,hi};bf16x2_t b=__builtin_convertvector(v,bf16x2_t);return __builtin_bit_cast(unsigned,b);}
#define WAIT_BAR(N) asm volatile("s_waitcnt vmcnt(" #N ") lgkmcnt(0)\n\ts_barrier":::"memory")

__device__ __forceinline__ void qkt(f32x16&p0,f32x16&p1,const char*Kslot,const bf16x8*qr,const f32x16&negm,int r32,int hi){
  const char*kb=Kslot+hi*1024+r32*16;
  #pragma unroll
  for(int d0=0;d0<4;++d0){
    const bf16x8 b0=*reinterpret_cast<const bf16x8*>(kb+d0*2048);
    const bf16x8 b1=*reinterpret_cast<const bf16x8*>(kb+d0*2048+512);
    if(d0==0){p0=__builtin_amdgcn_mfma_f32_32x32x16_bf16(b0,qr[0],negm,0,0,0);p1=__builtin_amdgcn_mfma_f32_32x32x16_bf16(b1,qr[0],negm,0,0,0);}
    else{p0=__builtin_amdgcn_mfma_f32_32x32x16_bf16(b0,qr[d0],p0,0,0,0);p1=__builtin_amdgcn_mfma_f32_32x32x16_bf16(b1,qr[d0],p1,0,0,0);}}
}
typedef __attribute__((address_space(3))) const char* lds_cptr;
typedef short v4i16_t __attribute__((ext_vector_type(4)));
__device__ __forceinline__ void kload8(bf16x8*kf,lds_cptr kp){
  kf[0]=*(const __attribute__((address_space(3))) bf16x8*)(kp);      kf[1]=*(const __attribute__((address_space(3))) bf16x8*)(kp+512);
  kf[2]=*(const __attribute__((address_space(3))) bf16x8*)(kp+2048); kf[3]=*(const __attribute__((address_space(3))) bf16x8*)(kp+2560);
  kf[4]=*(const __attribute__((address_space(3))) bf16x8*)(kp+4096); kf[5]=*(const __attribute__((address_space(3))) bf16x8*)(kp+4608);
  kf[6]=*(const __attribute__((address_space(3))) bf16x8*)(kp+6144); kf[7]=*(const __attribute__((address_space(3))) bf16x8*)(kp+6656);
}
__device__ __forceinline__ void kload2(bf16x8*kf,lds_cptr kp,int j){ kf[2*j]=*(const __attribute__((address_space(3))) bf16x8*)(kp+j*2048); kf[2*j+1]=*(const __attribute__((address_space(3))) bf16x8*)(kp+j*2048+512); }
__device__ __forceinline__ s16x4 vtr(lds_cptr p){ return __builtin_bit_cast(s16x4,__builtin_amdgcn_ds_read_tr16_b64_v4i16((__attribute__((address_space(3))) v4i16_t*)p)); }
__device__ __forceinline__ float rowmax(const f32x16&p0,const f32x16&p1){
  float a=max3f(p0[0],p0[1],p1[0]),b=max3f(p0[2],p0[3],p1[1]);a=max3f(a,p1[2],p1[3]);
  #pragma unroll
  for(int r=4;r<16;r+=4){a=max3f(a,p0[r],p0[r+1]);b=max3f(b,p0[r+2],p0[r+3]);a=max3f(a,p1[r],p1[r+1]);b=max3f(b,p1[r+2],p1[r+3]);}
  const float m=max2f(a,b);
  auto rr=__builtin_amdgcn_permlane32_swap(__float_as_uint(m),__float_as_uint(m),false,false);
  return max2f(__uint_as_float(rr[0]),__uint_as_float(rr[1]));
}
__device__ __forceinline__ void pv(f32x16*o,int vb,bf16x8 pa0,bf16x8 pa1,bf16x8 pa2,bf16x8 pa3){
  #pragma unroll
  for(int d0=0;d0<2;++d0){s16x4 lo[4],hi[4];
    #pragma unroll
    for(int ks=0;ks<4;++ks){
      asm volatile("ds_read_b64_tr_b16 %0,%1 offset:%c2":"=&v"(lo[ks]):"v"(vb),"i"(d0*4096+ks*1024):"memory");
      asm volatile("ds_read_b64_tr_b16 %0,%1 offset:%c2":"=&v"(hi[ks]):"v"(vb),"i"(d0*4096+ks*1024+512):"memory");}
    asm volatile("s_waitcnt lgkmcnt(0)":::"memory");SBAR();
    #define PK(k) (bf16x8){lo[k][0],lo[k][1],lo[k][2],lo[k][3],hi[k][0],hi[k][1],hi[k][2],hi[k][3]}
    o[d0]=__builtin_amdgcn_mfma_f32_32x32x16_bf16(pa0,PK(0),o[d0],0,0,0);
    o[d0]=__builtin_amdgcn_mfma_f32_32x32x16_bf16(pa1,PK(1),o[d0],0,0,0);
    o[d0]=__builtin_amdgcn_mfma_f32_32x32x16_bf16(pa2,PK(2),o[d0],0,0,0);
    o[d0]=__builtin_amdgcn_mfma_f32_32x32x16_bf16(pa3,PK(3),o[d0],0,0,0);
    #undef PK
  }
}

#ifndef ATTN_STORE16
#define ATTN_STORE16(p,v) (*(u32x4*)(p)=(v))
#endif
template<int THRL> __device__ __forceinline__ void attn_unit(int b,int h,int qb,const bf16*Q,const bf16*__restrict__ K,const bf16*__restrict__ V,bf16*O,const unsigned*__restrict__ MG,char*shm,char*mshm){
  const int tid=threadIdx.x,lane=tid&63,r32=lane&31,hi=lane>>5; const int wid=__builtin_amdgcn_readfirstlane(tid>>6);
  const long rowbase=(long)b*SEQ; const int q0=qb*QB;
  const bf16*Qw=Q+(rowbase+q0+wid*QBLK)*DM+h*D;
  const bf16*Kh=K+rowbase*KP+(h>>2)*D,*Vh=V+rowbase*KP+(h>>2)*D;
  const unsigned lds0=(unsigned)(uintptr_t)shm;
  float*wsf=(float*)(shm+LDS_WS)+wid*64;
  const bf16*ksrc=Kh+(long)lane*KP+wid*8;
  const bf16*vsrc=Vh+(long)(16*(wid&3)+(lane>>2))*KP+(wid>>2)*32+(lane&3)*8;
  const unsigned kdst=lds0+LDS_K+wid*1024, vdst=lds0+LDS_V+wid*1024;
  #define DMA_K(t,slot) glds16(ksrc+(long)(t)*KVBLK*KP,(unsigned)__builtin_amdgcn_readfirstlane(kdst+(slot)))
  #define DMA_V(t,slot) glds16(vsrc+(long)(t)*KVBLK*KP,(unsigned)__builtin_amdgcn_readfirstlane(vdst+(slot)))
  const int vb0=(int)(lds0+LDS_V)+((lane>>4)&1)*32+(lane&3)*8+(4*hi+((lane&15)>>2))*64;
  const char*Kbase=shm+LDS_K; bf16x8 kf[8];
  const lds_cptr shm3=(lds_cptr)shm; const lds_cptr kp0=shm3+LDS_K+hi*1024+r32*16; const lds_cptr vp0=shm3+LDS_V+((lane>>4)&1)*32+(lane&3)*8+(4*hi+((lane&15)>>2))*64;
  const int NT=(q0+QB)/KVBLK;
  unsigned*mwv=(unsigned*)(mshm+wid*8192);
  { const u32x4*msrc=(const u32x4*)(MG+(size_t)((b*(SEQ/QBLK))+qb*NW+wid)*2048);
    #pragma unroll
    for(int i=0;i<8;++i){ if(i<=qb){ const u32x4 v_=msrc[i*64+lane]; *(u32x4*)(mwv+(i*64+lane)*4)=v_; } } }
  const unsigned*mldsw=mwv+hi*32+r32;
  asm volatile("s_waitcnt vmcnt(0) lgkmcnt(0)":::"memory");
  DMA_K(0,0);DMA_V(0,0);DMA_K(1,SLOTB);
  bf16x8 qr[4];
  #pragma unroll
  for(int d0=0;d0<4;++d0)qr[d0]=*reinterpret_cast<const bf16x8*>(&Qw[(long)r32*DM+d0*16+hi*8]);
  float mhat=0.f,l_reg=0.f;f32x16 o[2];o[0]=f32x16{};o[1]=f32x16{};const f32x16 negm=f32x16{};
  const int qrel=wid*QBLK+r32;
  #define CMASK(P0,P1,t) do{ _Pragma("unroll") for(int r_=0;r_<16;++r_){P0[r_]-=mhat;P1[r_]-=mhat;} amask(P0,P1,mldsw[(t)*64]); }while(0)
  bool resc=false;
  #define START(P0,P1) do{ const float rm=rowmax(P0,P1); resc=false; \
    { const float dl=(rm<-3.0e38f)?0.f:rm; mhat=fadd_s(mhat,dl); \
      _Pragma("unroll") for(int r=0;r<16;++r){P0[r]=fsub_s(P0[r],dl);P1[r]=fsub_s(P1[r],dl);} \
    } \
    _Pragma("unroll") for(int r=0;r<16;++r)P0[r]=__builtin_amdgcn_exp2f(P0[r]); }while(0)
  #define RESC() do{ if(resc){ asm volatile("s_waitcnt lgkmcnt(0)":::"memory"); \
      _Pragma("unroll") for(int d_=0;d_<2;++d_) _Pragma("unroll") for(int r=0;r<16;++r)o[d_][r]*=wsf[crow(r,hi)]; } }while(0)
  f32x16 pA0,pA1,pB0,pB1;
  int sl_prev=0,sl_cur=0,sl_next=SLOTB;
  #define ROT() do{sl_prev=sl_cur;sl_cur=sl_next;sl_next=(sl_next==(NSLOT-1)*SLOTB)?0:sl_next+SLOTB;}while(0)
  DMA_K(2,2*SLOTB);
  WAIT_BAR(3);
  qkt(pA0,pA1,Kbase,qr,negm,r32,hi);asm volatile("s_nop 15\n\ts_nop 7":"+v"(pA0),"+v"(pA1));CMASK(pA0,pA1,0);
  START(pA0,pA1);
  _Pragma("unroll") for(int r=0;r<16;++r)pA1[r]=__builtin_amdgcn_exp2f(pA1[r]);
  WAIT_BAR(0);
  DMA_K(3,0);DMA_V(1,SLOTB);
  ROT();
  kload8(kf,kp0+sl_cur);
  WAIT_BAR(2);
  s16x4 vlo[8],vhi[8]; u32x4 pw0,pw1,pw2,pw3;
  #define PKW(P,B) cvtpk_s(P[B],P[B+1])
  #define PAF(k) __builtin_bit_cast(bf16x8,pw##k)
  #define VFR(i) (bf16x8){vlo[i][0],vlo[i][1],vlo[i][2],vlo[i][3],vhi[i][0],vhi[i][1],vhi[i][2],vhi[i][3]}
  #define PIN(x) asm volatile("":"+v"(x))
  #define MX3(a,b,c) __builtin_fmaxf(__builtin_fmaxf((a),(b)),(c))
  #define GAPA(MF,A0,A1,A2,A3,W0,W1,PW) do{ MF; sacc+=A0; sacc+=A1; sacc+=A2; sacc+=A3; PIN(sacc); W0; W1; PIN(PW); SBAR(); }while(0)
  #define EX(v) __builtin_amdgcn_exp2f(v)
  #define GAPB(MF,X,B) do{ MF; X[B]=EX(X[B]); X[B+1]=EX(X[B+1]); X[B+2]=EX(X[B+2]); X[B+3]=EX(X[B+3]); PIN(X); SBAR(); }while(0)
  #define VRD(i) do{ vlo[i]=vtr(vp_+(((i)>>2)*4096+((i)&3)*1024)); vhi[i]=vtr(vp_+(((i)>>2)*4096+((i)&3)*1024+512)); }while(0)
  #define KRD(G,j) do{ if(G){ kload2(kf,kp0+sl_next,j); SBAR(); } }while(0)
  #define STEP(C0,C1,P0,P1,t,GK,GV,GL) do{ SBAR(); \
    const lds_cptr vp_=vp0+sl_prev; \
    VRD(0); SBAR(); float sacc=(P0[0]+P0[1]); \
    GAPA(C0=__builtin_amdgcn_mfma_f32_32x32x16_bf16(kf[0],qr[0],f32x16{},0,0,0), P0[2],P0[3],P0[4],P0[5],     pw0[0]=PKW(P0,0), pw0[1]=PKW(P0,2), pw0); \
    VRD(4); SBAR(); GAPA(C1=__builtin_amdgcn_mfma_f32_32x32x16_bf16(kf[1],qr[0],f32x16{},0,0,0), P0[6],P0[7],P0[8],P0[9],     pw0[2]=PKW(P0,4), pw0[3]=PKW(P0,6), pw0); \
    VRD(1); SBAR(); GAPA(C0=__builtin_amdgcn_mfma_f32_32x32x16_bf16(kf[2],qr[1],C0,0,0,0),   P0[10],P0[11],P0[12],P0[13], pw1[0]=PKW(P0,8), pw1[1]=PKW(P0,10), pw1); \
    VRD(5); SBAR(); GAPA(C1=__builtin_amdgcn_mfma_f32_32x32x16_bf16(kf[3],qr[1],C1,0,0,0),   P0[14],P0[15],P1[0],P1[1],   pw1[2]=PKW(P0,12),pw1[3]=PKW(P0,14), pw1); \
    VRD(2); SBAR(); GAPA(C0=__builtin_amdgcn_mfma_f32_32x32x16_bf16(kf[4],qr[2],C0,0,0,0),   P1[2],P1[3],P1[4],P1[5],     pw2[0]=PKW(P1,0), pw2[1]=PKW(P1,2), pw2); \
    VRD(6); SBAR(); GAPA(C1=__builtin_amdgcn_mfma_f32_32x32x16_bf16(kf[5],qr[2],C1,0,0,0),   P1[6],P1[7],P1[8],P1[9],     pw2[2]=PKW(P1,4), pw2[3]=PKW(P1,6), pw2); \
    VRD(3); SBAR(); GAPA(C0=__builtin_amdgcn_mfma_f32_32x32x16_bf16(kf[6],qr[3],C0,0,0,0),   P1[10],P1[11],P1[12],P1[13], pw3[0]=PKW(P1,8), pw3[1]=PKW(P1,10), pw3); \
    VRD(7); SBAR(); GAPA(C1=__builtin_amdgcn_mfma_f32_32x32x16_bf16(kf[7],qr[3],C1,0,0,0),   P1[14],P1[15],0.f,0.f,       pw3[2]=PKW(P1,12),pw3[3]=PKW(P1,14), pw3); \
    l_reg+=sacc; \
    if(GK){DMA_K((t)+3,sl_cur);} if(GV){DMA_V((t)+1,sl_next);} \
    CMASK(C0,C1,t); \
    { float a=MX3(C0[0],C0[1],C1[0]),b=MX3(C0[2],C0[3],C1[1]); a=MX3(a,C1[2],C1[3]); \
      _Pragma("unroll") for(int r=4;r<16;r+=4){a=MX3(a,C0[r],C0[r+1]);b=MX3(b,C0[r+2],C0[r+3]);a=MX3(a,C1[r],C1[r+1]);b=MX3(b,C1[r+2],C1[r+3]);} \
      float rm=__builtin_fmaxf(a,b); { auto rr=__builtin_amdgcn_permlane32_swap(__float_as_uint(rm),__float_as_uint(rm),false,false); rm=__builtin_fmaxf(__uint_as_float(rr[0]),__uint_as_float(rr[1])); } \
      resc=false; \
      if(__builtin_expect(__any(rm>(float)THRL),0)){ const float dl=__builtin_fmaxf(rm,0.f); mhat+=dl; \
        _Pragma("unroll") for(int r=0;r<16;++r){C0[r]-=dl;C1[r]-=dl;} \
        const float f=__builtin_amdgcn_exp2f(-dl); l_reg*=f; if(hi==0)wsf[r32]=f; resc=true; } } \
    SBAR(); \
    GAPB(o[0]=__builtin_amdgcn_mfma_f32_32x32x16_bf16(PAF(0),VFR(0),o[0],0,0,0), C0,0); \
    GAPB(o[1]=__builtin_amdgcn_mfma_f32_32x32x16_bf16(PAF(0),VFR(4),o[1],0,0,0), C0,4); \
    KRD(GL,0); GAPB(o[0]=__builtin_amdgcn_mfma_f32_32x32x16_bf16(PAF(1),VFR(1),o[0],0,0,0), C0,8); \
    KRD(GL,1); GAPB(o[1]=__builtin_amdgcn_mfma_f32_32x32x16_bf16(PAF(1),VFR(5),o[1],0,0,0), C0,12); \
    KRD(GL,2); GAPB(o[0]=__builtin_amdgcn_mfma_f32_32x32x16_bf16(PAF(2),VFR(2),o[0],0,0,0), C1,0); \
    KRD(GL,3); GAPB(o[1]=__builtin_amdgcn_mfma_f32_32x32x16_bf16(PAF(2),VFR(6),o[1],0,0,0), C1,4); \
    GAPB(o[0]=__builtin_amdgcn_mfma_f32_32x32x16_bf16(PAF(3),VFR(3),o[0],0,0,0), C1,8); \
    GAPB(o[1]=__builtin_amdgcn_mfma_f32_32x32x16_bf16(PAF(3),VFR(7),o[1],0,0,0), C1,12); \
    }while(0)
  int t=1;
  for(;t+5<NT;t+=2){
    STEP(pB0,pB1,pA0,pA1,t,true,true,true);     WAIT_BAR(2); RESC(); ROT();
    STEP(pA0,pA1,pB0,pB1,t+1,true,true,true);   WAIT_BAR(2); RESC(); ROT();
  }
  #undef CMASK
  #define CMASK(P0,P1,t) do{ _Pragma("unroll") for(int r_=0;r_<16;++r_){P0[r_]-=mhat;P1[r_]-=mhat;} amask(P0,P1,mldsw[(t)*64]); }while(0)
  #define ENDW(tt) do{ if((tt)+3<NT){WAIT_BAR(2);} else if((tt)+2<NT){WAIT_BAR(1);} else {WAIT_BAR(0);} }while(0)
  for(;t+1<NT;t+=2){
    STEP(pB0,pB1,pA0,pA1,t,(t+3<NT),(t+1<NT),(t+1<NT));       ENDW(t);   RESC(); ROT();
    STEP(pA0,pA1,pB0,pB1,t+1,(t+4<NT),(t+2<NT),(t+2<NT));     ENDW(t+1); RESC(); ROT();
  }
  STEP(pB0,pB1,pA0,pA1,NT-1,false,false,false); RESC();
  { float sacc=pB0[0]+pB0[1]; _Pragma("unroll") for(int r=2;r<16;++r)sacc+=pB0[r]; _Pragma("unroll") for(int r=0;r<16;++r)sacc+=pB1[r]; l_reg+=sacc;
    pw0=(u32x4){PKW(pB0,0),PKW(pB0,2),PKW(pB0,4),PKW(pB0,6)};pw1=(u32x4){PKW(pB0,8),PKW(pB0,10),PKW(pB0,12),PKW(pB0,14)};pw2=(u32x4){PKW(pB1,0),PKW(pB1,2),PKW(pB1,4),PKW(pB1,6)};pw3=(u32x4){PKW(pB1,8),PKW(pB1,10),PKW(pB1,12),PKW(pB1,14)};
    SBAR(); pv(o,vb0+sl_cur,PAF(0),PAF(1),PAF(2),PAF(3)); }
  #undef PKW
  #undef PAF
  #undef VFR
  #undef PIN
  #undef MX3
  #undef GAPA
  #undef GAPB
  #undef EX
  #undef VRD
  #undef KRD
  #undef STEP
  #undef ENDW
  {auto rr=__builtin_amdgcn_permlane32_swap(__float_as_uint(l_reg),__float_as_uint(l_reg),false,false);l_reg=__uint_as_float(rr[0])+__uint_as_float(rr[1]);}
  if(hi==0)wsf[32+r32]=l_reg;asm volatile("s_waitcnt lgkmcnt(0)":::"memory");
  float rli[16];
  #pragma unroll
  for(int r=0;r<16;++r)rli[r]=__builtin_amdgcn_rcpf(wsf[32+crow(r,hi)]);
  bf16*Ow=O+(rowbase+q0+wid*QBLK)*DM+h*D;
  { bf16*stg=(bf16*)(shm+LDS_OST)+wid*2048;
    #pragma unroll
    for(int r=0;r<16;++r){const int orow=crow(r,hi);
      #pragma unroll
      for(int d0=0;d0<2;++d0)stg[orow*64+d0*32+r32]=__float2bfloat16(o[d0][r]*rli[r]);}
    asm volatile("s_waitcnt lgkmcnt(0)":::"memory");
    #pragma unroll
    for(int i=0;i<4;++i){const int row=i*8+(lane>>3),ch=lane&7; const u32x4 v=*(const u32x4*)(stg+row*64+ch*8); ATTN_STORE16(Ow+(long)row*DM+ch*8,v);} }
  asm volatile("s_waitcnt lgkmcnt(0)\n\ts_barrier":::"memory");
  #undef DMA_K
  #undef DMA_V
  #undef CMASK
  #undef START
  #undef RESC
  #undef ROT
}
constexpr int ATTN_LDS_BYTES=LDS_BYTES;
struct AttnTensors { const bf16* Q; const bf16* K; const bf16* V; bf16* O; };
struct AttnUnit { int bh; int qb; };
struct StaticOrder {
  int vcu;
  __device__ __forceinline__ explicit StaticOrder(int grid,int block):vcu((block%8)*(grid/8)+block/8){}
  __device__ __forceinline__ bool next(int i,AttnUnit&u)const{ if(i>=4)return false; const int s=vcu&7; u.bh=vcu>>3; u.qb=(i==0)?s:(i==1)?15-s:(i==2)?16+s:31-s; return true; }
  __device__ __forceinline__ void a_ready(const AttnUnit&)const{}
  __device__ __forceinline__ void done(const AttnUnit&)const{}
};
#undef SBAR
#undef WAIT_BAR
}

constexpr int DM_ = 2048, PB = 4, PT_ = 2048, SB_ = 128, ST_ = 4, NPAGES = 16, PAGE = 128;
constexpr int MP = PB * PT_;
constexpr int MS = SB_ * ST_;
constexpr int MROWS = MP + MS;
constexpr int NIN = 7424;
constexpr int DFF = 5632, DFF2 = 11264;
constexpr float EPS_ = 1e-6f;
constexpr float C2 = 0.125f * 1.4426950408889634f;
constexpr size_t O_YP = 0, O_YS = O_YP + (size_t)MP * DM_, O_KP = O_YS + (size_t)MS * DM_, O_VP = O_KP + (size_t)MP * 256, O_KIP = O_VP + (size_t)MP * 256,
                 O_SRP = O_KIP + (size_t)MP * 64, O_SIP = O_SRP + 4 * 64 * 64, O_CP = O_SIP + 4 * 64 * 64, O_KS = O_CP + (size_t)4 * 2 * DFF2, O_VS = O_KS + (size_t)MS * 256,
                 O_KIS = O_VS + (size_t)MS * 256, O_SRS = O_KIS + (size_t)MS * 64, O_SIS = O_SRS + (size_t)128 * 64 * 64, O_CS = O_SIS + (size_t)128 * 64 * 64, O_END = O_CS + (size_t)128 * 2 * DFF2;
constexpr size_t MiB = 1u << 20;
constexpr size_t WS_CTL = 0, CTL_ZERO_BYTES = 1 * MiB;
constexpr size_t WS_WIN = 1 * MiB, WS_WP = 30 * MiB, WS_WG = 34 * MiB, WS_WO = 42 * MiB, WS_WUP = 50 * MiB, WS_WDN = 94 * MiB;
constexpr size_t WS_XB = 116 * MiB, WS_Q = 150 * MiB, WS_KB = 167 * MiB, WS_VB = 172 * MiB, WS_QI = 177 * MiB, WS_KI = 186 * MiB, WS_WI = 188 * MiB, WS_RS0 = 189 * MiB;
constexpr size_t WS_U = 190 * MiB, WS_SGA = 207 * MiB, WS_SGB = 241 * MiB, WS_Z = 275 * MiB, WS_MRG = 292 * MiB, WS_SS1 = 326 * MiB, WS_SS2 = 328 * MiB;
constexpr size_t WS_MASK = 330 * MiB, WS_LIST = 332 * MiB, WS_SCP = 333 * MiB, WS_SCS = 397 * MiB, WS_UP = 402 * MiB, WS_ACT = 590 * MiB, WS_O = WS_Q  , WS_END = 684 * MiB;
constexpr int SCS_PITCH = 2304;
constexpr int CW_BAR = 4096;
constexpr int CW_QUEUE = 16384;
constexpr int RING_OFF = 0, RING_BYTES = 131072;
constexpr int AMASK_OFF = 86016;
constexpr int MISC_OFF = 151552;
constexpr int LDS_BYTES = 155648;
static_assert(AMASK_OFF >= attn_body::ATTN_LDS_BYTES && AMASK_OFF + 65536 <= MISC_OFF && MISC_OFF + 512 <= LDS_BYTES, "LDS map");

#define GAS __attribute__((address_space(1)))
#define LAS __attribute__((address_space(3)))
typedef unsigned short bf16;
typedef unsigned v4u __attribute__((ext_vector_type(4)));
typedef unsigned v2u __attribute__((ext_vector_type(2)));
typedef float f32x4 __attribute__((ext_vector_type(4)));
typedef float f32x16 __attribute__((ext_vector_type(16)));
typedef short bf16x8 __attribute__((ext_vector_type(8)));
typedef short s16x4 __attribute__((ext_vector_type(4)));
typedef GAS unsigned gu32;
#define RLX_AGENT __ATOMIC_RELAXED, __HIP_MEMORY_SCOPE_AGENT
#define LDS_WAIT() asm volatile("s_waitcnt lgkmcnt(0)" ::: "memory")
#define VM_WAIT() asm volatile("s_waitcnt vmcnt(0)" ::: "memory")
__device__ __forceinline__ unsigned f2bf(float f) { unsigned u = __builtin_bit_cast(unsigned, f); return (u + 0x7fffu + ((u >> 16) & 1u)) >> 16; }
__device__ __forceinline__ unsigned pk2(float lo, float hi) { return pg8::cvt_pk_bf16(lo, hi); }
__device__ __forceinline__ float bflo(unsigned w) { return __uint_as_float(w << 16); }
__device__ __forceinline__ float bfhi(unsigned w) { return __uint_as_float(w & 0xffff0000u); }
using pg8::sigmoidf_;

#define XB_TMO      128
#define XB_XCNT(j)  (256  + 64 * (j))
#define XB_XSUB(j)  (1280 + 64 * (j))
#define XB_XGEN(j)  (2304 + 64 * (j))
#define XB_TOP      3328
#define XB_TOPGEN   3392
#define XCD_BAR_WORDS 3456
#define XB_SPIN_CAP (1u << 18)
__device__ __forceinline__ unsigned xb_ld(unsigned* p)              { return __hip_atomic_load(p, __ATOMIC_RELAXED, __HIP_MEMORY_SCOPE_AGENT); }
__device__ __forceinline__ unsigned xb_add(unsigned* p, unsigned v) { return __hip_atomic_fetch_add(p, v, __ATOMIC_RELAXED, __HIP_MEMORY_SCOPE_AGENT); }
__device__ __forceinline__ unsigned xb_xcc_id() { return (unsigned)__builtin_amdgcn_s_getreg((3 << 11) | 20) & 0xFu; }
#define XB_SPIN(cond, bar) do { unsigned _sp = 0; while (cond) { __builtin_amdgcn_s_sleep(1); \
    if ((++_sp & 255u) == 0u) { if (xb_ld(&(bar)[XB_TMO])) break; if (_sp > XB_SPIN_CAP) { atomicAdd(&(bar)[XB_TMO], 1u); break; } } } } while (0)
struct XcdBarrier { unsigned* bar; unsigned x; volatile LAS unsigned* st; };
__device__ __forceinline__ XcdBarrier xcd_barrier_post(unsigned* bar, volatile LAS unsigned* st) {
    XcdBarrier b; b.bar = bar; b.x = xb_xcc_id(); b.st = st;
    if (threadIdx.x == 0) (void)xb_add(&bar[XB_XCNT(b.x)], 1u);
    return b;
}
__device__ __forceinline__ void xcd_barrier_complete(unsigned* bar, unsigned x, unsigned& nloc, unsigned& nx) {
    const unsigned G = gridDim.x * gridDim.y * gridDim.z;
    unsigned sum, cnt, mine, sp = 0u;
    for (;;) {
        sum = 0u; cnt = 0u; mine = 0u;
#pragma unroll
        for (unsigned j = 0; j < 16; ++j) { const unsigned c = xb_ld(&bar[XB_XCNT(j)]); sum += c; cnt += (c > 0u) ? 1u : 0u; mine = (j == x) ? c : mine; }
        if (sum == G) break;
        __builtin_amdgcn_s_sleep(1);
        if ((++sp & 255u) == 0u) { if (xb_ld(&bar[XB_TMO])) break; if (sp > XB_SPIN_CAP) { atomicAdd(&bar[XB_TMO], 1u); break; } }
    }
    nloc = mine > 0u ? mine : 1u; nx = cnt > 0u ? cnt : 1u;
}
__device__ __forceinline__ void xcd_barrier(const XcdBarrier& b) {
    asm volatile("s_waitcnt vmcnt(0)" ::: "memory");
    __syncthreads();
    if (threadIdx.x == 0) {
        unsigned* bar = b.bar;
        __builtin_amdgcn_s_waitcnt(0);
        unsigned nloc = b.st[0], nx = b.st[1];
        if (nloc == 0u) { xcd_barrier_complete(bar, b.x, nloc, nx); b.st[0] = nloc; b.st[1] = nx; }
        const unsigned old = xb_add(&bar[XB_XSUB(b.x)], 1u);
        const unsigned gen = old / nloc;
        if (old + 1u == (gen + 1u) * nloc) {
            __builtin_amdgcn_fence(__ATOMIC_RELEASE, "agent");
            asm volatile("s_waitcnt vmcnt(0)" ::: "memory");
            const unsigned og = xb_add(&bar[XB_TOP], 1u);
            const unsigned tg = og / nx;
            if (og + 1u == (tg + 1u) * nx) xb_add(&bar[XB_TOPGEN], 1u);
            else XB_SPIN(xb_ld(&bar[XB_TOPGEN]) == tg, bar);
            __builtin_amdgcn_fence(__ATOMIC_ACQUIRE, "agent");
            xb_add(&bar[XB_XGEN(b.x)], 1u);
            asm volatile("s_waitcnt vmcnt(0)" ::: "memory");
        } else {
            XB_SPIN(xb_ld(&bar[XB_XGEN(b.x)]) == gen, bar);
            __builtin_amdgcn_fence(__ATOMIC_ACQUIRE, "agent");
            asm volatile("s_waitcnt vmcnt(0)" ::: "memory");
        }
    }
    __syncthreads();
}

struct Args { const void* in[28]; float* out; unsigned char* ws; int ph_lo, ph_hi, li, qoff, flags, pad; };
struct Frame {
    LAS unsigned char* lds;
    volatile LAS unsigned* MISC;
    gu32* ctl;
    int tid, lane, wave, vcu, G;
    const void* const* in; float* out; unsigned char* ws;
};
#define INF(k) ((const float*)F.in[k])
#define WSP(T, off) ((T*)(F.ws + (off)))
__device__ __forceinline__ float wave_sum(float v) {
#pragma unroll
    for (int o = 1; o < 64; o <<= 1) v += __shfl_xor(v, o);
    return v;
}
__device__ __forceinline__ int queue_pop(Frame& F, int q) {
    __syncthreads();
    if (F.tid == 0) F.MISC[16] = __hip_atomic_fetch_add(F.ctl + CW_QUEUE + 64 * q, 1u, RLX_AGENT);
    __syncthreads();
    return (int)F.MISC[16];
}

using pg8::Unit;
#define EPI_ARGS const f32x4 (&acc)[2][2][4][2], const Unit& u, int wr, int wc, int fr, int fq
__device__ __forceinline__ v4u pack8(f32x4 a, f32x4 b) { v4u w; w.x = pk2(a[0], a[1]); w.y = pk2(a[2], a[3]); w.z = pk2(b[0], b[1]); w.w = pk2(b[2], b[3]); return w; }
__device__ __forceinline__ void unpack8(v4u w, f32x4& a, f32x4& b) { a = (f32x4){bflo(w.x), bfhi(w.x), bflo(w.y), bfhi(w.y)}; b = (f32x4){bflo(w.z), bfhi(w.z), bflo(w.w), bfhi(w.w)}; }
__device__ __forceinline__ f32x4 sig4(f32x4 v) { return (f32x4){sigmoidf_(v[0]), sigmoidf_(v[1]), sigmoidf_(v[2]), sigmoidf_(v[3])}; }

struct EpiIn {
    static constexpr bool PERM = true, AFTER_DRAIN = false;
    bf16 *Q, *KB, *VB, *QI, *KI, *U, *SGA, *SGB; float* WI; const float* RS0; float* out;
    __device__ __forceinline__ void operator()(EPI_ARGS) const {
        const int row0 = u.pm * 256 + wr * 64 + fr, cl = wc * 32 + 8 * fq, pn = u.pn;
        if (pn < 4 || pn == 6 || pn == 7 || (pn >= 9 && pn < 13)) {
            bf16* base; int ldc, colt; float sc = 1.f;
            if (pn < 4) { base = Q; ldc = 1024; colt = pn * 256; sc = C2; } else if (pn < 8) { base = QI; ldc = 512; colt = (pn - 6) * 256; } else { base = U; ldc = 1024; colt = (pn - 9) * 256; }
#pragma unroll
            for (int ai = 0; ai < 2; ++ai)
#pragma unroll
                for (int m = 0; m < 4; ++m) { const int r = row0 + ai * 128 + m * 16; const float s = RS0[r] * sc; bf16* rowp = base + (size_t)r * ldc + colt + cl;
#pragma unroll
                    for (int bj = 0; bj < 2; ++bj) *(v4u*)(rowp + bj * 128) = pack8(acc[ai][bj][m][0] * s, acc[ai][bj][m][1] * s); }
        } else if (pn >= 13) {
            bf16* base = pn < 21 ? SGA : SGB; const int colt = (pn - (pn < 21 ? 13 : 21)) * 256;
#pragma unroll
            for (int ai = 0; ai < 2; ++ai)
#pragma unroll
                for (int m = 0; m < 4; ++m) { const int r = row0 + ai * 128 + m * 16; const float s = RS0[r]; bf16* rowp = base + (size_t)r * 2048 + colt + cl;
#pragma unroll
                    for (int bj = 0; bj < 2; ++bj) *(v4u*)(rowp + bj * 128) = pack8(sig4(acc[ai][bj][m][0] * s), sig4(acc[ai][bj][m][1] * s)); }
        } else if (pn == 4 || pn == 5) {
            bf16* cb = pn == 4 ? KB : VB; float* oP = out + (pn == 4 ? O_KP : O_VP); float* oS = out + (pn == 4 ? O_KS : O_VS);
#pragma unroll
            for (int ai = 0; ai < 2; ++ai)
#pragma unroll
                for (int m = 0; m < 4; ++m) { const int r = row0 + ai * 128 + m * 16; const float s = RS0[r]; float* orow = (r < MP ? oP + (size_t)r * 256 : oS + (size_t)(r - MP) * 256) + cl; bf16* crow_ = cb + (size_t)r * 256 + cl;
#pragma unroll
                    for (int bj = 0; bj < 2; ++bj) { const f32x4 v0 = acc[ai][bj][m][0] * s, v1 = acc[ai][bj][m][1] * s; *(f32x4*)(orow + bj * 128) = v0; *(f32x4*)(orow + bj * 128 + 4) = v1; *(v4u*)(crow_ + bj * 128) = pack8(v0, v1); } }
        } else if (pn == 8) {
            float* oP = out + O_KIP; float* oS = out + O_KIS;
#pragma unroll
            for (int ai = 0; ai < 2; ++ai)
#pragma unroll
                for (int m = 0; m < 4; ++m) { const int r = row0 + ai * 128 + m * 16; const float s = RS0[r]; const f32x4 v0 = acc[ai][0][m][0] * s, v1 = acc[ai][0][m][1] * s;
                    if (cl < 64) { float* orow = (r < MP ? oP + (size_t)r * 64 : oS + (size_t)(r - MP) * 64) + cl; *(f32x4*)orow = v0; *(f32x4*)(orow + 4) = v1; *(v4u*)(KI + (size_t)r * 64 + cl) = pack8(v0, v1); }
                    else if (cl == 64) { *(f32x4*)(WI + (size_t)r * 8) = v0; *(f32x4*)(WI + (size_t)r * 8 + 4) = v1; } }
        }
    }
};
struct EpiGlu {
    static constexpr bool PERM = true, AFTER_DRAIN = false;
    const bf16* SGB; bf16* MRG;
    __device__ __forceinline__ void operator()(EPI_ARGS) const {
        const int row0 = u.pm * 256 + wr * 64 + fr, col = u.pn * 128 + wc * 32 + 8 * fq;
#pragma unroll
        for (int ai = 0; ai < 2; ++ai)
#pragma unroll
            for (int m = 0; m < 4; ++m) { const size_t off = (size_t)(row0 + ai * 128 + m * 16) * 2048 + col; f32x4 g0, g1; unpack8(*(const v4u*)(SGB + off), g0, g1);
                const f32x4 y0 = acc[ai][0][m][0] * sig4(acc[ai][1][m][0]) * g0, y1 = acc[ai][0][m][1] * sig4(acc[ai][1][m][1]) * g1;
                *(v4u*)(MRG + off) = pack8(y0, y1); }
    }
};
struct EpiProj {
    static constexpr bool PERM = true, AFTER_DRAIN = false;
    const bf16* SGA; bf16* MRG;
    __device__ __forceinline__ void operator()(EPI_ARGS) const {
        const int row0 = u.pm * 256 + wr * 64 + fr, col = u.pn * 256 + wc * 32 + 8 * fq;
#pragma unroll
        for (int ai = 0; ai < 2; ++ai)
#pragma unroll
            for (int m = 0; m < 4; ++m)
#pragma unroll
                for (int bj = 0; bj < 2; ++bj) { const size_t off = (size_t)(row0 + ai * 128 + m * 16) * 2048 + col + bj * 128; f32x4 g0, g1, p0, p1; unpack8(*(const v4u*)(SGA + off), g0, g1); unpack8(*(const v4u*)(MRG + off), p0, p1);
                    *(v4u*)(MRG + off) = pack8(p0 + g0 * acc[ai][bj][m][0], p1 + g1 * acc[ai][bj][m][1]); }
    }
};
struct EpiOut {
    static constexpr bool PERM = true, AFTER_DRAIN = false;
    const float *xP, *xS; float* out; bf16* X1B; float* SS1;
    __device__ __forceinline__ void operator()(EPI_ARGS) const {
        const int row0 = u.pm * 256 + wr * 64 + fr, col = u.pn * 256 + wc * 32 + 8 * fq;
#pragma unroll
        for (int ai = 0; ai < 2; ++ai) {
            f32x4 xv[4][2][2];
#pragma unroll
            for (int m = 0; m < 4; ++m) { const int r = row0 + ai * 128 + m * 16; const float* xrow = (r < MP ? xP + (size_t)r * 2048 : xS + (size_t)(r - MP) * 2048) + col;
#pragma unroll
                for (int bj = 0; bj < 2; ++bj) { xv[m][bj][0] = *(const f32x4*)(xrow + bj * 128); xv[m][bj][1] = *(const f32x4*)(xrow + bj * 128 + 4); } }
#pragma unroll
            for (int m = 0; m < 4; ++m) { const int r = row0 + ai * 128 + m * 16; float* yrow = out + (size_t)r * 2048 + col;
                float ss = 0.f;
#pragma unroll
                for (int bj = 0; bj < 2; ++bj) { const f32x4 v0 = xv[m][bj][0] + acc[ai][bj][m][0], v1 = xv[m][bj][1] + acc[ai][bj][m][1];
                    *(f32x4*)(yrow + bj * 128) = v0; *(f32x4*)(yrow + bj * 128 + 4) = v1; *(v4u*)(X1B + (size_t)r * 2048 + col + bj * 128) = pack8(v0, v1);
                    ss += (v0[0] * v0[0] + v0[1] * v0[1]) + (v0[2] * v0[2] + v0[3] * v0[3]) + (v1[0] * v1[0] + v1[1] * v1[1]) + (v1[2] * v1[2] + v1[3] * v1[3]); }
                ss += __shfl_xor(ss, 16); ss += __shfl_xor(ss, 32);
                if (fq == 0) SS1[(size_t)r * 32 + u.pn * 4 + wc] = ss; }
        }
    }
};
__device__ __forceinline__ float row_rs(const float* part) {
    const f32x4* p = (const f32x4*)part; float s = 0.f;
#pragma unroll
    for (int i = 0; i < 8; ++i) { const f32x4 v = p[i]; s += (v[0] + v[1]) + (v[2] + v[3]); }
    return 1.0f / sqrtf(s * (1.0f / 2048.0f) + EPS_);
}
struct EpiUp {
    static constexpr bool PERM = true, AFTER_DRAIN = false;
    const float* SS1; bf16* UP; float* out;
    __device__ __forceinline__ void operator()(EPI_ARGS) const {
        const int row0 = u.pm * 256 + wr * 64 + fr, cl = wc * 32 + 8 * fq, lane = fr + 16 * fq;
        const float rsA = row_rs(SS1 + (size_t)(u.pm * 256 + wr * 64 + lane) * 32), rsB = row_rs(SS1 + (size_t)(u.pm * 256 + 128 + wr * 64 + lane) * 32);
        float rs[2][4];
#pragma unroll
        for (int m = 0; m < 4; ++m) { rs[0][m] = __shfl(rsA, 16 * m + fr); rs[1][m] = __shfl(rsB, 16 * m + fr); }
#pragma unroll
        for (int ai = 0; ai < 2; ++ai)
#pragma unroll
            for (int m = 0; m < 4; ++m) { const int r = row0 + ai * 128 + m * 16; const float s = rs[ai][m]; bf16* rowp = UP + (size_t)r * DFF2 + u.pn * 256 + cl;
                float* cdst = nullptr;
                if (r < MP) { const int t = r & 2047; if (t >= 2046) cdst = out + O_CP + (size_t)((r >> 11) * 2 + (t - 2046)) * DFF2; }
                else { const int t = (r - MP) & 3; if (t >= 2) cdst = out + O_CS + (size_t)(((r - MP) >> 2) * 2 + (t - 2)) * DFF2; }
#pragma unroll
                for (int bj = 0; bj < 2; ++bj) { const f32x4 v0 = acc[ai][bj][m][0] * s, v1 = acc[ai][bj][m][1] * s; *(v4u*)(rowp + bj * 128) = pack8(v0, v1);
                    if (cdst) { float* d = cdst + (bj ? DFF : 0) + u.pn * 128 + cl; *(f32x4*)d = v0; *(f32x4*)(d + 4) = v1; } } }
    }
};
struct EpiDown {
    static constexpr bool PERM = true, AFTER_DRAIN = false;
    float* out;
    __device__ __forceinline__ void operator()(EPI_ARGS) const {
        const int row0 = u.pm * 256 + wr * 64 + fr, col = u.pn * 256 + wc * 32 + 8 * fq;
#pragma unroll
        for (int ai = 0; ai < 2; ++ai) {
            f32x4 yv[4][2][2];
#pragma unroll
            for (int m = 0; m < 4; ++m) { const float* yrow = out + (size_t)(row0 + ai * 128 + m * 16) * 2048 + col;
#pragma unroll
                for (int bj = 0; bj < 2; ++bj) { yv[m][bj][0] = *(const f32x4*)(yrow + bj * 128); yv[m][bj][1] = *(const f32x4*)(yrow + bj * 128 + 4); } }
#pragma unroll
            for (int m = 0; m < 4; ++m) { float* yrow = out + (size_t)(row0 + ai * 128 + m * 16) * 2048 + col;
#pragma unroll
                for (int bj = 0; bj < 2; ++bj) { *(f32x4*)(yrow + bj * 128) = yv[m][bj][0] + acc[ai][bj][m][0]; *(f32x4*)(yrow + bj * 128 + 4) = yv[m][bj][1] + acc[ai][bj][m][1]; } }
        }
    }
};
struct OrderGlu {
    int c;
    __device__ __forceinline__ bool next(int i, Unit& u) const {
        if (i < 2) { const int x = c & 7, ii = c >> 3; u.pm = 4 * x + (ii >> 3); u.pn = 2 * (ii & 7) + i; u.kofs = 0; return true; }
        return false; }
    __device__ __forceinline__ void a_ready(const Unit&) const {}
    __device__ __forceinline__ void done(const Unit&) const {}
};
struct OrderProj {
    int c;
    __device__ __forceinline__ bool next(int i, Unit& u) const {
        if (i == 0) { const int x = c & 7, ii = c >> 3; u.pm = 4 * x + (ii >> 3); u.pn = ii & 7; u.kofs = 0; return true; }
        return false; }
    __device__ __forceinline__ void a_ready(const Unit&) const {}
    __device__ __forceinline__ void done(const Unit&) const {}
};

template <int MAT> __device__ __forceinline__ int colmap(int n) {
    if (MAT == 0) return n < 2120 ? n : (n < 2304 ? -1 : n - 184);
    if (MAT == 2) { const int j = n >> 8, i = n & 255; return i < 128 ? 128 * j + i : 2048 + 128 * j + (i - 128); }
    if (MAT == 4) { const int j = n >> 8, i = n & 255; return i < 128 ? 128 * j + i : DFF + 128 * j + (i - 128); }
    return n;
}
template <int MAT> __device__ __forceinline__ void p0_transpose_item(const float* W, int K, int Nsrc, int Nrows, const float* gain, bf16* WT, LAS float* scr, int item, int lane) {
    const int nblk = Nrows / 64, kb = item / nblk, nb = item % nblk, k0 = 64 * kb, n0 = 64 * nb;
    const int c4 = lane & 15, kr = lane >> 4;
    const int nc = colmap<MAT>(n0 + 4 * c4);
    f32x4 v[16];
#pragma unroll
    for (int i = 0; i < 16; ++i) { const int kk = 4 * i + kr; v[i] = (f32x4){0.f, 0.f, 0.f, 0.f}; if (nc >= 0) v[i] = *(const f32x4*)(W + (size_t)(k0 + kk) * Nsrc + nc); }
#pragma unroll
    for (int i = 0; i < 16; ++i) { const int kk = 4 * i + kr; f32x4 t = v[i]; if (gain) t = t * gain[k0 + kk];
        scr[kk * 65 + 4 * c4 + 0] = t[0]; scr[kk * 65 + 4 * c4 + 1] = t[1]; scr[kk * 65 + 4 * c4 + 2] = t[2]; scr[kk * 65 + 4 * c4 + 3] = t[3]; }
    LDS_WAIT(); asm volatile("" ::: "memory");
    const int c = lane & 7;
#pragma unroll
    for (int j = 0; j < 8; ++j) { const int n = (lane >> 3) + 8 * j; const LAS float* s = scr + (8 * c) * 65 + n;
        v4u o; o.x = pk2(s[0 * 65], s[1 * 65]); o.y = pk2(s[2 * 65], s[3 * 65]); o.z = pk2(s[4 * 65], s[5 * 65]); o.w = pk2(s[6 * 65], s[7 * 65]);
        *(GAS v4u*)(WT + (size_t)(n0 + n) * K + k0 + 8 * c) = o; }
    LDS_WAIT(); asm volatile("" ::: "memory");
}
__device__ __forceinline__ void p0_prologue(Frame& F) {
    LAS float* scr = (LAS float*)(F.lds + RING_OFF + F.wave * 17408);
    const int gw = F.vcu * 8 + F.wave, NGW = F.G * 8;
    constexpr int I0 = 32 * (NIN / 64), I1 = 16 * 32, I2 = 16 * 64, I3 = 32 * 32, I4 = 32 * (DFF2 / 64), I5 = 88 * 32;
    constexpr int NITEMS = I0 + I1 + I2 + I3 + I4 + I5;
    for (int m = gw; m < MROWS; m += NGW) {
        const float* xrow = m < MP ? INF(0) + (size_t)m * 2048 : INF(1) + (size_t)(m - MP) * 2048;
        const GAS f32x4* xr = (const GAS f32x4*)xrow + F.lane; f32x4 v[8]; float s = 0.f;
#pragma unroll
        for (int j = 0; j < 8; ++j) { v[j] = xr[64 * j]; s += (v[j][0] * v[j][0] + v[j][1] * v[j][1]) + (v[j][2] * v[j][2] + v[j][3] * v[j][3]); }
        s = wave_sum(s);
        GAS v2u* o8 = (GAS v2u*)(WSP(bf16, WS_XB) + (size_t)m * 2048) + F.lane;
#pragma unroll
        for (int j = 0; j < 8; ++j) { v2u w; w.x = pk2(v[j][0], v[j][1]); w.y = pk2(v[j][2], v[j][3]); o8[64 * j] = w; }
        if (F.lane == 0) WSP(float, WS_RS0)[m] = 1.0f / sqrtf(s * (1.0f / 2048.0f) + EPS_);
    }
    for (int it = gw; it < NITEMS; it += NGW) {
        int r = it;
        if (r < I0) { p0_transpose_item<0>(INF(10), 2048, 7240, NIN, INF(9), WSP(bf16, WS_WIN), scr, r, F.lane); continue; } r -= I0;
        if (r < I1) { p0_transpose_item<1>(INF(11), 1024, 2048, 2048, nullptr, WSP(bf16, WS_WP), scr, r, F.lane); continue; } r -= I1;
        if (r < I2) { p0_transpose_item<2>(INF(20), 1024, 4096, 4096, nullptr, WSP(bf16, WS_WG), scr, r, F.lane); continue; } r -= I2;
        if (r < I3) { p0_transpose_item<3>(INF(21), 2048, 2048, 2048, nullptr, WSP(bf16, WS_WO), scr, r, F.lane); continue; } r -= I3;
        if (r < I4) { p0_transpose_item<4>(INF(23), 2048, DFF2, DFF2, INF(22), WSP(bf16, WS_WUP), scr, r, F.lane); continue; } r -= I4;
        p0_transpose_item<5>(INF(26), DFF, 2048, 2048, nullptr, WSP(bf16, WS_WDN), scr, r, F.lane);
    }
}

#define MFMA32(a, b, c) __builtin_amdgcn_mfma_f32_32x32x16_bf16((a), (b), (c), 0, 0, 0)
__device__ __forceinline__ s16x4 tr_read(unsigned lds_addr) { s16x4 r; asm volatile("ds_read_b64_tr_b16 %0, %1\n\ts_waitcnt lgkmcnt(0)" : "=&v"(r) : "v"(lds_addr) : "memory"); return r; }
__device__ __forceinline__ float gelu_tanh(float x) {
    const float t = 1.5957691216057308f * (x + 0.044715f * x * x * x);
    return x * sigmoidf_(t);
}
struct S5Const { bf16x8 Bf[2][2]; bf16x8 Cf[8]; bf16x8 Df; float lbr[2], lbi[2]; };
__device__ __forceinline__ void s5_consts(Frame& F, int g, S5Const& C) {
    const int r32 = F.lane & 31, hi = F.lane >> 5;
    const float step = expf(INF(14)[g]);
#pragma unroll
    for (int pg = 0; pg < 2; ++pg) {
        const int p = 32 * pg + r32; const float ar = INF(12)[g * 64 + p], ai = INF(13)[g * 64 + p];
        const float e = expf(ar * step), lr = e * cosf(ai * step), li = e * sinf(ai * step);
        C.lbr[pg] = lr; C.lbi[pg] = li;
        const float den = 1.0f / (ar * ar + ai * ai), cr = ((lr - 1.f) * ar + li * ai) * den, ci = (li * ar - (lr - 1.f) * ai) * den;
        const float* bre = INF(15) + (size_t)(g * 64 + p) * 16 + 8 * hi; const float* bim = INF(16) + (size_t)(g * 64 + p) * 16 + 8 * hi;
#pragma unroll
        for (int j = 0; j < 8; ++j) { const float br = bre[j], bi = bim[j]; C.Bf[pg][0][j] = (short)f2bf(cr * br - ci * bi); C.Bf[pg][1][j] = (short)f2bf(cr * bi + ci * br); }
    }
#pragma unroll
    for (int s = 0; s < 8; ++s)
#pragma unroll
        for (int j = 0; j < 8; ++j) { const int kap = 16 * s + 8 * hi + j, blk = kap >> 5, p = 32 * (blk & 1) + (kap & 31); float v = 0.f;
            if (r32 < 16) v = (blk < 2) ? INF(17)[(size_t)(g * 16 + r32) * 64 + p] : -INF(18)[(size_t)(g * 16 + r32) * 64 + p];
            C.Cf[s][j] = (short)f2bf(v); }
#pragma unroll
    for (int j = 0; j < 8; ++j) C.Df[j] = (short)((r32 < 16 && 8 * hi + j == r32) ? f2bf(INF(19)[g * 16 + r32]) : 0u);
}
__device__ __forceinline__ f32x16 s5_ytile(const f32x16 (&x)[4], const bf16x8& ua, const S5Const& C, LAS unsigned char* img, int lane) {
    const int r32 = lane & 31, hi = lane >> 5;
#pragma unroll
    for (int blk = 0; blk < 4; ++blk)
#pragma unroll
        for (int g4 = 0; g4 < 4; ++g4) { v2u w; w.x = pk2(x[blk][4 * g4], x[blk][4 * g4 + 1]); w.y = pk2(x[blk][4 * g4 + 2], x[blk][4 * g4 + 3]);
            *(LAS v2u*)(img + (32 * blk + r32) * 64 + 8 * (2 * g4 + hi)) = w; }
    LDS_WAIT(); asm volatile("" ::: "memory");
    const unsigned base = (unsigned)(size_t)img;
    const int i16 = lane & 15, q = i16 >> 2, p = i16 & 3, bk = (lane >> 4) & 1;
    f32x16 y = {};
#pragma unroll
    for (int s = 0; s < 8; ++s) {
        const s16x4 lo = tr_read(base + (16 * s + 8 * hi + q) * 64 + 8 * (4 * bk + p));
        const s16x4 hh = tr_read(base + (16 * s + 8 * hi + 4 + q) * 64 + 8 * (4 * bk + p));
        const bf16x8 xa = __builtin_shufflevector(lo, hh, 0, 1, 2, 3, 4, 5, 6, 7);
        y = MFMA32(xa, C.Cf[s], y);
    }
    y = MFMA32(ua, C.Df, y);
    return y;
}
__device__ __forceinline__ void s5_unit(Frame& F, int bp, int g) {
    const int lane = F.lane, w = F.wave, r32 = lane & 31, hi = lane >> 5;
    LAS unsigned char* img = F.lds + w * 8192;
    LAS float* EL = (LAS float*)(F.lds + 65536);
    S5Const C; s5_consts(F, g, C);
    const bf16* U = WSP(bf16, WS_U); bf16* Z = WSP(bf16, WS_Z);
    const int rho = r32, rb = 2 * bp + ((rho >> 2) & 1), rtau = (rho & 3) + 4 * (rho >> 3);
    const bf16* ubase = U + (size_t)(rb * 2048 + 256 * w + rtau) * 1024 + g * 16 + 8 * hi;
    float xr[2] = {0.f, 0.f}, xi[2] = {0.f, 0.f};
    for (int tt = 0; tt < 16; ++tt) {
        const bf16x8 ua = *(const bf16x8*)(ubase + (size_t)tt * 16 * 1024);
        f32x16 acc[4];
#pragma unroll
        for (int blk = 0; blk < 4; ++blk) acc[blk] = MFMA32(ua, C.Bf[blk & 1][blk >> 1], (f32x16){});
#pragma unroll
        for (int pg = 0; pg < 2; ++pg)
#pragma unroll
            for (int r = 0; r < 16; ++r) { const float nr = C.lbr[pg] * xr[pg] - C.lbi[pg] * xi[pg] + acc[pg][r], ni = C.lbr[pg] * xi[pg] + C.lbi[pg] * xr[pg] + acc[2 + pg][r]; xr[pg] = nr; xi[pg] = ni; }
    }
#pragma unroll
    for (int pg = 0; pg < 2; ++pg) { EL[(w * 4 + pg * 2 + 0) * 64 + lane] = xr[pg]; EL[(w * 4 + pg * 2 + 1) * 64 + lane] = xi[pg]; }
    __syncthreads();
#pragma unroll
    for (int pg = 0; pg < 2; ++pg) {
        float pr = C.lbr[pg], pi = C.lbi[pg];
#pragma unroll
        for (int k = 0; k < 8; ++k) { const float nr = pr * pr - pi * pi, ni = 2.f * pr * pi; pr = nr; pi = ni; }
        float cr = 0.f, ci = 0.f;
        for (int ww = 0; ww < w; ++ww) { const float er = EL[(ww * 4 + pg * 2 + 0) * 64 + lane], ei = EL[(ww * 4 + pg * 2 + 1) * 64 + lane];
            const float nr = pr * cr - pi * ci + er, ni = pr * ci + pi * cr + ei; cr = nr; ci = ni; }
        xr[pg] = cr; xi[pg] = ci;
    }
    for (int tt = 0; tt < 16; ++tt) {
        const bf16x8 ua = *(const bf16x8*)(ubase + (size_t)tt * 16 * 1024);
        f32x16 acc[4];
#pragma unroll
        for (int blk = 0; blk < 4; ++blk) acc[blk] = MFMA32(ua, C.Bf[blk & 1][blk >> 1], (f32x16){});
#pragma unroll
        for (int pg = 0; pg < 2; ++pg)
#pragma unroll
            for (int r = 0; r < 16; ++r) { const float nr = C.lbr[pg] * xr[pg] - C.lbi[pg] * xi[pg] + acc[pg][r], ni = C.lbr[pg] * xi[pg] + C.lbi[pg] * xr[pg] + acc[2 + pg][r]; xr[pg] = nr; xi[pg] = ni; acc[pg][r] = nr; acc[2 + pg][r] = ni; }
        const f32x16 y = s5_ytile(acc, ua, C, img, lane);
        if (r32 < 16) {
#pragma unroll
            for (int r = 0; r < 16; ++r) { const int orho = (r & 3) + 8 * (r >> 2) + 4 * hi, ob = 2 * bp + ((orho >> 2) & 1), otau = (orho & 3) + 4 * (orho >> 3);
                Z[(size_t)(ob * 2048 + 256 * w + 16 * tt + otau) * 1024 + g * 16 + r32] = (bf16)f2bf(gelu_tanh(y[r])); }
        }
        LDS_WAIT(); asm volatile("" ::: "memory");
    }
    if (w == 7) {
#pragma unroll
        for (int pg = 0; pg < 2; ++pg) { const size_t o = (size_t)((2 * bp + hi) * 64 + g) * 64 + 32 * pg + r32; F.out[O_SRP + o] = xr[pg]; F.out[O_SIP + o] = xi[pg]; }
    }
    {
        const int T = 8 * bp + w;
        const bf16x8 ua = *(const bf16x8*)(U + (size_t)(MP + 32 * T + r32) * 1024 + g * 16 + 8 * hi);
        f32x16 acc[4];
#pragma unroll
        for (int blk = 0; blk < 4; ++blk) acc[blk] = MFMA32(ua, C.Bf[blk & 1][blk >> 1], (f32x16){});
#pragma unroll
        for (int pg = 0; pg < 2; ++pg)
#pragma unroll
            for (int k4 = 0; k4 < 4; ++k4) { const size_t so = (size_t)((8 * T + 2 * k4 + hi) * 64 + g) * 64 + 32 * pg + r32; float sr = INF(5)[so], si = INF(6)[so];
#pragma unroll
                for (int t = 0; t < 4; ++t) { const int r = 4 * k4 + t; const float nr = C.lbr[pg] * sr - C.lbi[pg] * si + acc[pg][r], ni = C.lbr[pg] * si + C.lbi[pg] * sr + acc[2 + pg][r]; sr = nr; si = ni; acc[pg][r] = nr; acc[2 + pg][r] = ni; }
                F.out[O_SRS + so] = sr; F.out[O_SIS + so] = si; }
        const f32x16 y = s5_ytile(acc, ua, C, img, lane);
        if (r32 < 16) {
#pragma unroll
            for (int r = 0; r < 16; ++r) { const int orho = (r & 3) + 8 * (r >> 2) + 4 * hi; Z[(size_t)(MP + 32 * T + orho) * 1024 + g * 16 + r32] = (bf16)f2bf(gelu_tanh(y[r])); }
        }
        LDS_WAIT();
    }
    __syncthreads();
}

__device__ __forceinline__ unsigned wave_incl_scan(unsigned v, int lane) {
#pragma unroll
    for (int o = 1; o < 64; o <<= 1) { const unsigned t = __shfl_up(v, o); if (lane >= o) v += t; }
    return v;
}
__device__ __forceinline__ unsigned fkey(float f) { const unsigned u = __float_as_uint(f); return (u & 0x80000000u) ? ~u : (u | 0x80000000u); }
template <int MODE> __device__ __forceinline__ void select_query(const float* row, int n_valid, LAS unsigned* hist  , LAS unsigned* mwords  , unsigned* mout, int q32, unsigned* list, int lane) {
    constexpr int NJ = MODE == 0 ? 8 : 9;
    const int L = (n_valid + 255) >> 8;
    unsigned key[NJ][4];
#pragma unroll
    for (int j = 0; j < NJ; ++j) {
        f32x4 v = {0.f, 0.f, 0.f, 0.f};
        if (j < L) v = *(const f32x4*)(row + 256 * j + 4 * lane);
#pragma unroll
        for (int i = 0; i < 4; ++i) { const int kv = 256 * j + 4 * lane + i; key[j][i] = (j < L && kv < n_valid) ? fkey(v[i]) : 0u; }
    }
    unsigned T = 0u, need = 256u; bool all = (n_valid <= 256);
    if (!all) {
#pragma unroll 1
        for (int lvl = 3; lvl >= 0; --lvl) {
            const int sh = 8 * lvl;
            hist[lane] = 0u; hist[64 + lane] = 0u; hist[128 + lane] = 0u; hist[192 + lane] = 0u;
            LDS_WAIT();
            const unsigned pmask = lvl == 3 ? 0u : (0xffffffffu << (sh + 8));
#pragma unroll
            for (int j = 0; j < NJ; ++j) if (j < L) {
#pragma unroll
                for (int i = 0; i < 4; ++i) { const unsigned k = key[j][i]; if (k != 0u && ((k ^ T) & pmask) == 0u) __hip_atomic_fetch_add(&hist[(k >> sh) & 255u], 1u, __ATOMIC_RELAXED, __HIP_MEMORY_SCOPE_WORKGROUP); } }
            LDS_WAIT();
            const unsigned c0 = hist[4 * lane], c1 = hist[4 * lane + 1], c2 = hist[4 * lane + 2], c3 = hist[4 * lane + 3];
            const unsigned tl = c0 + c1 + c2 + c3, incl = wave_incl_scan(tl, lane), tot = __shfl(incl, 63);
            unsigned run = tot - incl;
            int fb = -1; unsigned fab = 0u;
            if (run < need && need <= run + c3) { fb = 4 * lane + 3; fab = run; } run += c3;
            if (fb < 0 && run < need && need <= run + c2) { fb = 4 * lane + 2; fab = run; } run += c2;
            if (fb < 0 && run < need && need <= run + c1) { fb = 4 * lane + 1; fab = run; } run += c1;
            if (fb < 0 && run < need && need <= run + c0) { fb = 4 * lane + 0; fab = run; }
            const unsigned long long bal = __ballot(fb >= 0);
            const int src = bal ? (int)__builtin_ctzll(bal) : 0;
            const int bsel = __shfl(fb, src); const unsigned above = __shfl(fab, src);
            T |= ((unsigned)(bsel < 0 ? 0 : bsel)) << sh; need -= above;
            LDS_WAIT();
        }
    }
    unsigned eqtot = 0u;
    if (!all) { unsigned c = 0u;
#pragma unroll
        for (int j = 0; j < NJ; ++j)
#pragma unroll
            for (int i = 0; i < 4; ++i) c += (key[j][i] == T) ? 1u : 0u;
        eqtot = __shfl(wave_incl_scan(c, lane), 63); }
    const bool ties = !all && eqtot != need;
    unsigned nib[NJ]; unsigned ebase = 0u;
#pragma unroll
    for (int j = 0; j < NJ; ++j) {
        unsigned nb = 0u;
        if (all) {
#pragma unroll
            for (int i = 0; i < 4; ++i) nb |= (key[j][i] != 0u) ? (1u << i) : 0u;
        } else if (!ties) {
#pragma unroll
            for (int i = 0; i < 4; ++i) nb |= (key[j][i] >= T && key[j][i] != 0u) ? (1u << i) : 0u;
        } else {
            unsigned cnt = 0u;
#pragma unroll
            for (int i = 0; i < 4; ++i) cnt += (key[j][i] == T) ? 1u : 0u;
            const unsigned incl = wave_incl_scan(cnt, lane); unsigned run = ebase + incl - cnt; ebase += __shfl(incl, 63);
#pragma unroll
            for (int i = 0; i < 4; ++i) { const bool e = key[j][i] == T; if (key[j][i] > T || (e && run < need)) nb |= 1u << i; run += e ? 1u : 0u; }
        }
        nib[j] = nb;
    }
    if (MODE == 0) {
        mwords[lane] = 0u; LDS_WAIT();
#pragma unroll
        for (int j = 0; j < 8; ++j) if (nib[j]) __hip_atomic_fetch_or(&mwords[(lane & 1) * 32 + 4 * j + (lane >> 4)], nib[j] << (4 * ((lane & 15) >> 1)), __ATOMIC_RELAXED, __HIP_MEMORY_SCOPE_WORKGROUP);
        LDS_WAIT();
        const unsigned wv = mwords[lane];
        mout[((lane & 31) * 2 + (lane >> 5)) * 32 + q32] = wv;
        LDS_WAIT();
    } else {
        unsigned base = 0u;
#pragma unroll
        for (int j = 0; j < NJ; ++j) { const unsigned cnt = __builtin_popcount(nib[j]); const unsigned incl = wave_incl_scan(cnt, lane); unsigned pos = base + incl - cnt; base += __shfl(incl, 63);
#pragma unroll
            for (int i = 0; i < 4; ++i) if ((nib[j] >> i) & 1u) { if (pos < 256u) list[pos] = (unsigned)(256 * j + 4 * lane + i); ++pos; } }
    }
}
__device__ __forceinline__ float dpp_sum8(float v) {
    v += __uint_as_float(__builtin_amdgcn_update_dpp(0u, __float_as_uint(v), 0xB1, 0xf, 0xf, true));
    v += __uint_as_float(__builtin_amdgcn_update_dpp(0u, __float_as_uint(v), 0x4E, 0xf, 0xf, true));
    v += __uint_as_float(__builtin_amdgcn_update_dpp(0u, __float_as_uint(v), 0x141, 0xf, 0xf, true));
    return v;
}
__device__ __forceinline__ float dpp_sum16(float v) {
    v = dpp_sum8(v);
    v += __uint_as_float(__builtin_amdgcn_update_dpp(0u, __float_as_uint(v), 0x140, 0xf, 0xf, true));
    return v;
}
__device__ __forceinline__ float dpp_max16(float v) {
    v = fmaxf(v, __uint_as_float(__builtin_amdgcn_update_dpp(0u, __float_as_uint(v), 0xB1, 0xf, 0xf, true)));
    v = fmaxf(v, __uint_as_float(__builtin_amdgcn_update_dpp(0u, __float_as_uint(v), 0x4E, 0xf, 0xf, true)));
    v = fmaxf(v, __uint_as_float(__builtin_amdgcn_update_dpp(0u, __float_as_uint(v), 0x141, 0xf, 0xf, true)));
    v = fmaxf(v, __uint_as_float(__builtin_amdgcn_update_dpp(0u, __float_as_uint(v), 0x140, 0xf, 0xf, true)));
    return v;
}
constexpr float IDX_SCALE = 0.125f * 0.35355339059327373f;
constexpr int QIL_PITCH = 1040;
__device__ __forceinline__ void idx_unit_prompt(Frame& F, int b, int qb) {
    const int lane = F.lane, w = F.wave, r32 = lane & 31, hi = lane >> 5;
    const int R0 = b * 2048 + 32 * qb;
    const bf16* QI = WSP(bf16, WS_QI); const bf16* KI = WSP(bf16, WS_KI); float* SC = WSP(float, WS_SCP);
    LAS unsigned char* qil = F.lds;
    LAS unsigned* hist = (LAS unsigned*)(F.lds + 40960) + w * 256;
    LAS unsigned* mw = (LAS unsigned*)(F.lds + 49152) + w * 64;
    { const int row = F.tid >> 4, ch = F.tid & 15; const v4u* src = (const v4u*)(QI + (size_t)(R0 + row) * 512) + ch * 4;
#pragma unroll
      for (int i = 0; i < 4; ++i) *(LAS v4u*)(qil + row * QIL_PITCH + (ch * 4 + i) * 16) = src[i]; }
    float wq[8];
    { const f32x4 a = *(const f32x4*)(WSP(float, WS_WI) + (size_t)(R0 + r32) * 8), c = *(const f32x4*)(WSP(float, WS_WI) + (size_t)(R0 + r32) * 8 + 4);
#pragma unroll
      for (int h = 0; h < 4; ++h) { wq[h] = a[h] * IDX_SCALE; wq[4 + h] = c[h] * IDX_SCALE; } }
    __syncthreads();
    for (int kb = w; kb <= qb; kb += 8) {
        bf16x8 af[4];
#pragma unroll
        for (int ks = 0; ks < 4; ++ks) af[ks] = *(const bf16x8*)(KI + (size_t)(b * 2048 + 32 * kb + r32) * 64 + 16 * ks + 8 * hi);
        f32x16 sc = {};
#pragma unroll 1
        for (int h = 0; h < 8; ++h) {
            f32x16 acc = {}; const float wqh = wq[h];
#pragma unroll
            for (int ks = 0; ks < 4; ++ks) { const bf16x8 bfr = *(const LAS bf16x8*)(qil + r32 * QIL_PITCH + h * 128 + ks * 32 + hi * 16); acc = MFMA32(af[ks], bfr, acc); }
#pragma unroll
            for (int r = 0; r < 16; ++r) sc[r] += fmaxf(acc[r], 0.f) * wqh;
        }
#pragma unroll
        for (int k4 = 0; k4 < 4; ++k4) *(f32x4*)(SC + (size_t)(R0 + r32) * 2048 + 32 * kb + 8 * k4 + 4 * hi) = (f32x4){sc[4 * k4], sc[4 * k4 + 1], sc[4 * k4 + 2], sc[4 * k4 + 3]};
    }
    VM_WAIT(); __syncthreads();
    unsigned* mout = WSP(unsigned, WS_MASK) + (size_t)(b * 64 + qb) * 2048;
    for (int qq = w; qq < 32; qq += 8) select_query<0>(SC + (size_t)(R0 + qq) * 2048, 32 * qb + qq + 1, hist, mw, mout, qq, nullptr, lane);
    __syncthreads();
}
__device__ __forceinline__ void idx_unit_sample(Frame& F, int b) {
    const int lane = F.lane, w = F.wave, r32 = lane & 31, hi = lane >> 5, t = r32 >> 3, h = r32 & 7;
    const bf16* QI = WSP(bf16, WS_QI); const bf16* KI = WSP(bf16, WS_KI); float* SC = WSP(float, WS_SCS);
    LAS unsigned* hist = (LAS unsigned*)(F.lds + 40960) + w * 256;
    const int* PTB = (const int*)F.in[8] + b * 16;
    bf16x8 bfr[4];
#pragma unroll
    for (int ks = 0; ks < 4; ++ks) bfr[ks] = *(const bf16x8*)(QI + (size_t)(MP + 4 * b + t) * 512 + h * 64 + 16 * ks + 8 * hi);
    const float wq = WSP(float, WS_WI)[(size_t)(MP + 4 * b + t) * 8 + h] * IDX_SCALE;
    for (int kb = w; kb < 65; kb += 8) {
        bf16x8 af[4];
        if (kb < 64) {
            const int kv = 32 * kb + r32, page = PTB[kv >> 7];
            const float* src = INF(4) + ((size_t)page * 128 + (kv & 127)) * 64 + 8 * hi;
#pragma unroll
            for (int ks = 0; ks < 4; ++ks) { const f32x4 a = *(const f32x4*)(src + 16 * ks), c = *(const f32x4*)(src + 16 * ks + 4); const v4u pk = pack8(a, c); af[ks] = __builtin_bit_cast(bf16x8, pk); }
        } else {
#pragma unroll
            for (int ks = 0; ks < 4; ++ks) { v4u z = {0u, 0u, 0u, 0u}; if (r32 < 4) z = *(const v4u*)(KI + (size_t)(MP + 4 * b + r32) * 64 + 16 * ks + 8 * hi); af[ks] = __builtin_bit_cast(bf16x8, z); }
        }
        f32x16 acc = {};
#pragma unroll
        for (int ks = 0; ks < 4; ++ks) acc = MFMA32(af[ks], bfr[ks], acc);
        float v[16];
#pragma unroll
        for (int r = 0; r < 16; ++r) v[r] = dpp_sum8(fmaxf(acc[r], 0.f) * wq);
        f32x4 o = {v[0], v[1], v[2], v[3]};
        if (h == 1) o = (f32x4){v[4], v[5], v[6], v[7]}; else if (h == 2) o = (f32x4){v[8], v[9], v[10], v[11]}; else if (h == 3) o = (f32x4){v[12], v[13], v[14], v[15]};
        if (h < 4) *(f32x4*)(SC + (size_t)(4 * b + t) * SCS_PITCH + 32 * kb + 8 * h + 4 * hi) = o;
    }
    VM_WAIT(); __syncthreads();
    if (w < 4) select_query<1>(SC + (size_t)(4 * b + w) * SCS_PITCH, 2049 + w, hist, nullptr, nullptr, 0, WSP(unsigned, WS_LIST) + (size_t)(4 * b + w) * 256, lane);
    __syncthreads();
}

__device__ __forceinline__ void sattn_unit(Frame& F, int b, int t) {
    const int lane = F.lane, w = F.wave, n = lane >> 4, d4 = lane & 15;
    const int rs = 4 * b + t, row = MP + rs;
    const bf16* Q = WSP(bf16, WS_Q);
    LAS float* xm = (LAS float*)(F.lds);
    LAS float* xs = (LAS float*)(F.lds + 512);
    LAS float* pl = (LAS float*)(F.lds + 1024) + w * 512;
    LAS float* ored = (LAS float*)(F.lds + 1024 + 16384);
    float qv[4][4];
#pragma unroll
    for (int j = 0; j < 4; ++j) { const v2u qw = *(const v2u*)(Q + (size_t)row * 1024 + (4 * n + j) * 64 + 4 * d4); qv[j][0] = bflo(qw.x); qv[j][1] = bfhi(qw.x); qv[j][2] = bflo(qw.y); qv[j][3] = bfhi(qw.y); }
    const unsigned kvl = WSP(unsigned, WS_LIST)[(size_t)rs * 256 + 32 * w + (lane & 31)];
    const int page = ((const int*)F.in[8])[b * 16 + ((kvl < 2048u ? kvl : 0u) >> 7)];
    const unsigned long long coff = ((unsigned long long)page * 128ull + (kvl & 127u)) * 256ull;
    const unsigned long long noff = (unsigned long long)(4 * b + (int)(kvl < 2048u ? 0u : kvl - 2048u)) * 256ull;
    const bool isnew = kvl >= 2048u;
    float sv[4][2];
#pragma unroll
    for (int j = 0; j < 4; ++j) { sv[j][0] = 0.f; sv[j][1] = 0.f; }
#pragma unroll 1
    for (int half = 0; half < 2; ++half) {
        f32x4 kvec[16];
#pragma unroll
        for (int k = 0; k < 16; ++k) { const int e = 16 * half + k; const bool nw = __shfl((int)isnew, e) != 0; const unsigned long long o = nw ? __shfl(noff, e) : __shfl(coff, e);
            const float* base = nw ? (F.out + O_KS) : INF(2); kvec[k] = *(const f32x4*)(base + o + 4 * lane); }
#pragma unroll
        for (int k = 0; k < 16; ++k)
#pragma unroll
            for (int j = 0; j < 4; ++j) { float p = qv[j][0] * kvec[k][0] + qv[j][1] * kvec[k][1] + qv[j][2] * kvec[k][2] + qv[j][3] * kvec[k][3]; p = dpp_sum16(p); if (d4 == k) { if (half == 0) sv[j][0] = p; else sv[j][1] = p; } }
    }
    float mj[4], sj[4];
#pragma unroll
    for (int j = 0; j < 4; ++j) { mj[j] = dpp_max16(fmaxf(sv[j][0], sv[j][1])); if (d4 == 0) xm[w * 16 + 4 * n + j] = mj[j]; }
    __syncthreads();
#pragma unroll
    for (int j = 0; j < 4; ++j) { float m = xm[4 * n + j];
#pragma unroll
        for (int ww = 1; ww < 8; ++ww) m = fmaxf(m, xm[ww * 16 + 4 * n + j]);
        const float p0 = __builtin_amdgcn_exp2f(sv[j][0] - m), p1 = __builtin_amdgcn_exp2f(sv[j][1] - m);
        pl[d4 * 16 + 4 * n + j] = p0; pl[(16 + d4) * 16 + 4 * n + j] = p1;
        sj[j] = dpp_sum16(p0 + p1); if (d4 == 0) xs[w * 16 + 4 * n + j] = sj[j]; }
    LDS_WAIT();
    float o[4][4] = {};
#pragma unroll 1
    for (int half = 0; half < 2; ++half) {
        f32x4 vvec[16];
#pragma unroll
        for (int k = 0; k < 16; ++k) { const int e = 16 * half + k; const bool nw = __shfl((int)isnew, e) != 0; const unsigned long long of = nw ? __shfl(noff, e) : __shfl(coff, e);
            const float* base = nw ? (F.out + O_VS) : INF(3); vvec[k] = *(const f32x4*)(base + of + 4 * lane); }
#pragma unroll
        for (int k = 0; k < 16; ++k) { const f32x4 pj = *(const LAS f32x4*)(pl + (16 * half + k) * 16 + 4 * n);
#pragma unroll
            for (int j = 0; j < 4; ++j)
#pragma unroll
                for (int c = 0; c < 4; ++c) o[j][c] += pj[j] * vvec[k][c]; }
    }
#pragma unroll
    for (int j = 0; j < 4; ++j)
#pragma unroll
        for (int c = 0; c < 4; ++c) ored[(w * 16 + j * 4 + c) * 64 + lane] = o[j][c];
    __syncthreads();
    {
        const int part = w, j = part >> 1, c0 = 2 * (part & 1);
        float tot = 0.f;
#pragma unroll
        for (int ww = 0; ww < 8; ++ww) tot += xs[ww * 16 + 4 * n + j];
        float a0 = 0.f, a1 = 0.f;
#pragma unroll
        for (int ww = 0; ww < 8; ++ww) { a0 += ored[(ww * 16 + j * 4 + c0) * 64 + lane]; a1 += ored[(ww * 16 + j * 4 + c0 + 1) * 64 + lane]; }
        const float inv = 1.0f / tot;
        *(unsigned*)(WSP(bf16, WS_O) + (size_t)row * 1024 + (4 * n + j) * 64 + 4 * d4 + c0) = pk2(a0 * inv, a1 * inv);
    }
    __syncthreads();
}

__device__ __forceinline__ void p7_convgate(Frame& F) {
    const int gw = F.vcu * 8 + F.wave, NGW = F.G * 8;
    const bf16* UP = WSP(bf16, WS_UP); bf16* ACT = WSP(bf16, WS_ACT);
    const float* cw = INF(24); const float* cb = INF(25); const float* cst = INF(7);
    for (int it = gw; it < (MROWS / 32) * 11; it += NGW) {
        const int rb = it / 11, cg = it % 11, c = cg * 512 + F.lane * 8;
        const size_t ucol = (size_t)(c >> 7) * 256 + (c & 127);
        float wg[3][8], wv[3][8], bg[8], bv[8];
#pragma unroll
        for (int j = 0; j < 3; ++j)
#pragma unroll
            for (int e = 0; e < 8; ++e) { wg[j][e] = cw[(size_t)j * DFF2 + c + e]; wv[j][e] = cw[(size_t)j * DFF2 + DFF + c + e]; }
#pragma unroll
        for (int e = 0; e < 8; ++e) { bg[e] = cb[c + e]; bv[e] = cb[DFF + c + e]; }
        f32x4 g2[2], g1[2], v2[2], v1[2];
        const int r0 = rb * 32;
#define loadrow(r_, g_, v_) do { const v4u a_ = *(const v4u*)(UP + (size_t)(r_) * DFF2 + ucol), bb_ = *(const v4u*)(UP + (size_t)(r_) * DFF2 + ucol + 128); unpack8(a_, g_[0], g_[1]); unpack8(bb_, v_[0], v_[1]); } while (0)
        if (r0 < MP && (r0 & 2047) != 0) { loadrow(r0 - 2, g2, v2); loadrow(r0 - 1, g1, v1); }
        else { g2[0] = g2[1] = g1[0] = g1[1] = v2[0] = v2[1] = v1[0] = v1[1] = (f32x4){0.f, 0.f, 0.f, 0.f}; }
        for (int rr = 0; rr < 32; ++rr) {
            const int r = r0 + rr;
            if (r >= MP && ((r - MP) & 3) == 0) {
                const float* s0 = cst + (size_t)((r - MP) >> 2) * 2 * DFF2; const float* s1 = s0 + DFF2;
                g2[0] = *(const f32x4*)(s0 + c); g2[1] = *(const f32x4*)(s0 + c + 4); v2[0] = *(const f32x4*)(s0 + DFF + c); v2[1] = *(const f32x4*)(s0 + DFF + c + 4);
                g1[0] = *(const f32x4*)(s1 + c); g1[1] = *(const f32x4*)(s1 + c + 4); v1[0] = *(const f32x4*)(s1 + DFF + c); v1[1] = *(const f32x4*)(s1 + DFF + c + 4);
            }
            f32x4 g0[2], v0[2]; loadrow(r, g0, v0);
            float o[8];
#pragma unroll
            for (int e = 0; e < 8; ++e) { const int hh = e >> 2, ee = e & 3;
                const float gm = bg[e] + wg[0][e] * g2[hh][ee] + wg[1][e] * g1[hh][ee] + wg[2][e] * g0[hh][ee];
                const float vm = bv[e] + wv[0][e] * v2[hh][ee] + wv[1][e] * v1[hh][ee] + wv[2][e] * v0[hh][ee];
                o[e] = gm * sigmoidf_(gm) * vm; }
            v4u ow; ow.x = pk2(o[0], o[1]); ow.y = pk2(o[2], o[3]); ow.z = pk2(o[4], o[5]); ow.w = pk2(o[6], o[7]);
            *(v4u*)(ACT + (size_t)r * DFF + c) = ow;
            g2[0] = g1[0]; g2[1] = g1[1]; v2[0] = v1[0]; v2[1] = v1[1]; g1[0] = g0[0]; g1[1] = g0[1]; v1[0] = v0[0]; v1[1] = v0[1];
        }
    }
}
#undef loadrow
__device__ __forceinline__ void p9_final(Frame& F) {
    const int gw = F.vcu * 8 + F.wave, NGW = F.G * 8;
    const float* gf = INF(27);
    for (int m = gw; m < MROWS; m += NGW) {
        GAS f32x4* yr = (GAS f32x4*)(F.out + (size_t)m * 2048) + F.lane; const f32x4* gr = (const f32x4*)gf + F.lane;
        f32x4 v[8]; float s = 0.f;
#pragma unroll
        for (int j = 0; j < 8; ++j) { v[j] = yr[64 * j]; s += (v[j][0] * v[j][0] + v[j][1] * v[j][1]) + (v[j][2] * v[j][2] + v[j][3] * v[j][3]); }
        const float rs = 1.0f / sqrtf(wave_sum(s) * (1.0f / 2048.0f) + EPS_);
#pragma unroll
        for (int j = 0; j < 8; ++j) yr[64 * j] = v[j] * rs * gr[64 * j];
    }
}

#define MFMA16(a, b, c) __builtin_amdgcn_mfma_f32_16x16x32_bf16((a), (b), (c), 0, 0, 0)
constexpr int SG_PITCH = 68;
template <int KW, int NSTG = 4> __device__ __forceinline__ void sg64(LAS float* red, const bf16* A, int lda, const bf16* B, int ldb, int wave, int lane, float (&out)[8]) {
    constexpr int NST = KW < NSTG ? KW : NSTG;
    const int fr = lane & 15, fq = lane >> 4;
    const bf16* ap = A + (size_t)fr * lda + wave * (KW * 32) + 8 * fq;
    const bf16* bp = B + (size_t)fr * ldb + wave * (KW * 32) + 8 * fq;
    f32x4 acc[4][4];
#pragma unroll
    for (int i = 0; i < 4; ++i)
#pragma unroll
        for (int j = 0; j < 4; ++j) acc[i][j] = (f32x4){0.f, 0.f, 0.f, 0.f};
    bf16x8 fa[NST][4], fb[NST][4];
#pragma unroll
    for (int st = 0; st < NST; ++st)
#pragma unroll
        for (int i = 0; i < 4; ++i) { fa[st][i] = *(const bf16x8*)(ap + (size_t)(16 * i) * lda + st * 32); fb[st][i] = *(const bf16x8*)(bp + (size_t)(16 * i) * ldb + st * 32); }
#pragma unroll
    for (int ks = 0; ks < KW; ++ks) {
        const int st = ks % NST;
#pragma unroll
        for (int i = 0; i < 4; ++i)
#pragma unroll
            for (int j = 0; j < 4; ++j) acc[i][j] = MFMA16(fb[st][j], fa[st][i], acc[i][j]);
        if (ks + NST < KW) {
#pragma unroll
            for (int i = 0; i < 4; ++i) { fa[st][i] = *(const bf16x8*)(ap + (size_t)(16 * i) * lda + (ks + NST) * 32); fb[st][i] = *(const bf16x8*)(bp + (size_t)(16 * i) * ldb + (ks + NST) * 32); }
        }
        __builtin_amdgcn_sched_barrier(0);
    }
#pragma unroll
    for (int i = 0; i < 4; ++i)
#pragma unroll
        for (int j = 0; j < 4; ++j) *(LAS f32x4*)(red + (size_t)(wave * 64 + 16 * i + fr) * SG_PITCH + 16 * j + 4 * fq) = acc[i][j];
    LDS_WAIT(); __syncthreads();
    const int row = 8 * wave + (lane >> 3), c0 = 8 * (lane & 7);
    f32x4 s0 = {0.f, 0.f, 0.f, 0.f}, s1 = {0.f, 0.f, 0.f, 0.f};
#pragma unroll
    for (int w = 0; w < 8; ++w) { s0 += *(const LAS f32x4*)(red + (size_t)(w * 64 + row) * SG_PITCH + c0); s1 += *(const LAS f32x4*)(red + (size_t)(w * 64 + row) * SG_PITCH + c0 + 4); }
    out[0] = s0[0]; out[1] = s0[1]; out[2] = s0[2]; out[3] = s0[3]; out[4] = s1[0]; out[5] = s1[1]; out[6] = s1[2]; out[7] = s1[3];
    LDS_WAIT(); __syncthreads();
}
__device__ __forceinline__ void p4_sample(Frame& F, int c) {
    LAS float* red = (LAS float*)F.lds;
    const int m0 = MP + 64 * (c >> 5), n0 = 64 * (c & 31);
    const bf16* WG = WSP(bf16, WS_WG) + (size_t)(256 * (n0 >> 7) + (n0 & 127)) * 1024;
    const int r = m0 + 8 * F.wave + (F.lane >> 3), col = n0 + 8 * (F.lane & 7); const size_t off = (size_t)r * 2048 + col;
    float t[8];
#pragma unroll
    for (int e = 0; e < 8; ++e) t[e] = 0.f;
#pragma unroll 1
    for (int q = 0; q < 3; ++q) {
        const bf16* Ap = (q == 2 ? WSP(bf16, WS_O) : WSP(bf16, WS_Z)) + (size_t)m0 * 1024;
        const bf16* Bp = q == 0 ? WG + (size_t)128 * 1024 : (q == 1 ? WG : WSP(bf16, WS_WP) + (size_t)n0 * 1024);
        float v[8];
        sg64<4, 2>(red, Ap, 1024, Bp, 1024, F.wave, F.lane, v);
        if (q == 0) {
#pragma unroll
            for (int e = 0; e < 8; ++e) t[e] = sigmoidf_(v[e]);
        } else {
            f32x4 s0, s1; unpack8(*(const v4u*)((q == 1 ? WSP(bf16, WS_SGB) : WSP(bf16, WS_SGA)) + off), s0, s1);
#pragma unroll
            for (int e = 0; e < 8; ++e) { const float sc = e < 4 ? s0[e & 3] : s1[e & 3]; t[e] = (q == 1) ? t[e] * v[e] * sc : t[e] + v[e] * sc; }
        }
    }
    v4u w; w.x = pk2(t[0], t[1]); w.y = pk2(t[2], t[3]); w.z = pk2(t[4], t[5]); w.w = pk2(t[6], t[7]);
    *(v4u*)(WSP(bf16, WS_MRG) + off) = w;
}
__device__ __forceinline__ void p5_sample(Frame& F, int c) {
    LAS float* red = (LAS float*)F.lds;
    const int m0 = MP + 64 * (c >> 5), n0 = 64 * (c & 31);
    float a[8];
    sg64<8>(red, WSP(bf16, WS_MRG) + (size_t)m0 * 2048, 2048, WSP(bf16, WS_WO) + (size_t)n0 * 2048, 2048, F.wave, F.lane, a);
    const int r = m0 + 8 * F.wave + (F.lane >> 3), col = n0 + 8 * (F.lane & 7);
    const float* xr = INF(1) + (size_t)(r - MP) * 2048 + col; float* yr = F.out + (size_t)r * 2048 + col;
    const f32x4 x0 = *(const f32x4*)xr, x1 = *(const f32x4*)(xr + 4);
    const f32x4 v0 = x0 + (f32x4){a[0], a[1], a[2], a[3]}, v1 = x1 + (f32x4){a[4], a[5], a[6], a[7]};
    *(f32x4*)yr = v0; *(f32x4*)(yr + 4) = v1; *(v4u*)(WSP(bf16, WS_XB) + (size_t)r * 2048 + col) = pack8(v0, v1);
    float ss = (v0[0] * v0[0] + v0[1] * v0[1]) + (v0[2] * v0[2] + v0[3] * v0[3]) + (v1[0] * v1[0] + v1[1] * v1[1]) + (v1[2] * v1[2] + v1[3] * v1[3]);
    ss = dpp_sum8(ss);
    if ((F.lane & 7) == 0) WSP(float, WS_SS1)[(size_t)r * 32 + (c & 31)] = ss;
}
__device__ __forceinline__ void p8_sample(Frame& F, int c) {
    LAS float* red = (LAS float*)F.lds;
    const int m0 = MP + 64 * (c >> 5), n0 = 64 * (c & 31);
    float a[8];
    sg64<22>(red, WSP(bf16, WS_ACT) + (size_t)m0 * DFF, DFF, WSP(bf16, WS_WDN) + (size_t)n0 * DFF, DFF, F.wave, F.lane, a);
    const int r = m0 + 8 * F.wave + (F.lane >> 3), col = n0 + 8 * (F.lane & 7);
    float* yr = F.out + (size_t)r * 2048 + col;
    *(f32x4*)yr = *(const f32x4*)yr + (f32x4){a[0], a[1], a[2], a[3]}; *(f32x4*)(yr + 4) = *(const f32x4*)(yr + 4) + (f32x4){a[4], a[5], a[6], a[7]};
}

constexpr int NPHASE = 10;
__global__ void __launch_bounds__(512, 2) hybrid_fwd(Args args) {
    extern __shared__ __attribute__((aligned(16))) unsigned char lds[];
    Frame F;
    F.lds = (LAS unsigned char*)lds;
    F.MISC = (volatile LAS unsigned*)(F.lds + MISC_OFF);
    F.tid = threadIdx.x; F.lane = F.tid & 63; F.wave = __builtin_amdgcn_readfirstlane(F.tid >> 6);
    F.G = gridDim.x; { const int bx = blockIdx.x; F.vcu = (F.G % 8 == 0) ? (bx % 8) * (F.G / 8) + bx / 8 : bx; }
    F.in = args.in; F.out = args.out; F.ws = args.ws; F.ctl = (gu32*)(args.ws + WS_CTL);
    for (int u = F.tid; u < 128; u += 512) ((LAS unsigned*)(F.lds + MISC_OFF))[u] = 0u;
    __syncthreads();
    const int lo = args.ph_lo, hi = args.ph_hi;
    const bool multi = (hi - lo) > 1;
    XcdBarrier bar; bar.bar = (unsigned*)(F.ctl + CW_BAR) + args.li * XCD_BAR_WORDS; bar.x = 0; bar.st = nullptr;
    if (multi) bar = xcd_barrier_post((unsigned*)(F.ctl + CW_BAR) + args.li * XCD_BAR_WORDS, F.MISC + 8);
#ifndef PH_MASK
#define PH_MASK 0x3ff
#endif
#define IN(k) (((PH_MASK >> (k)) & 1) && lo <= (k) && (k) < hi)
#define SEAM(k) do { if (IN(k) && IN((k) + 1)) xcd_barrier(bar); } while (0)
    const int c = (int)blockIdx.x;

    if (IN(0)) { p0_prologue(F); SEAM(0); }

    if (IN(1)) {
        pg8::Gemm g{WSP(bf16, WS_XB), WSP(bf16, WS_WIN), 2048, 2048, 2048}; pg8::StaticOrder S; S.init(MROWS, NIN, F.G, c);
        EpiIn E{WSP(bf16, WS_Q), WSP(bf16, WS_KB), WSP(bf16, WS_VB), WSP(bf16, WS_QI), WSP(bf16, WS_KI), WSP(bf16, WS_U), WSP(bf16, WS_SGA), WSP(bf16, WS_SGB), WSP(float, WS_WI), WSP(float, WS_RS0), F.out};
        pg8::gemm_phase<EpiIn, pg8::StaticOrder, true, true>(F.lds + RING_OFF, g, S, E);
        SEAM(1);
    }

    if (IN(2)) {
#ifndef P2_MASK
#define P2_MASK 7
#endif
        const int qb0 = args.qoff;
        if (P2_MASK & 1) for (;;) { const int u = queue_pop(F, qb0 + 0); if (u >= 128) break; s5_unit(F, u & 1, u >> 1); }
        if (P2_MASK & 2) for (;;) { const int u = queue_pop(F, qb0 + 1); if (u >= 256) break; idx_unit_prompt(F, u & 3, 63 - (u >> 2)); }
        if (P2_MASK & 4) for (;;) { const int u = queue_pop(F, qb0 + 2); if (u >= 128) break; idx_unit_sample(F, u); }
        SEAM(2);
    }

    if (IN(3)) {
        {
        const attn_body::bf16* Qp = (const attn_body::bf16*)WSP(bf16, WS_Q);
        const int bh = F.vcu >> 2, s = F.vcu & 3;
#ifndef P3_MASK
#define P3_MASK 3
#endif
        if (F.G == 256 && (P3_MASK & 1)) {
            if (c & 1) { sattn_unit(F, c >> 2, c & 3); }
            for (int i = 0; i < 2; ++i)
                attn_body::attn_unit<8>(bh >> 4, bh & 15, i == 0 ? 7 - s : s, Qp, (const attn_body::bf16*)WSP(bf16, WS_KB), (const attn_body::bf16*)WSP(bf16, WS_VB), (attn_body::bf16*)WSP(bf16, WS_O),
                                        WSP(unsigned, WS_MASK), (char*)lds + RING_OFF, (char*)lds + AMASK_OFF);
        }
        if (P3_MASK & 2) for (int v = c; v < 512; v += F.G) { if (F.G == 256 && (c & 1) && v == c) continue; sattn_unit(F, v >> 2, v & 3); }
        }
        SEAM(3);
    }

    if (IN(4)) {
        if (!(args.flags & 1)) {
        { pg8::Gemm g{WSP(bf16, WS_Z), WSP(bf16, WS_WG), 1024, 1024, 1024}; OrderGlu S{c}; EpiGlu E{WSP(bf16, WS_SGB), WSP(bf16, WS_MRG)};
          pg8::gemm_phase<EpiGlu, OrderGlu, true, true>(F.lds + RING_OFF, g, S, E); }
        { pg8::Gemm g{WSP(bf16, WS_O), WSP(bf16, WS_WP), 1024, 1024, 1024}; OrderProj S{c}; EpiProj E{WSP(bf16, WS_SGA), WSP(bf16, WS_MRG)};
          pg8::gemm_phase<EpiProj, OrderProj, true, true>(F.lds + RING_OFF, g, S, E); }
        }
        if (!(args.flags & 2)) p4_sample(F, c);
        SEAM(4);
    }

    if (IN(5)) {
        pg8::Gemm g{WSP(bf16, WS_MRG), WSP(bf16, WS_WO), 2048, 2048, 2048}; pg8::StaticOrder S; S.init(MP, 2048, F.G, c);
        EpiOut E{INF(0), INF(1), F.out, WSP(bf16, WS_XB), WSP(float, WS_SS1)};
        if (!(args.flags & 1)) pg8::gemm_phase<EpiOut, pg8::StaticOrder, true, true>(F.lds + RING_OFF, g, S, E);
        if (!(args.flags & 2)) p5_sample(F, c);
        SEAM(5);
    }

    if (IN(6)) {
        pg8::Gemm g{WSP(bf16, WS_XB), WSP(bf16, WS_WUP), 2048, 2048, 2048}; pg8::StaticOrder S; S.init(MROWS, DFF2, F.G, c);
        EpiUp E{WSP(float, WS_SS1), WSP(bf16, WS_UP), F.out};
        pg8::gemm_phase<EpiUp, pg8::StaticOrder, true, true>(F.lds + RING_OFF, g, S, E);
        SEAM(6);
    }

    if (IN(7)) { p7_convgate(F); SEAM(7); }

    if (IN(8)) {
        pg8::Gemm g{WSP(bf16, WS_ACT), WSP(bf16, WS_WDN), DFF, DFF, DFF}; pg8::StaticOrder S; S.init(MP, 2048, F.G, c);
        EpiDown E{F.out};
        if (!(args.flags & 1)) pg8::gemm_phase<EpiDown, pg8::StaticOrder, true, true>(F.lds + RING_OFF, g, S, E);
        if (!(args.flags & 2)) p8_sample(F, c);
        SEAM(8);
    }

    if (IN(9)) { p9_final(F); }
#undef IN
#undef SEAM
}

#ifndef MK_N_LAUNCHES
#define MK_N_LAUNCHES 1
#endif
extern "C" void kernel_launch(void* const* d_in, const int* in_sizes, int n_in, void* d_out, int out_size, void* d_ws, size_t ws_size, hipStream_t stream) {
    static int grid = 0;
    if (grid == 0) {
        if (n_in != 28 || (size_t)out_size != O_END || ws_size < WS_END) { fprintf(stderr, "kernel_launch: unexpected shapes: n_in %d out %d ws %zu (want 28, %zu, >= %zu)\n", n_in, out_size, ws_size, (size_t)O_END, (size_t)WS_END); grid = -1; return; }
        int dev = 0, cus = 0, per_cu = 0;
        if (hipGetDevice(&dev) != hipSuccess || hipDeviceGetAttribute(&cus, hipDeviceAttributeMultiprocessorCount, dev) != hipSuccess) { grid = -1; return; }
        if (hipFuncSetAttribute((const void*)hybrid_fwd, hipFuncAttributeMaxDynamicSharedMemorySize, LDS_BYTES) != hipSuccess) { fprintf(stderr, "kernel_launch: hipFuncSetAttribute failed\n"); grid = -1; return; }
        if (hipOccupancyMaxActiveBlocksPerMultiprocessor(&per_cu, (const void*)hybrid_fwd, 512, LDS_BYTES) != hipSuccess || per_cu < 1) fprintf(stderr, "kernel_launch: occupancy query reports %d\n", per_cu);
        (void)hipGetLastError();
        grid = cus;
        if (grid != 256) fprintf(stderr, "kernel_launch: %d CUs (built for 256)\n", grid);
    }
    if (grid < 0) return;
    (void)hipMemsetAsync((char*)d_ws + WS_CTL, 0, CTL_ZERO_BYTES, stream);
    Args a{};
    for (int i = 0; i < 28; ++i) a.in[i] = d_in[i];
    a.out = (float*)d_out; a.ws = (unsigned char*)d_ws;
#ifndef PROBE_FLAGS
#define PROBE_FLAGS 0
#endif
#ifdef PROBE_PHASE
    { const int k = PROBE_PHASE; const int cuts[4] = {0, k + 1, k + 1, NPHASE}; const int los[3] = {0, k, k + 1};
      for (int li = 0; li < 3; ++li) { a.ph_lo = los[li]; a.ph_hi = (li == 1) ? k + 1 : cuts[li == 0 ? 1 : 3]; a.li = li; a.qoff = (li == 1) ? 3 : 0; a.flags = (li == 1) ? PROBE_FLAGS : 0; if (a.ph_lo < a.ph_hi) hipLaunchKernelGGL(hybrid_fwd, dim3(grid), dim3(512), LDS_BYTES, stream, a); } }
#else
    if (MK_N_LAUNCHES == 1) { a.ph_lo = 0; a.ph_hi = NPHASE; hipLaunchKernelGGL(hybrid_fwd, dim3(grid), dim3(512), LDS_BYTES, stream, a); }
    else for (int p = 0; p < NPHASE; ++p) { a.ph_lo = p; a.ph_hi = p + 1; hipLaunchKernelGGL(hybrid_fwd, dim3(grid), dim3(512), LDS_BYTES, stream, a); }
#endif
}
```

```cpp
#include <hip/hip_runtime.h>
#include <cstdio>
#include <cstdint>
namespace pg8 {
#define PG8_LAS __attribute__((address_space(3)))
typedef unsigned short bf16_t;
typedef short bf16x8 __attribute__((ext_vector_type(8)));
typedef float f32x4 __attribute__((ext_vector_type(4)));
typedef unsigned u32x4 __attribute__((ext_vector_type(4)));
typedef unsigned u32x2 __attribute__((ext_vector_type(2)));
constexpr int BM = 256, BK = 64, HALF = 128, HTB = HALF * BK * 2  , STAGE_BYTES = 8 * HTB, NXCD = 8, WGM = 8;
__host__ __device__ __forceinline__ int lds_byte(int r, int c) { const int st = (r >> 4) * 2 + (c >> 5), rr = r & 15, cc = c & 31, ob = rr * 64 + cc * 2; return st * 1024 + (ob ^ (((ob >> 9) & 1) << 5)); }
__host__ __device__ __forceinline__ void stage_rc(int b, int& R, int& C) { const int st = b / 1024, sb = b % 1024, swz = sb ^ (((sb >> 9) & 1) << 5); R = (st >> 1) * 16 + swz / 64; C = (st & 1) * 32 + (swz % 64) / 2; }
__host__ __device__ __forceinline__ int perm32(int rho) { const int n = rho >> 4, i = rho & 15; return 8 * (i >> 2) + 4 * n + (i & 3); }

struct Unit { int pm, pn, kofs; };
struct Gemm { const bf16_t* A; const bf16_t* Bt; int lda, ldb, K; };

struct StaticOrder {
    int nM, nN, nwg, G, c;
    __host__ __device__ void init(int M, int N, int G_, int c_) { nM = M / BM; nN = N / BM; nwg = nM * nN; G = G_; c = c_; }
    __host__ __device__ bool next(int i, Unit& u) const {
        const long L = (long)i * G + c; if (L >= nwg) return false;
        int wgid = (int)L; { const int q = nwg / NXCD, r = nwg % NXCD, xcd = wgid % NXCD, off = wgid / NXCD; wgid = (xcd < r ? xcd * (q + 1) : r * (q + 1) + (xcd - r) * q) + off; }
        const int nig = WGM * nN, gid = wgid / nig, fm = gid * WGM, gsz = (nM - fm) < WGM ? (nM - fm) : WGM;
        u.pm = fm + ((wgid % nig) % gsz); u.pn = (wgid % nig) / gsz; u.kofs = 0; return true;
    }
    __device__ __forceinline__ void a_ready(const Unit&) const {}
    __device__ __forceinline__ void done(const Unit&) const {}
};
__device__ __forceinline__ unsigned cvt_pk_bf16(float lo, float hi) { unsigned r; asm volatile("v_cvt_pk_bf16_f32 %0, %1, %2" : "=v"(r) : "v"(lo), "v"(hi)); return r; }
__device__ __forceinline__ float bf_lo(unsigned w) { return __uint_as_float(w << 16); }
__device__ __forceinline__ float bf_hi(unsigned w) { return __uint_as_float(w & 0xffff0000u); }
__device__ __forceinline__ float sigmoidf_(float v) { return __builtin_amdgcn_rcpf(1.0f + __builtin_amdgcn_exp2f(-1.4426950408889634f * v)); }
template <class Epi, class Sched, bool ALIGN_EPI = false, bool SP2 = false>
__device__ __forceinline__ void gemm_phase(PG8_LAS unsigned char* lds, const Gemm g, const Sched& S, const Epi& E) {
    const int tid = threadIdx.x, wid = __builtin_amdgcn_readfirstlane(tid >> 6), lane = tid & 63, wr = wid >> 2, wc = wid & 3, fr = lane & 15, fq = lane >> 4;
    const int nt = g.K / BK, lda = g.lda, ldb = g.ldb;
    unsigned voffA[2], voffB[2];
#pragma unroll
    for (int i = 0; i < 2; ++i) { int R, C; stage_rc(tid * 16 + i * 8192, R, C); const int Rb = Epi::PERM ? ((R & ~31) + perm32(R & 31)) : R;
        voffA[i] = (unsigned)(R * lda + C) * 2u; voffB[i] = (unsigned)(Rb * ldb + C) * 2u; }
    const size_t kstep = (size_t)(BK * 2);
    const size_t hstepA = (size_t)HALF * lda * 2, hstepB = (size_t)HALF * ldb * 2;
    const size_t tstepA = 2 * hstepA, tstepB = 2 * hstepB;
    const unsigned ldsw = (unsigned)wid * 1024u;
    const int aoff = lds_byte(wr * 64 + fr, fq * 8), boff = lds_byte(wc * 32 + fr, fq * 8);
#define PG8_SA(b, h) (((b) * 2 + (h)) * HTB)
#define PG8_SB(b, h) ((4 + (b) * 2 + (h)) * HTB)
#define PG8_STAGE(bufoff, gbase, voff) do { _Pragma("unroll") for (int _i = 0; _i < 2; ++_i) \
        __builtin_amdgcn_global_load_lds((const unsigned*)((const char*)(gbase) + (voff)[_i]), (PG8_LAS unsigned*)(lds + (bufoff) + ldsw + _i * 8192), 16, 0, 0); } while (0)
#define PG8_LDA(dst, b, h) do { _Pragma("unroll") for (int m = 0; m < 4; ++m) _Pragma("unroll") for (int k = 0; k < 2; ++k) dst[m][k] = *(const PG8_LAS bf16x8*)(lds + PG8_SA(b, h) + aoff + m * 2048 + k * 1024); } while (0)
#define PG8_LDB(dst, b, h) do { _Pragma("unroll") for (int n = 0; n < 2; ++n) _Pragma("unroll") for (int k = 0; k < 2; ++k) dst[n][k] = *(const PG8_LAS bf16x8*)(lds + PG8_SB(b, h) + boff + n * 2048 + k * 1024); } while (0)
#define PG8_MMA(ai, bj, At, Bt) do { __builtin_amdgcn_s_setprio(1); _Pragma("unroll") for (int m = 0; m < 4; ++m) _Pragma("unroll") for (int n = 0; n < 2; ++n) _Pragma("unroll") for (int k = 0; k < 2; ++k) \
        acc[ai][bj][m][n] = __builtin_amdgcn_mfma_f32_16x16x32_bf16(Bt[n][k], At[m][k], acc[ai][bj][m][n], 0, 0, 0); __builtin_amdgcn_s_setprio(0); } while (0)
#define PG8_WAIT_V(n) asm volatile("s_waitcnt vmcnt(" #n ")" ::: "memory")
#define PG8_WAIT_L(n) asm volatile("s_waitcnt lgkmcnt(" #n ")" ::: "memory")
#define PG8_BAR __builtin_amdgcn_s_barrier()
#define PG8_SCHED __builtin_amdgcn_sched_barrier(0)
    Unit cur, nxt; int ui = 0;
    if (!S.next(0, cur)) return;
    f32x4 acc[2][2][4][2];
#pragma unroll
    for (int a = 0; a < 2; ++a)
#pragma unroll
        for (int b = 0; b < 2; ++b)
#pragma unroll
            for (int m = 0; m < 4; ++m)
#pragma unroll
                for (int n = 0; n < 2; ++n) acc[a][b][m][n] = (f32x4){0.f, 0.f, 0.f, 0.f};
    bf16x8 At[4][2], B0[2][2], B1[2][2];
    const char* cA = (const char*)g.A + (size_t)cur.pm * tstepA + (size_t)cur.kofs * 2; const char* cB = (const char*)g.Bt + (size_t)cur.pn * tstepB + (size_t)cur.kofs * 2;
    S.a_ready(cur);
    if constexpr (SP2) {
        PG8_STAGE(PG8_SB(0, 0), cB, voffB); PG8_STAGE(PG8_SB(0, 1), cB + hstepB, voffB); PG8_STAGE(PG8_SA(0, 0), cA, voffA); PG8_STAGE(PG8_SA(0, 1), cA + hstepA, voffA);
        if (wr == 1) PG8_BAR;
        PG8_WAIT_V(2); PG8_BAR;
        PG8_STAGE(PG8_SB(1, 0), cB + kstep, voffB); PG8_STAGE(PG8_SA(1, 0), cA + kstep, voffA); PG8_STAGE(PG8_SB(1, 1), cB + hstepB + kstep, voffB);
        PG8_WAIT_V(6); PG8_BAR;
    } else {
        PG8_STAGE(PG8_SB(0, 0), cB, voffB); PG8_STAGE(PG8_SA(0, 0), cA, voffA); PG8_STAGE(PG8_SB(0, 1), cB + hstepB, voffB); PG8_STAGE(PG8_SA(0, 1), cA + hstepA, voffA);
        if (wr == 1) PG8_BAR;
        PG8_WAIT_V(4); PG8_BAR;
        PG8_STAGE(PG8_SB(1, 0), cB + kstep, voffB); PG8_STAGE(PG8_SA(1, 0), cA + kstep, voffA); PG8_STAGE(PG8_SB(1, 1), cB + hstepB + kstep, voffB);
        PG8_WAIT_V(6); PG8_BAR;
    }
    for (;;) {
        const bool has_next = S.next(ui + 1, nxt);
        const char* nA = has_next ? (const char*)g.A + (size_t)nxt.pm * tstepA + (size_t)nxt.kofs * 2 : cA; const char* nB = has_next ? (const char*)g.Bt + (size_t)nxt.pn * tstepB + (size_t)nxt.kofs * 2 : cB;
        for (int t = 0; t < nt; t += 2) {
            const bool last = (t == nt - 2);
            const char* a1 = cA + (size_t)(t + 1) * kstep;
            const char* a2 = last ? nA : cA + (size_t)(t + 2) * kstep; const char* b2 = last ? nB : cB + (size_t)(t + 2) * kstep;
            const char* a3 = a2 + kstep; const char* b3 = b2 + kstep;
            if (last && has_next) S.a_ready(nxt);
            if constexpr (SP2) {
            PG8_LDB(B0, 0, 0); PG8_LDB(B1, 0, 1); PG8_SCHED; PG8_LDA(At, 0, 0); PG8_STAGE(PG8_SA(1, 1), a1 + hstepA, voffA);
            PG8_WAIT_V(8); PG8_WAIT_L(0); PG8_BAR; PG8_MMA(0, 0, At, B0); PG8_MMA(0, 1, At, B1); PG8_BAR; PG8_SCHED;
            PG8_LDA(At, 0, 1); PG8_STAGE(PG8_SB(0, 0), b2, voffB); PG8_STAGE(PG8_SB(0, 1), b2 + hstepB, voffB); PG8_STAGE(PG8_SA(0, 0), a2, voffA);
            PG8_WAIT_V(8); PG8_WAIT_L(0); PG8_BAR; PG8_MMA(1, 0, At, B0); PG8_MMA(1, 1, At, B1); PG8_BAR; PG8_SCHED;
            PG8_LDB(B0, 1, 0); PG8_LDB(B1, 1, 1); PG8_SCHED; PG8_LDA(At, 1, 0); PG8_STAGE(PG8_SA(0, 1), a2 + hstepA, voffA);
            PG8_WAIT_V(8); PG8_WAIT_L(0); PG8_BAR; PG8_MMA(0, 0, At, B0); PG8_MMA(0, 1, At, B1); PG8_BAR; PG8_SCHED;
            PG8_LDA(At, 1, 1); PG8_STAGE(PG8_SB(1, 0), b3, voffB); PG8_STAGE(PG8_SB(1, 1), b3 + hstepB, voffB); PG8_STAGE(PG8_SA(1, 0), a3, voffA);
            PG8_WAIT_V(8); PG8_WAIT_L(0); PG8_BAR; PG8_MMA(1, 0, At, B0); PG8_MMA(1, 1, At, B1); PG8_BAR; PG8_SCHED;
            } else {
            PG8_LDB(B0, 0, 0); PG8_SCHED; PG8_LDA(At, 0, 0); PG8_STAGE(PG8_SA(1, 1), a1 + hstepA, voffA);
            PG8_WAIT_L(8); PG8_BAR; PG8_WAIT_L(0); PG8_MMA(0, 0, At, B0); PG8_BAR; PG8_SCHED;
            PG8_LDB(B1, 0, 1); PG8_STAGE(PG8_SB(0, 0), b2, voffB);
            PG8_BAR; PG8_WAIT_L(0); PG8_MMA(0, 1, At, B1); PG8_BAR;
            PG8_LDA(At, 0, 1); PG8_STAGE(PG8_SA(0, 0), a2, voffA);
            PG8_BAR; PG8_WAIT_L(0); PG8_MMA(1, 0, At, B0); PG8_BAR; PG8_SCHED;
            PG8_STAGE(PG8_SB(0, 1), b2 + hstepB, voffB);
            PG8_WAIT_V(6); PG8_BAR; PG8_MMA(1, 1, At, B1); PG8_BAR;
            PG8_LDB(B0, 1, 0); PG8_SCHED; PG8_LDA(At, 1, 0); PG8_STAGE(PG8_SA(0, 1), a2 + hstepA, voffA);
            PG8_WAIT_L(8); PG8_BAR; PG8_WAIT_L(0); PG8_MMA(0, 0, At, B0); PG8_BAR; PG8_SCHED;
            PG8_LDB(B1, 1, 1); PG8_STAGE(PG8_SB(1, 0), b3, voffB);
            PG8_BAR; PG8_WAIT_L(0); PG8_MMA(0, 1, At, B1); PG8_BAR;
            PG8_LDA(At, 1, 1); PG8_STAGE(PG8_SA(1, 0), a3, voffA);
            PG8_BAR; PG8_WAIT_L(0); PG8_MMA(1, 0, At, B0); PG8_BAR; PG8_SCHED;
            PG8_STAGE(PG8_SB(1, 1), b3 + hstepB, voffB);
            PG8_WAIT_V(6); PG8_BAR; PG8_MMA(1, 1, At, B1); PG8_BAR;
            }
        }
        if constexpr (ALIGN_EPI) { if (wr == 0) PG8_BAR; }
        if constexpr (!Epi::AFTER_DRAIN) { E(acc, cur, wr, wc, fr, fq); S.done(cur); }
        if (!has_next) break;
#pragma unroll
        for (int a = 0; a < 2; ++a)
#pragma unroll
            for (int b = 0; b < 2; ++b)
#pragma unroll
                for (int m = 0; m < 4; ++m)
#pragma unroll
                    for (int n = 0; n < 2; ++n) acc[a][b][m][n] = (f32x4){0.f, 0.f, 0.f, 0.f};
        cur = nxt; cA = nA; cB = nB; ++ui;
        if constexpr (ALIGN_EPI) { if (wr == 1) PG8_BAR; }
    }
    PG8_WAIT_V(0);
    if constexpr (!ALIGN_EPI) { if (wr == 0) PG8_BAR; }
    PG8_BAR;
    if constexpr (Epi::AFTER_DRAIN) { E.fused(acc, cur, wr, wc, fr, fq, lds, wid, lane); S.done(cur); }
#undef PG8_SA
#undef PG8_SB
#undef PG8_STAGE
#undef PG8_LDA
#undef PG8_LDB
#undef PG8_MMA
#undef PG8_WAIT_V
#undef PG8_WAIT_L
#undef PG8_BAR
#undef PG8_SCHED
}
}
#include <hip/hip_bf16.h>
#include <cmath>
namespace attn_body {
using bf16=__hip_bfloat16;
using bf16x8=__attribute__((ext_vector_type(8)))short;
using s16x4=__attribute__((ext_vector_type(4)))short;
using f32x16=__attribute__((ext_vector_type(16)))float;
using u32x4=__attribute__((ext_vector_type(4)))unsigned;
constexpr int BATCH=4,NHEAD=16,SEQ=2048,D=64,DM=NHEAD*D,KP=256;
constexpr int NW=8,QBLK=32,QB=QBLK*NW,KVBLK=64,NQB=SEQ/QB;
constexpr int ATTN_PITCH=DM, ATTN_UNIT_ROWS=QB;
__device__ __forceinline__ int crow(int r,int hi){return (r&3)+8*(r>>2)+4*hi;}
#define SBAR() __builtin_amdgcn_sched_barrier(0)
__device__ __forceinline__ void amask(f32x16&p0,f32x16&p1,unsigned mw){
  #pragma unroll
  for(int r=0;r<16;++r){
    const unsigned m0=(unsigned)__builtin_amdgcn_sbfe((int)mw,r,1), m1=(unsigned)__builtin_amdgcn_sbfe((int)mw,16+r,1);
    p0[r]=__uint_as_float((__float_as_uint(p0[r])&m0)|(0xff800000u&~m0));
    p1[r]=__uint_as_float((__float_as_uint(p1[r])&m1)|(0xff800000u&~m1));}
}
constexpr int NSLOT=3, SLOTB=8192;
constexpr int LDS_K=0, LDS_V=NSLOT*SLOTB, LDS_WS=2*NSLOT*SLOTB, LDS_OST=LDS_WS+NW*64*4, LDS_BYTES=LDS_OST+NW*4096;
constexpr float C2=0.125f*1.4426950408889634f;
__device__ __forceinline__ void glds16(const void*gsrc,unsigned lds_dst){unsigned keep;
  asm volatile("s_mov_b32 %0, m0\n\ts_mov_b32 m0, %2\n\ts_nop 0\n\tglobal_load_lds_dwordx4 %1, off\n\ts_mov_b32 m0, %0":"=&s"(keep):"v"(gsrc),"s"(lds_dst):"memory");}
__device__ __forceinline__ float max3f(float a,float b,float c){float r;asm("v_max3_f32 %0, %1, %2, %3":"=v"(r):"v"(a),"v"(b),"v"(c));return r;}
__device__ __forceinline__ float max2f(float a,float b){float r;asm("v_max_f32_e32 %0, %1, %2":"=v"(r):"v"(a),"v"(b));return r;}
__device__ __forceinline__ float fadd_s(float a,float b){float r;asm("v_add_f32_e32 %0, %1, %2":"=v"(r):"v"(a),"v"(b));return r;}
__device__ __forceinline__ float fsub_s(float a,float b){float r;asm("v_sub_f32_e32 %0, %1, %2":"=v"(r):"v"(a),"v"(b));return r;}
typedef float f32x2_t __attribute__((ext_vector_type(2))); typedef __bf16 bf16x2_t __attribute__((ext_vector_type(2)));
__device__ __forceinline__ unsigned cvtpk_s(float lo,float hi){f32x2_t v={lo,hi};bf16x2_t b=__builtin_convertvector(v,bf16x2_t);return __builtin_bit_cast(unsigned,b);}
#define WAIT_BAR(N) asm volatile("s_waitcnt vmcnt(" #N ") lgkmcnt(0)\n\ts_barrier":::"memory")

__device__ __forceinline__ void qkt(f32x16&p0,f32x16&p1,const char*Kslot,const bf16x8*qr,const f32x16&negm,int r32,int hi){
  const char*kb=Kslot+hi*1024+r32*16;
  #pragma unroll
  for(int d0=0;d0<4;++d0){
    const bf16x8 b0=*reinterpret_cast<const bf16x8*>(kb+d0*2048);
    const bf16x8 b1=*reinterpret_cast<const bf16x8*>(kb+d0*2048+512);
    if(d0==0){p0=__builtin_amdgcn_mfma_f32_32x32x16_bf16(b0,qr[0],negm,0,0,0);p1=__builtin_amdgcn_mfma_f32_32x32x16_bf16(b1,qr[0],negm,0,0,0);}
    else{p0=__builtin_amdgcn_mfma_f32_32x32x16_bf16(b0,qr[d0],p0,0,0,0);p1=__builtin_amdgcn_mfma_f32_32x32x16_bf16(b1,qr[d0],p1,0,0,0);}}
}
typedef __attribute__((address_space(3))) const char* lds_cptr;
typedef short v4i16_t __attribute__((ext_vector_type(4)));
__device__ __forceinline__ void kload8(bf16x8*kf,lds_cptr kp){
  kf[0]=*(const __attribute__((address_space(3))) bf16x8*)(kp);      kf[1]=*(const __attribute__((address_space(3))) bf16x8*)(kp+512);
  kf[2]=*(const __attribute__((address_space(3))) bf16x8*)(kp+2048); kf[3]=*(const __attribute__((address_space(3))) bf16x8*)(kp+2560);
  kf[4]=*(const __attribute__((address_space(3))) bf16x8*)(kp+4096); kf[5]=*(const __attribute__((address_space(3))) bf16x8*)(kp+4608);
  kf[6]=*(const __attribute__((address_space(3))) bf16x8*)(kp+6144); kf[7]=*(const __attribute__((address_space(3))) bf16x8*)(kp+6656);
}
__device__ __forceinline__ void kload2(bf16x8*kf,lds_cptr kp,int j){ kf[2*j]=*(const __attribute__((address_space(3))) bf16x8*)(kp+j*2048); kf[2*j+1]=*(const __attribute__((address_space(3))) bf16x8*)(kp+j*2048+512); }
__device__ __forceinline__ s16x4 vtr(lds_cptr p){ return __builtin_bit_cast(s16x4,__builtin_amdgcn_ds_read_tr16_b64_v4i16((__attribute__((address_space(3))) v4i16_t*)p)); }
__device__ __forceinline__ float rowmax(const f32x16&p0,const f32x16&p1){
  float a=max3f(p0[0],p0[1],p1[0]),b=max3f(p0[2],p0[3],p1[1]);a=max3f(a,p1[2],p1[3]);
  #pragma unroll
  for(int r=4;r<16;r+=4){a=max3f(a,p0[r],p0[r+1]);b=max3f(b,p0[r+2],p0[r+3]);a=max3f(a,p1[r],p1[r+1]);b=max3f(b,p1[r+2],p1[r+3]);}
  const float m=max2f(a,b);
  auto rr=__builtin_amdgcn_permlane32_swap(__float_as_uint(m),__float_as_uint(m),false,false);
  return max2f(__uint_as_float(rr[0]),__uint_as_float(rr[1]));
}
__device__ __forceinline__ void pv(f32x16*o,int vb,bf16x8 pa0,bf16x8 pa1,bf16x8 pa2,bf16x8 pa3){
  #pragma unroll
  for(int d0=0;d0<2;++d0){s16x4 lo[4],hi[4];
    #pragma unroll
    for(int ks=0;ks<4;++ks){
      asm volatile("ds_read_b64_tr_b16 %0,%1 offset:%c2":"=&v"(lo[ks]):"v"(vb),"i"(d0*4096+ks*1024):"memory");
      asm volatile("ds_read_b64_tr_b16 %0,%1 offset:%c2":"=&v"(hi[ks]):"v"(vb),"i"(d0*4096+ks*1024+512):"memory");}
    asm volatile("s_waitcnt lgkmcnt(0)":::"memory");SBAR();
    #define PK(k) (bf16x8){lo[k][0],lo[k][1],lo[k][2],lo[k][3],hi[k][0],hi[k][1],hi[k][2],hi[k][3]}
    o[d0]=__builtin_amdgcn_mfma_f32_32x32x16_bf16(pa0,PK(0),o[d0],0,0,0);
    o[d0]=__builtin_amdgcn_mfma_f32_32x32x16_bf16(pa1,PK(1),o[d0],0,0,0);
    o[d0]=__builtin_amdgcn_mfma_f32_32x32x16_bf16(pa2,PK(2),o[d0],0,0,0);
    o[d0]=__builtin_amdgcn_mfma_f32_32x32x16_bf16(pa3,PK(3),o[d0],0,0,0);
    #undef PK
  }
}

#ifndef ATTN_STORE16
#define ATTN_STORE16(p,v) (*(u32x4*)(p)=(v))
#endif
template<int THRL> __device__ __forceinline__ void attn_unit(int b,int h,int qb,const bf16*Q,const bf16*__restrict__ K,const bf16*__restrict__ V,bf16*O,const unsigned*__restrict__ MG,char*shm,char*mshm){
  const int tid=threadIdx.x,lane=tid&63,r32=lane&31,hi=lane>>5; const int wid=__builtin_amdgcn_readfirstlane(tid>>6);
  const long rowbase=(long)b*SEQ; const int q0=qb*QB;
  const bf16*Qw=Q+(rowbase+q0+wid*QBLK)*DM+h*D;
  const bf16*Kh=K+rowbase*KP+(h>>2)*D,*Vh=V+rowbase*KP+(h>>2)*D;
  const unsigned lds0=(unsigned)(uintptr_t)shm;
  float*wsf=(float*)(shm+LDS_WS)+wid*64;
  const bf16*ksrc=Kh+(long)lane*KP+wid*8;
  const bf16*vsrc=Vh+(long)(16*(wid&3)+(lane>>2))*KP+(wid>>2)*32+(lane&3)*8;
  const unsigned kdst=lds0+LDS_K+wid*1024, vdst=lds0+LDS_V+wid*1024;
  #define DMA_K(t,slot) glds16(ksrc+(long)(t)*KVBLK*KP,(unsigned)__builtin_amdgcn_readfirstlane(kdst+(slot)))
  #define DMA_V(t,slot) glds16(vsrc+(long)(t)*KVBLK*KP,(unsigned)__builtin_amdgcn_readfirstlane(vdst+(slot)))
  const int vb0=(int)(lds0+LDS_V)+((lane>>4)&1)*32+(lane&3)*8+(4*hi+((lane&15)>>2))*64;
  const char*Kbase=shm+LDS_K; bf16x8 kf[8];
  const lds_cptr shm3=(lds_cptr)shm; const lds_cptr kp0=shm3+LDS_K+hi*1024+r32*16; const lds_cptr vp0=shm3+LDS_V+((lane>>4)&1)*32+(lane&3)*8+(4*hi+((lane&15)>>2))*64;
  const int NT=(q0+QB)/KVBLK;
  unsigned*mwv=(unsigned*)(mshm+wid*8192);
  { const u32x4*msrc=(const u32x4*)(MG+(size_t)((b*(SEQ/QBLK))+qb*NW+wid)*2048);
    #pragma unroll
    for(int i=0;i<8;++i){ if(i<=qb){ const u32x4 v_=msrc[i*64+lane]; *(u32x4*)(mwv+(i*64+lane)*4)=v_; } } }
  const unsigned*mldsw=mwv+hi*32+r32;
  asm volatile("s_waitcnt vmcnt(0) lgkmcnt(0)":::"memory");
  DMA_K(0,0);DMA_V(0,0);DMA_K(1,SLOTB);
  bf16x8 qr[4];
  #pragma unroll
  for(int d0=0;d0<4;++d0)qr[d0]=*reinterpret_cast<const bf16x8*>(&Qw[(long)r32*DM+d0*16+hi*8]);
  float mhat=0.f,l_reg=0.f;f32x16 o[2];o[0]=f32x16{};o[1]=f32x16{};const f32x16 negm=f32x16{};
  const int qrel=wid*QBLK+r32;
  #define CMASK(P0,P1,t) do{ _Pragma("unroll") for(int r_=0;r_<16;++r_){P0[r_]-=mhat;P1[r_]-=mhat;} amask(P0,P1,mldsw[(t)*64]); }while(0)
  bool resc=false;
  #define START(P0,P1) do{ const float rm=rowmax(P0,P1); resc=false; \
    { const float dl=(rm<-3.0e38f)?0.f:rm; mhat=fadd_s(mhat,dl); \
      _Pragma("unroll") for(int r=0;r<16;++r){P0[r]=fsub_s(P0[r],dl);P1[r]=fsub_s(P1[r],dl);} \
    } \
    _Pragma("unroll") for(int r=0;r<16;++r)P0[r]=__builtin_amdgcn_exp2f(P0[r]); }while(0)
  #define RESC() do{ if(resc){ asm volatile("s_waitcnt lgkmcnt(0)":::"memory"); \
      _Pragma("unroll") for(int d_=0;d_<2;++d_) _Pragma("unroll") for(int r=0;r<16;++r)o[d_][r]*=wsf[crow(r,hi)]; } }while(0)
  f32x16 pA0,pA1,pB0,pB1;
  int sl_prev=0,sl_cur=0,sl_next=SLOTB;
  #define ROT() do{sl_prev=sl_cur;sl_cur=sl_next;sl_next=(sl_next==(NSLOT-1)*SLOTB)?0:sl_next+SLOTB;}while(0)
  DMA_K(2,2*SLOTB);
  WAIT_BAR(3);
  qkt(pA0,pA1,Kbase,qr,negm,r32,hi);asm volatile("s_nop 15\n\ts_nop 7":"+v"(pA0),"+v"(pA1));CMASK(pA0,pA1,0);
  START(pA0,pA1);
  _Pragma("unroll") for(int r=0;r<16;++r)pA1[r]=__builtin_amdgcn_exp2f(pA1[r]);
  WAIT_BAR(0);
  DMA_K(3,0);DMA_V(1,SLOTB);
  ROT();
  kload8(kf,kp0+sl_cur);
  WAIT_BAR(2);
  s16x4 vlo[8],vhi[8]; u32x4 pw0,pw1,pw2,pw3;
  #define PKW(P,B) cvtpk_s(P[B],P[B+1])
  #define PAF(k) __builtin_bit_cast(bf16x8,pw##k)
  #define VFR(i) (bf16x8){vlo[i][0],vlo[i][1],vlo[i][2],vlo[i][3],vhi[i][0],vhi[i][1],vhi[i][2],vhi[i][3]}
  #define PIN(x) asm volatile("":"+v"(x))
  #define MX3(a,b,c) __builtin_fmaxf(__builtin_fmaxf((a),(b)),(c))
  #define GAPA(MF,A0,A1,A2,A3,W0,W1,PW) do{ MF; sacc+=A0; sacc+=A1; sacc+=A2; sacc+=A3; PIN(sacc); W0; W1; PIN(PW); SBAR(); }while(0)
  #define EX(v) __builtin_amdgcn_exp2f(v)
  #define GAPB(MF,X,B) do{ MF; X[B]=EX(X[B]); X[B+1]=EX(X[B+1]); X[B+2]=EX(X[B+2]); X[B+3]=EX(X[B+3]); PIN(X); SBAR(); }while(0)
  #define VRD(i) do{ vlo[i]=vtr(vp_+(((i)>>2)*4096+((i)&3)*1024)); vhi[i]=vtr(vp_+(((i)>>2)*4096+((i)&3)*1024+512)); }while(0)
  #define KRD(G,j) do{ if(G){ kload2(kf,kp0+sl_next,j); SBAR(); } }while(0)
  #define STEP(C0,C1,P0,P1,t,GK,GV,GL) do{ SBAR(); \
    const lds_cptr vp_=vp0+sl_prev; \
    VRD(0); SBAR(); float sacc=(P0[0]+P0[1]); \
    GAPA(C0=__builtin_amdgcn_mfma_f32_32x32x16_bf16(kf[0],qr[0],f32x16{},0,0,0), P0[2],P0[3],P0[4],P0[5],     pw0[0]=PKW(P0,0), pw0[1]=PKW(P0,2), pw0); \
    VRD(4); SBAR(); GAPA(C1=__builtin_amdgcn_mfma_f32_32x32x16_bf16(kf[1],qr[0],f32x16{},0,0,0), P0[6],P0[7],P0[8],P0[9],     pw0[2]=PKW(P0,4), pw0[3]=PKW(P0,6), pw0); \
    VRD(1); SBAR(); GAPA(C0=__builtin_amdgcn_mfma_f32_32x32x16_bf16(kf[2],qr[1],C0,0,0,0),   P0[10],P0[11],P0[12],P0[13], pw1[0]=PKW(P0,8), pw1[1]=PKW(P0,10), pw1); \
    VRD(5); SBAR(); GAPA(C1=__builtin_amdgcn_mfma_f32_32x32x16_bf16(kf[3],qr[1],C1,0,0,0),   P0[14],P0[15],P1[0],P1[1],   pw1[2]=PKW(P0,12),pw1[3]=PKW(P0,14), pw1); \
    VRD(2); SBAR(); GAPA(C0=__builtin_amdgcn_mfma_f32_32x32x16_bf16(kf[4],qr[2],C0,0,0,0),   P1[2],P1[3],P1[4],P1[5],     pw2[0]=PKW(P1,0), pw2[1]=PKW(P1,2), pw2); \
    VRD(6); SBAR(); GAPA(C1=__builtin_amdgcn_mfma_f32_32x32x16_bf16(kf[5],qr[2],C1,0,0,0),   P1[6],P1[7],P1[8],P1[9],     pw2[2]=PKW(P1,4), pw2[3]=PKW(P1,6), pw2); \
    VRD(3); SBAR(); GAPA(C0=__builtin_amdgcn_mfma_f32_32x32x16_bf16(kf[6],qr[3],C0,0,0,0),   P1[10],P1[11],P1[12],P1[13], pw3[0]=PKW(P1,8), pw3[1]=PKW(P1,10), pw3); \
    VRD(7); SBAR(); GAPA(C1=__builtin_amdgcn_mfma_f32_32x32x16_bf16(kf[7],qr[3],C1,0,0,0),   P1[14],P1[15],0.f,0.f,       pw3[2]=PKW(P1,12),pw3[3]=PKW(P1,14), pw3); \
    l_reg+=sacc; \
    if(GK){DMA_K((t)+3,sl_cur);} if(GV){DMA_V((t)+1,sl_next);} \
    CMASK(C0,C1,t); \
    { float a=MX3(C0[0],C0[1],C1[0]),b=MX3(C0[2],C0[3],C1[1]); a=MX3(a,C1[2],C1[3]); \
      _Pragma("unroll") for(int r=4;r<16;r+=4){a=MX3(a,C0[r],C0[r+1]);b=MX3(b,C0[r+2],C0[r+3]);a=MX3(a,C1[r],C1[r+1]);b=MX3(b,C1[r+2],C1[r+3]);} \
      float rm=__builtin_fmaxf(a,b); { auto rr=__builtin_amdgcn_permlane32_swap(__float_as_uint(rm),__float_as_uint(rm),false,false); rm=__builtin_fmaxf(__uint_as_float(rr[0]),__uint_as_float(rr[1])); } \
      resc=false; \
      if(__builtin_expect(__any(rm>(float)THRL),0)){ const float dl=__builtin_fmaxf(rm,0.f); mhat+=dl; \
        _Pragma("unroll") for(int r=0;r<16;++r){C0[r]-=dl;C1[r]-=dl;} \
        const float f=__builtin_amdgcn_exp2f(-dl); l_reg*=f; if(hi==0)wsf[r32]=f; resc=true; } } \
    SBAR(); \
    GAPB(o[0]=__builtin_amdgcn_mfma_f32_32x32x16_bf16(PAF(0),VFR(0),o[0],0,0,0), C0,0); \
    GAPB(o[1]=__builtin_amdgcn_mfma_f32_32x32x16_bf16(PAF(0),VFR(4),o[1],0,0,0), C0,4); \
    KRD(GL,0); GAPB(o[0]=__builtin_amdgcn_mfma_f32_32x32x16_bf16(PAF(1),VFR(1),o[0],0,0,0), C0,8); \
    KRD(GL,1); GAPB(o[1]=__builtin_amdgcn_mfma_f32_32x32x16_bf16(PAF(1),VFR(5),o[1],0,0,0), C0,12); \
    KRD(GL,2); GAPB(o[0]=__builtin_amdgcn_mfma_f32_32x32x16_bf16(PAF(2),VFR(2),o[0],0,0,0), C1,0); \
    KRD(GL,3); GAPB(o[1]=__builtin_amdgcn_mfma_f32_32x32x16_bf16(PAF(2),VFR(6),o[1],0,0,0), C1,4); \
    GAPB(o[0]=__builtin_amdgcn_mfma_f32_32x32x16_bf16(PAF(3),VFR(3),o[0],0,0,0), C1,8); \
    GAPB(o[1]=__builtin_amdgcn_mfma_f32_32x32x16_bf16(PAF(3),VFR(7),o[1],0,0,0), C1,12); \
    }while(0)
  int t=1;
  for(;t+5<NT;t+=2){
    STEP(pB0,pB1,pA0,pA1,t,true,true,true);     WAIT_BAR(2); RESC(); ROT();
    STEP(pA0,pA1,pB0,pB1,t+1,true,true,true);   WAIT_BAR(2); RESC(); ROT();
  }
  #undef CMASK
  #define CMASK(P0,P1,t) do{ _Pragma("unroll") for(int r_=0;r_<16;++r_){P0[r_]-=mhat;P1[r_]-=mhat;} amask(P0,P1,mldsw[(t)*64]); }while(0)
  #define ENDW(tt) do{ if((tt)+3<NT){WAIT_BAR(2);} else if((tt)+2<NT){WAIT_BAR(1);} else {WAIT_BAR(0);} }while(0)
  for(;t+1<NT;t+=2){
    STEP(pB0,pB1,pA0,pA1,t,(t+3<NT),(t+1<NT),(t+1<NT));       ENDW(t);   RESC(); ROT();
    STEP(pA0,pA1,pB0,pB1,t+1,(t+4<NT),(t+2<NT),(t+2<NT));     ENDW(t+1); RESC(); ROT();
  }
  STEP(pB0,pB1,pA0,pA1,NT-1,false,false,false); RESC();
  { float sacc=pB0[0]+pB0[1]; _Pragma("unroll") for(int r=2;r<16;++r)sacc+=pB0[r]; _Pragma("unroll") for(int r=0;r<16;++r)sacc+=pB1[r]; l_reg+=sacc;
    pw0=(u32x4){PKW(pB0,0),PKW(pB0,2),PKW(pB0,4),PKW(pB0,6)};pw1=(u32x4){PKW(pB0,8),PKW(pB0,10),PKW(pB0,12),PKW(pB0,14)};pw2=(u32x4){PKW(pB1,0),PKW(pB1,2),PKW(pB1,4),PKW(pB1,6)};pw3=(u32x4){PKW(pB1,8),PKW(pB1,10),PKW(pB1,12),PKW(pB1,14)};
    SBAR(); pv(o,vb0+sl_cur,PAF(0),PAF(1),PAF(2),PAF(3)); }
  #undef PKW
  #undef PAF
  #undef VFR
  #undef PIN
  #undef MX3
  #undef GAPA
  #undef GAPB
  #undef EX
  #undef VRD
  #undef KRD
  #undef STEP
  #undef ENDW
  {auto rr=__builtin_amdgcn_permlane32_swap(__float_as_uint(l_reg),__float_as_uint(l_reg),false,false);l_reg=__uint_as_float(rr[0])+__uint_as_float(rr[1]);}
  if(hi==0)wsf[32+r32]=l_reg;asm volatile("s_waitcnt lgkmcnt(0)":::"memory");
  float rli[16];
  #pragma unroll
  for(int r=0;r<16;++r)rli[r]=__builtin_amdgcn_rcpf(wsf[32+crow(r,hi)]);
  bf16*Ow=O+(rowbase+q0+wid*QBLK)*DM+h*D;
  { bf16*stg=(bf16*)(shm+LDS_OST)+wid*2048;
    #pragma unroll
    for(int r=0;r<16;++r){const int orow=crow(r,hi);
      #pragma unroll
      for(int d0=0;d0<2;++d0)stg[orow*64+d0*32+r32]=__float2bfloat16(o[d0][r]*rli[r]);}
    asm volatile("s_waitcnt lgkmcnt(0)":::"memory");
    #pragma unroll
    for(int i=0;i<4;++i){const int row=i*8+(lane>>3),ch=lane&7; const u32x4 v=*(const u32x4*)(stg+row*64+ch*8); ATTN_STORE16(Ow+(long)row*DM+ch*8,v);} }
  asm volatile("s_waitcnt lgkmcnt(0)\n\ts_barrier":::"memory");
  #undef DMA_K
  #undef DMA_V
  #undef CMASK
  #undef START
  #undef RESC
  #undef ROT
}
constexpr int ATTN_LDS_BYTES=LDS_BYTES;
struct AttnTensors { const bf16* Q; const bf16* K; const bf16* V; bf16* O; };
struct AttnUnit { int bh; int qb; };
struct StaticOrder {
  int vcu;
  __device__ __forceinline__ explicit StaticOrder(int grid,int block):vcu((block%8)*(grid/8)+block/8){}
  __device__ __forceinline__ bool next(int i,AttnUnit&u)const{ if(i>=4)return false; const int s=vcu&7; u.bh=vcu>>3; u.qb=(i==0)?s:(i==1)?15-s:(i==2)?16+s:31-s; return true; }
  __device__ __forceinline__ void a_ready(const AttnUnit&)const{}
  __device__ __forceinline__ void done(const AttnUnit&)const{}
};
#undef SBAR
#undef WAIT_BAR
}

constexpr int DM_ = 2048, PB = 4, PT_ = 2048, SB_ = 128, ST_ = 4, NPAGES = 16, PAGE = 128;
constexpr int MP = PB * PT_;
constexpr int MS = SB_ * ST_;
constexpr int MROWS = MP + MS;
constexpr int NIN = 7424;
constexpr int DFF = 5632, DFF2 = 11264;
constexpr float EPS_ = 1e-6f;
constexpr float C2 = 0.125f * 1.4426950408889634f;
constexpr size_t O_YP = 0, O_YS = O_YP + (size_t)MP * DM_, O_KP = O_YS + (size_t)MS * DM_, O_VP = O_KP + (size_t)MP * 256, O_KIP = O_VP + (size_t)MP * 256,
                 O_SRP = O_KIP + (size_t)MP * 64, O_SIP = O_SRP + 4 * 64 * 64, O_CP = O_SIP + 4 * 64 * 64, O_KS = O_CP + (size_t)4 * 2 * DFF2, O_VS = O_KS + (size_t)MS * 256,
                 O_KIS = O_VS + (size_t)MS * 256, O_SRS = O_KIS + (size_t)MS * 64, O_SIS = O_SRS + (size_t)128 * 64 * 64, O_CS = O_SIS + (size_t)128 * 64 * 64, O_END = O_CS + (size_t)128 * 2 * DFF2;
constexpr size_t MiB = 1u << 20;
constexpr size_t WS_CTL = 0, CTL_ZERO_BYTES = 1 * MiB;
constexpr size_t WS_WIN = 1 * MiB, WS_WP = 30 * MiB, WS_WG = 34 * MiB, WS_WO = 42 * MiB, WS_WUP = 50 * MiB, WS_WDN = 94 * MiB;
constexpr size_t WS_XB = 116 * MiB, WS_Q = 150 * MiB, WS_KB = 167 * MiB, WS_VB = 172 * MiB, WS_QI = 177 * MiB, WS_KI = 186 * MiB, WS_WI = 188 * MiB, WS_RS0 = 189 * MiB;
constexpr size_t WS_U = 190 * MiB, WS_SGA = 207 * MiB, WS_SGB = 241 * MiB, WS_Z = 275 * MiB, WS_MRG = 292 * MiB, WS_SS1 = 326 * MiB, WS_SS2 = 328 * MiB;
constexpr size_t WS_MASK = 330 * MiB, WS_LIST = 332 * MiB, WS_SCP = 333 * MiB, WS_SCS = 397 * MiB, WS_UP = 402 * MiB, WS_ACT = 590 * MiB, WS_O = WS_Q  , WS_END = 684 * MiB;
constexpr int SCS_PITCH = 2304;
constexpr int CW_BAR = 4096;
constexpr int CW_QUEUE = 16384;
constexpr int RING_OFF = 0, RING_BYTES = 131072;
constexpr int AMASK_OFF = 86016;
constexpr int MISC_OFF = 151552;
constexpr int LDS_BYTES = 155648;
static_assert(AMASK_OFF >= attn_body::ATTN_LDS_BYTES && AMASK_OFF + 65536 <= MISC_OFF && MISC_OFF + 512 <= LDS_BYTES, "LDS map");

#define GAS __attribute__((address_space(1)))
#define LAS __attribute__((address_space(3)))
typedef unsigned short bf16;
typedef unsigned v4u __attribute__((ext_vector_type(4)));
typedef unsigned v2u __attribute__((ext_vector_type(2)));
typedef float f32x4 __attribute__((ext_vector_type(4)));
typedef float f32x16 __attribute__((ext_vector_type(16)));
typedef short bf16x8 __attribute__((ext_vector_type(8)));
typedef short s16x4 __attribute__((ext_vector_type(4)));
typedef GAS unsigned gu32;
#define RLX_AGENT __ATOMIC_RELAXED, __HIP_MEMORY_SCOPE_AGENT
#define LDS_WAIT() asm volatile("s_waitcnt lgkmcnt(0)" ::: "memory")
#define VM_WAIT() asm volatile("s_waitcnt vmcnt(0)" ::: "memory")
__device__ __forceinline__ unsigned f2bf(float f) { unsigned u = __builtin_bit_cast(unsigned, f); return (u + 0x7fffu + ((u >> 16) & 1u)) >> 16; }
__device__ __forceinline__ unsigned pk2(float lo, float hi) { return pg8::cvt_pk_bf16(lo, hi); }
__device__ __forceinline__ float bflo(unsigned w) { return __uint_as_float(w << 16); }
__device__ __forceinline__ float bfhi(unsigned w) { return __uint_as_float(w & 0xffff0000u); }
using pg8::sigmoidf_;

#define XB_TMO      128
#define XB_XCNT(j)  (256  + 64 * (j))
#define XB_XSUB(j)  (1280 + 64 * (j))
#define XB_XGEN(j)  (2304 + 64 * (j))
#define XB_TOP      3328
#define XB_TOPGEN   3392
#define XCD_BAR_WORDS 3456
#define XB_SPIN_CAP (1u << 18)
__device__ __forceinline__ unsigned xb_ld(unsigned* p)              { return __hip_atomic_load(p, __ATOMIC_RELAXED, __HIP_MEMORY_SCOPE_AGENT); }
__device__ __forceinline__ unsigned xb_add(unsigned* p, unsigned v) { return __hip_atomic_fetch_add(p, v, __ATOMIC_RELAXED, __HIP_MEMORY_SCOPE_AGENT); }
__device__ __forceinline__ unsigned xb_xcc_id() { return (unsigned)__builtin_amdgcn_s_getreg((3 << 11) | 20) & 0xFu; }
#define XB_SPIN(cond, bar) do { unsigned _sp = 0; while (cond) { __builtin_amdgcn_s_sleep(1); \
    if ((++_sp & 255u) == 0u) { if (xb_ld(&(bar)[XB_TMO])) break; if (_sp > XB_SPIN_CAP) { atomicAdd(&(bar)[XB_TMO], 1u); break; } } } } while (0)
struct XcdBarrier { unsigned* bar; unsigned x; volatile LAS unsigned* st; };
__device__ __forceinline__ XcdBarrier xcd_barrier_post(unsigned* bar, volatile LAS unsigned* st) {
    XcdBarrier b; b.bar = bar; b.x = xb_xcc_id(); b.st = st;
    if (threadIdx.x == 0) (void)xb_add(&bar[XB_XCNT(b.x)], 1u);
    return b;
}
__device__ __forceinline__ void xcd_barrier_complete(unsigned* bar, unsigned x, unsigned& nloc, unsigned& nx) {
    const unsigned G = gridDim.x * gridDim.y * gridDim.z;
    unsigned sum, cnt, mine, sp = 0u;
    for (;;) {
        sum = 0u; cnt = 0u; mine = 0u;
#pragma unroll
        for (unsigned j = 0; j < 16; ++j) { const unsigned c = xb_ld(&bar[XB_XCNT(j)]); sum += c; cnt += (c > 0u) ? 1u : 0u; mine = (j == x) ? c : mine; }
        if (sum == G) break;
        __builtin_amdgcn_s_sleep(1);
        if ((++sp & 255u) == 0u) { if (xb_ld(&bar[XB_TMO])) break; if (sp > XB_SPIN_CAP) { atomicAdd(&bar[XB_TMO], 1u); break; } }
    }
    nloc = mine > 0u ? mine : 1u; nx = cnt > 0u ? cnt : 1u;
}
__device__ __forceinline__ void xcd_barrier(const XcdBarrier& b) {
    asm volatile("s_waitcnt vmcnt(0)" ::: "memory");
    __syncthreads();
    if (threadIdx.x == 0) {
        unsigned* bar = b.bar;
        __builtin_amdgcn_s_waitcnt(0);
        unsigned nloc = b.st[0], nx = b.st[1];
        if (nloc == 0u) { xcd_barrier_complete(bar, b.x, nloc, nx); b.st[0] = nloc; b.st[1] = nx; }
        const unsigned old = xb_add(&bar[XB_XSUB(b.x)], 1u);
        const unsigned gen = old / nloc;
        if (old + 1u == (gen + 1u) * nloc) {
            __builtin_amdgcn_fence(__ATOMIC_RELEASE, "agent");
            asm volatile("s_waitcnt vmcnt(0)" ::: "memory");
            const unsigned og = xb_add(&bar[XB_TOP], 1u);
            const unsigned tg = og / nx;
            if (og + 1u == (tg + 1u) * nx) xb_add(&bar[XB_TOPGEN], 1u);
            else XB_SPIN(xb_ld(&bar[XB_TOPGEN]) == tg, bar);
            __builtin_amdgcn_fence(__ATOMIC_ACQUIRE, "agent");
            xb_add(&bar[XB_XGEN(b.x)], 1u);
            asm volatile("s_waitcnt vmcnt(0)" ::: "memory");
        } else {
            XB_SPIN(xb_ld(&bar[XB_XGEN(b.x)]) == gen, bar);
            __builtin_amdgcn_fence(__ATOMIC_ACQUIRE, "agent");
            asm volatile("s_waitcnt vmcnt(0)" ::: "memory");
        }
    }
    __syncthreads();
}

struct Args { const void* in[28]; float* out; unsigned char* ws; int ph_lo, ph_hi, li, qoff, flags, pad; };
struct Frame {
    LAS unsigned char* lds;
    volatile LAS unsigned* MISC;
    gu32* ctl;
    int tid, lane, wave, vcu, G;
    const void* const* in; float* out; unsigned char* ws;
};
#define INF(k) ((const float*)F.in[k])
#define WSP(T, off) ((T*)(F.ws + (off)))
__device__ __forceinline__ float wave_sum(float v) {
#pragma unroll
    for (int o = 1; o < 64; o <<= 1) v += __shfl_xor(v, o);
    return v;
}
__device__ __forceinline__ int queue_pop(Frame& F, int q) {
    __syncthreads();
    if (F.tid == 0) F.MISC[16] = __hip_atomic_fetch_add(F.ctl + CW_QUEUE + 64 * q, 1u, RLX_AGENT);
    __syncthreads();
    return (int)F.MISC[16];
}

using pg8::Unit;
#define EPI_ARGS const f32x4 (&acc)[2][2][4][2], const Unit& u, int wr, int wc, int fr, int fq
__device__ __forceinline__ v4u pack8(f32x4 a, f32x4 b) { v4u w; w.x = pk2(a[0], a[1]); w.y = pk2(a[2], a[3]); w.z = pk2(b[0], b[1]); w.w = pk2(b[2], b[3]); return w; }
__device__ __forceinline__ void unpack8(v4u w, f32x4& a, f32x4& b) { a = (f32x4){bflo(w.x), bfhi(w.x), bflo(w.y), bfhi(w.y)}; b = (f32x4){bflo(w.z), bfhi(w.z), bflo(w.w), bfhi(w.w)}; }
__device__ __forceinline__ f32x4 sig4(f32x4 v) { return (f32x4){sigmoidf_(v[0]), sigmoidf_(v[1]), sigmoidf_(v[2]), sigmoidf_(v[3])}; }

struct EpiIn {
    static constexpr bool PERM = true, AFTER_DRAIN = false;
    bf16 *Q, *KB, *VB, *QI, *KI, *U, *SGA, *SGB; float* WI; const float* RS0; float* out;
    __device__ __forceinline__ void operator()(EPI_ARGS) const {
        const int row0 = u.pm * 256 + wr * 64 + fr, cl = wc * 32 + 8 * fq, pn = u.pn;
        if (pn < 4 || pn == 6 || pn == 7 || (pn >= 9 && pn < 13)) {
            bf16* base; int ldc, colt; float sc = 1.f;
            if (pn < 4) { base = Q; ldc = 1024; colt = pn * 256; sc = C2; } else if (pn < 8) { base = QI; ldc = 512; colt = (pn - 6) * 256; } else { base = U; ldc = 1024; colt = (pn - 9) * 256; }
#pragma unroll
            for (int ai = 0; ai < 2; ++ai)
#pragma unroll
                for (int m = 0; m < 4; ++m) { const int r = row0 + ai * 128 + m * 16; const float s = RS0[r] * sc; bf16* rowp = base + (size_t)r * ldc + colt + cl;
#pragma unroll
                    for (int bj = 0; bj < 2; ++bj) *(v4u*)(rowp + bj * 128) = pack8(acc[ai][bj][m][0] * s, acc[ai][bj][m][1] * s); }
        } else if (pn >= 13) {
            bf16* base = pn < 21 ? SGA : SGB; const int colt = (pn - (pn < 21 ? 13 : 21)) * 256;
#pragma unroll
            for (int ai = 0; ai < 2; ++ai)
#pragma unroll
                for (int m = 0; m < 4; ++m) { const int r = row0 + ai * 128 + m * 16; const float s = RS0[r]; bf16* rowp = base + (size_t)r * 2048 + colt + cl;
#pragma unroll
                    for (int bj = 0; bj < 2; ++bj) *(v4u*)(rowp + bj * 128) = pack8(sig4(acc[ai][bj][m][0] * s), sig4(acc[ai][bj][m][1] * s)); }
        } else if (pn == 4 || pn == 5) {
            bf16* cb = pn == 4 ? KB : VB; float* oP = out + (pn == 4 ? O_KP : O_VP); float* oS = out + (pn == 4 ? O_KS : O_VS);
#pragma unroll
            for (int ai = 0; ai < 2; ++ai)
#pragma unroll
                for (int m = 0; m < 4; ++m) { const int r = row0 + ai * 128 + m * 16; const float s = RS0[r]; float* orow = (r < MP ? oP + (size_t)r * 256 : oS + (size_t)(r - MP) * 256) + cl; bf16* crow_ = cb + (size_t)r * 256 + cl;
#pragma unroll
                    for (int bj = 0; bj < 2; ++bj) { const f32x4 v0 = acc[ai][bj][m][0] * s, v1 = acc[ai][bj][m][1] * s; *(f32x4*)(orow + bj * 128) = v0; *(f32x4*)(orow + bj * 128 + 4) = v1; *(v4u*)(crow_ + bj * 128) = pack8(v0, v1); } }
        } else if (pn == 8) {
            float* oP = out + O_KIP; float* oS = out + O_KIS;
#pragma unroll
            for (int ai = 0; ai < 2; ++ai)
#pragma unroll
                for (int m = 0; m < 4; ++m) { const int r = row0 + ai * 128 + m * 16; const float s = RS0[r]; const f32x4 v0 = acc[ai][0][m][0] * s, v1 = acc[ai][0][m][1] * s;
                    if (cl < 64) { float* orow = (r < MP ? oP + (size_t)r * 64 : oS + (size_t)(r - MP) * 64) + cl; *(f32x4*)orow = v0; *(f32x4*)(orow + 4) = v1; *(v4u*)(KI + (size_t)r * 64 + cl) = pack8(v0, v1); }
                    else if (cl == 64) { *(f32x4*)(WI + (size_t)r * 8) = v0; *(f32x4*)(WI + (size_t)r * 8 + 4) = v1; } }
        }
    }
};
struct EpiGlu {
    static constexpr bool PERM = true, AFTER_DRAIN = false;
    const bf16* SGB; bf16* MRG;
    __device__ __forceinline__ void operator()(EPI_ARGS) const {
        const int row0 = u.pm * 256 + wr * 64 + fr, col = u.pn * 128 + wc * 32 + 8 * fq;
#pragma unroll
        for (int ai = 0; ai < 2; ++ai)
#pragma unroll
            for (int m = 0; m < 4; ++m) { const size_t off = (size_t)(row0 + ai * 128 + m * 16) * 2048 + col; f32x4 g0, g1; unpack8(*(const v4u*)(SGB + off), g0, g1);
                const f32x4 y0 = acc[ai][0][m][0] * sig4(acc[ai][1][m][0]) * g0, y1 = acc[ai][0][m][1] * sig4(acc[ai][1][m][1]) * g1;
                *(v4u*)(MRG + off) = pack8(y0, y1); }
    }
};
struct EpiProj {
    static constexpr bool PERM = true, AFTER_DRAIN = false;
    const bf16* SGA; bf16* MRG;
    __device__ __forceinline__ void operator()(EPI_ARGS) const {
        const int row0 = u.pm * 256 + wr * 64 + fr, col = u.pn * 256 + wc * 32 + 8 * fq;
#pragma unroll
        for (int ai = 0; ai < 2; ++ai)
#pragma unroll
            for (int m = 0; m < 4; ++m)
#pragma unroll
                for (int bj = 0; bj < 2; ++bj) { const size_t off = (size_t)(row0 + ai * 128 + m * 16) * 2048 + col + bj * 128; f32x4 g0, g1, p0, p1; unpack8(*(const v4u*)(SGA + off), g0, g1); unpack8(*(const v4u*)(MRG + off), p0, p1);
                    *(v4u*)(MRG + off) = pack8(p0 + g0 * acc[ai][bj][m][0], p1 + g1 * acc[ai][bj][m][1]); }
    }
};
struct EpiOut {
    static constexpr bool PERM = true, AFTER_DRAIN = false;
    const float *xP, *xS; float* out; bf16* X1B; float* SS1;
    __device__ __forceinline__ void operator()(EPI_ARGS) const {
        const int row0 = u.pm * 256 + wr * 64 + fr, col = u.pn * 256 + wc * 32 + 8 * fq;
#pragma unroll
        for (int ai = 0; ai < 2; ++ai) {
            f32x4 xv[4][2][2];
#pragma unroll
            for (int m = 0; m < 4; ++m) { const int r = row0 + ai * 128 + m * 16; const float* xrow = (r < MP ? xP + (size_t)r * 2048 : xS + (size_t)(r - MP) * 2048) + col;
#pragma unroll
                for (int bj = 0; bj < 2; ++bj) { xv[m][bj][0] = *(const f32x4*)(xrow + bj * 128); xv[m][bj][1] = *(const f32x4*)(xrow + bj * 128 + 4); } }
#pragma unroll
            for (int m = 0; m < 4; ++m) { const int r = row0 + ai * 128 + m * 16; float* yrow = out + (size_t)r * 2048 + col;
                float ss = 0.f;
#pragma unroll
                for (int bj = 0; bj < 2; ++bj) { const f32x4 v0 = xv[m][bj][0] + acc[ai][bj][m][0], v1 = xv[m][bj][1] + acc[ai][bj][m][1];
                    *(f32x4*)(yrow + bj * 128) = v0; *(f32x4*)(yrow + bj * 128 + 4) = v1; *(v4u*)(X1B + (size_t)r * 2048 + col + bj * 128) = pack8(v0, v1);
                    ss += (v0[0] * v0[0] + v0[1] * v0[1]) + (v0[2] * v0[2] + v0[3] * v0[3]) + (v1[0] * v1[0] + v1[1] * v1[1]) + (v1[2] * v1[2] + v1[3] * v1[3]); }
                ss += __shfl_xor(ss, 16); ss += __shfl_xor(ss, 32);
                if (fq == 0) SS1[(size_t)r * 32 + u.pn * 4 + wc] = ss; }
        }
    }
};
__device__ __forceinline__ float row_rs(const float* part) {
    const f32x4* p = (const f32x4*)part; float s = 0.f;
#pragma unroll
    for (int i = 0; i < 8; ++i) { const f32x4 v = p[i]; s += (v[0] + v[1]) + (v[2] + v[3]); }
    return 1.0f / sqrtf(s * (1.0f / 2048.0f) + EPS_);
}
struct EpiUp {
    static constexpr bool PERM = true, AFTER_DRAIN = false;
    const float* SS1; bf16* UP; float* out;
    __device__ __forceinline__ void operator()(EPI_ARGS) const {
        const int row0 = u.pm * 256 + wr * 64 + fr, cl = wc * 32 + 8 * fq, lane = fr + 16 * fq;
        const float rsA = row_rs(SS1 + (size_t)(u.pm * 256 + wr * 64 + lane) * 32), rsB = row_rs(SS1 + (size_t)(u.pm * 256 + 128 + wr * 64 + lane) * 32);
        float rs[2][4];
#pragma unroll
        for (int m = 0; m < 4; ++m) { rs[0][m] = __shfl(rsA, 16 * m + fr); rs[1][m] = __shfl(rsB, 16 * m + fr); }
#pragma unroll
        for (int ai = 0; ai < 2; ++ai)
#pragma unroll
            for (int m = 0; m < 4; ++m) { const int r = row0 + ai * 128 + m * 16; const float s = rs[ai][m]; bf16* rowp = UP + (size_t)r * DFF2 + u.pn * 256 + cl;
                float* cdst = nullptr;
                if (r < MP) { const int t = r & 2047; if (t >= 2046) cdst = out + O_CP + (size_t)((r >> 11) * 2 + (t - 2046)) * DFF2; }
                else { const int t = (r - MP) & 3; if (t >= 2) cdst = out + O_CS + (size_t)(((r - MP) >> 2) * 2 + (t - 2)) * DFF2; }
#pragma unroll
                for (int bj = 0; bj < 2; ++bj) { const f32x4 v0 = acc[ai][bj][m][0] * s, v1 = acc[ai][bj][m][1] * s; *(v4u*)(rowp + bj * 128) = pack8(v0, v1);
                    if (cdst) { float* d = cdst + (bj ? DFF : 0) + u.pn * 128 + cl; *(f32x4*)d = v0; *(f32x4*)(d + 4) = v1; } } }
    }
};
struct EpiDown {
    static constexpr bool PERM = true, AFTER_DRAIN = false;
    float* out;
    __device__ __forceinline__ void operator()(EPI_ARGS) const {
        const int row0 = u.pm * 256 + wr * 64 + fr, col = u.pn * 256 + wc * 32 + 8 * fq;
#pragma unroll
        for (int ai = 0; ai < 2; ++ai) {
            f32x4 yv[4][2][2];
#pragma unroll
            for (int m = 0; m < 4; ++m) { const float* yrow = out + (size_t)(row0 + ai * 128 + m * 16) * 2048 + col;
#pragma unroll
                for (int bj = 0; bj < 2; ++bj) { yv[m][bj][0] = *(const f32x4*)(yrow + bj * 128); yv[m][bj][1] = *(const f32x4*)(yrow + bj * 128 + 4); } }
#pragma unroll
            for (int m = 0; m < 4; ++m) { float* yrow = out + (size_t)(row0 + ai * 128 + m * 16) * 2048 + col;
#pragma unroll
                for (int bj = 0; bj < 2; ++bj) { *(f32x4*)(yrow + bj * 128) = yv[m][bj][0] + acc[ai][bj][m][0]; *(f32x4*)(yrow + bj * 128 + 4) = yv[m][bj][1] + acc[ai][bj][m][1]; } }
        }
    }
};
struct OrderGlu {
    int c;
    __device__ __forceinline__ bool next(int i, Unit& u) const {
        if (i < 2) { const int x = c & 7, ii = c >> 3; u.pm = 4 * x + (ii >> 3); u.pn = 2 * (ii & 7) + i; u.kofs = 0; return true; }
        return false; }
    __device__ __forceinline__ void a_ready(const Unit&) const {}
    __device__ __forceinline__ void done(const Unit&) const {}
};
struct OrderProj {
    int c;
    __device__ __forceinline__ bool next(int i, Unit& u) const {
        if (i == 0) { const int x = c & 7, ii = c >> 3; u.pm = 4 * x + (ii >> 3); u.pn = ii & 7; u.kofs = 0; return true; }
        return false; }
    __device__ __forceinline__ void a_ready(const Unit&) const {}
    __device__ __forceinline__ void done(const Unit&) const {}
};

template <int MAT> __device__ __forceinline__ int colmap(int n) {
    if (MAT == 0) return n < 2120 ? n : (n < 2304 ? -1 : n - 184);
    if (MAT == 2) { const int j = n >> 8, i = n & 255; return i < 128 ? 128 * j + i : 2048 + 128 * j + (i - 128); }
    if (MAT == 4) { const int j = n >> 8, i = n & 255; return i < 128 ? 128 * j + i : DFF + 128 * j + (i - 128); }
    return n;
}
template <int MAT> __device__ __forceinline__ void p0_transpose_item(const float* W, int K, int Nsrc, int Nrows, const float* gain, bf16* WT, LAS float* scr, int item, int lane) {
    const int nblk = Nrows / 64, kb = item / nblk, nb = item % nblk, k0 = 64 * kb, n0 = 64 * nb;
    const int c4 = lane & 15, kr = lane >> 4;
    const int nc = colmap<MAT>(n0 + 4 * c4);
    f32x4 v[16];
#pragma unroll
    for (int i = 0; i < 16; ++i) { const int kk = 4 * i + kr; v[i] = (f32x4){0.f, 0.f, 0.f, 0.f}; if (nc >= 0) v[i] = *(const f32x4*)(W + (size_t)(k0 + kk) * Nsrc + nc); }
#pragma unroll
    for (int i = 0; i < 16; ++i) { const int kk = 4 * i + kr; f32x4 t = v[i]; if (gain) t = t * gain[k0 + kk];
        scr[kk * 65 + 4 * c4 + 0] = t[0]; scr[kk * 65 + 4 * c4 + 1] = t[1]; scr[kk * 65 + 4 * c4 + 2] = t[2]; scr[kk * 65 + 4 * c4 + 3] = t[3]; }
    LDS_WAIT(); asm volatile("" ::: "memory");
    const int c = lane & 7;
#pragma unroll
    for (int j = 0; j < 8; ++j) { const int n = (lane >> 3) + 8 * j; const LAS float* s = scr + (8 * c) * 65 + n;
        v4u o; o.x = pk2(s[0 * 65], s[1 * 65]); o.y = pk2(s[2 * 65], s[3 * 65]); o.z = pk2(s[4 * 65], s[5 * 65]); o.w = pk2(s[6 * 65], s[7 * 65]);
        *(GAS v4u*)(WT + (size_t)(n0 + n) * K + k0 + 8 * c) = o; }
    LDS_WAIT(); asm volatile("" ::: "memory");
}
__device__ __forceinline__ void p0_prologue(Frame& F) {
    LAS float* scr = (LAS float*)(F.lds + RING_OFF + F.wave * 17408);
    const int gw = F.vcu * 8 + F.wave, NGW = F.G * 8;
    constexpr int I0 = 32 * (NIN / 64), I1 = 16 * 32, I2 = 16 * 64, I3 = 32 * 32, I4 = 32 * (DFF2 / 64), I5 = 88 * 32;
    constexpr int NITEMS = I0 + I1 + I2 + I3 + I4 + I5;
    for (int m = gw; m < MROWS; m += NGW) {
        const float* xrow = m < MP ? INF(0) + (size_t)m * 2048 : INF(1) + (size_t)(m - MP) * 2048;
        const GAS f32x4* xr = (const GAS f32x4*)xrow + F.lane; f32x4 v[8]; float s = 0.f;
#pragma unroll
        for (int j = 0; j < 8; ++j) { v[j] = xr[64 * j]; s += (v[j][0] * v[j][0] + v[j][1] * v[j][1]) + (v[j][2] * v[j][2] + v[j][3] * v[j][3]); }
        s = wave_sum(s);
        GAS v2u* o8 = (GAS v2u*)(WSP(bf16, WS_XB) + (size_t)m * 2048) + F.lane;
#pragma unroll
        for (int j = 0; j < 8; ++j) { v2u w; w.x = pk2(v[j][0], v[j][1]); w.y = pk2(v[j][2], v[j][3]); o8[64 * j] = w; }
        if (F.lane == 0) WSP(float, WS_RS0)[m] = 1.0f / sqrtf(s * (1.0f / 2048.0f) + EPS_);
    }
    for (int it = gw; it < NITEMS; it += NGW) {
        int r = it;
        if (r < I0) { p0_transpose_item<0>(INF(10), 2048, 7240, NIN, INF(9), WSP(bf16, WS_WIN), scr, r, F.lane); continue; } r -= I0;
        if (r < I1) { p0_transpose_item<1>(INF(11), 1024, 2048, 2048, nullptr, WSP(bf16, WS_WP), scr, r, F.lane); continue; } r -= I1;
        if (r < I2) { p0_transpose_item<2>(INF(20), 1024, 4096, 4096, nullptr, WSP(bf16, WS_WG), scr, r, F.lane); continue; } r -= I2;
        if (r < I3) { p0_transpose_item<3>(INF(21), 2048, 2048, 2048, nullptr, WSP(bf16, WS_WO), scr, r, F.lane); continue; } r -= I3;
        if (r < I4) { p0_transpose_item<4>(INF(23), 2048, DFF2, DFF2, INF(22), WSP(bf16, WS_WUP), scr, r, F.lane); continue; } r -= I4;
        p0_transpose_item<5>(INF(26), DFF, 2048, 2048, nullptr, WSP(bf16, WS_WDN), scr, r, F.lane);
    }
}

#define MFMA32(a, b, c) __builtin_amdgcn_mfma_f32_32x32x16_bf16((a), (b), (c), 0, 0, 0)
__device__ __forceinline__ s16x4 tr_read(unsigned lds_addr) { s16x4 r; asm volatile("ds_read_b64_tr_b16 %0, %1\n\ts_waitcnt lgkmcnt(0)" : "=&v"(r) : "v"(lds_addr) : "memory"); return r; }
__device__ __forceinline__ float gelu_tanh(float x) {
    const float t = 1.5957691216057308f * (x + 0.044715f * x * x * x);
    return x * sigmoidf_(t);
}
struct S5Const { bf16x8 Bf[2][2]; bf16x8 Cf[8]; bf16x8 Df; float lbr[2], lbi[2]; };
__device__ __forceinline__ void s5_consts(Frame& F, int g, S5Const& C) {
    const int r32 = F.lane & 31, hi = F.lane >> 5;
    const float step = expf(INF(14)[g]);
#pragma unroll
    for (int pg = 0; pg < 2; ++pg) {
        const int p = 32 * pg + r32; const float ar = INF(12)[g * 64 + p], ai = INF(13)[g * 64 + p];
        const float e = expf(ar * step), lr = e * cosf(ai * step), li = e * sinf(ai * step);
        C.lbr[pg] = lr; C.lbi[pg] = li;
        const float den = 1.0f / (ar * ar + ai * ai), cr = ((lr - 1.f) * ar + li * ai) * den, ci = (li * ar - (lr - 1.f) * ai) * den;
        const float* bre = INF(15) + (size_t)(g * 64 + p) * 16 + 8 * hi; const float* bim = INF(16) + (size_t)(g * 64 + p) * 16 + 8 * hi;
        { const f32x4 br0 = *(const f32x4*)bre, br1 = *(const f32x4*)(bre + 4), bi0 = *(const f32x4*)bim, bi1 = *(const f32x4*)(bim + 4);
#pragma unroll
          for (int j = 0; j < 8; ++j) { const float br = j < 4 ? br0[j & 3] : br1[j & 3], bi = j < 4 ? bi0[j & 3] : bi1[j & 3]; C.Bf[pg][0][j] = (short)f2bf(cr * br - ci * bi); C.Bf[pg][1][j] = (short)f2bf(cr * bi + ci * br); } }
    }
    const int ch = g * 16 + (r32 & 15); const float keep = r32 < 16 ? 1.f : 0.f;
#pragma unroll
    for (int s = 0; s < 8; ++s) { const int blk = s >> 1, p0 = 32 * (blk & 1) + 16 * (s & 1) + 8 * hi; const float* src = (blk < 2 ? INF(17) : INF(18)) + (size_t)ch * 64 + p0; const float sg = blk < 2 ? keep : -keep;
        const f32x4 a = *(const f32x4*)src, b = *(const f32x4*)(src + 4);
        C.Cf[s][0] = (short)f2bf(a[0] * sg); C.Cf[s][1] = (short)f2bf(a[1] * sg); C.Cf[s][2] = (short)f2bf(a[2] * sg); C.Cf[s][3] = (short)f2bf(a[3] * sg);
        C.Cf[s][4] = (short)f2bf(b[0] * sg); C.Cf[s][5] = (short)f2bf(b[1] * sg); C.Cf[s][6] = (short)f2bf(b[2] * sg); C.Cf[s][7] = (short)f2bf(b[3] * sg); }
    const float dv = INF(19)[ch] * keep;
#pragma unroll
    for (int j = 0; j < 8; ++j) C.Df[j] = (short)((8 * hi + j == r32) ? f2bf(dv) : 0u);
}
__device__ __forceinline__ f32x16 s5_ytile(const f32x16 (&x)[4], const bf16x8& ua, const S5Const& C, LAS unsigned char* img, int lane) {
    const int r32 = lane & 31, hi = lane >> 5;
#pragma unroll
    for (int blk = 0; blk < 4; ++blk)
#pragma unroll
        for (int g4 = 0; g4 < 4; ++g4) { v2u w; w.x = pk2(x[blk][4 * g4], x[blk][4 * g4 + 1]); w.y = pk2(x[blk][4 * g4 + 2], x[blk][4 * g4 + 3]);
            *(LAS v2u*)(img + (32 * blk + r32) * 64 + 8 * (2 * g4 + hi)) = w; }
    LDS_WAIT(); asm volatile("" ::: "memory");
    const unsigned base = (unsigned)(size_t)img;
    const int i16 = lane & 15, q = i16 >> 2, p = i16 & 3, bk = (lane >> 4) & 1;
    f32x16 y = {};
#pragma unroll
    for (int sh = 0; sh < 2; ++sh) {
        s16x4 t[8]; const unsigned a0 = base + (64 * sh + 8 * hi + q) * 64 + 8 * (4 * bk + p);
        asm volatile("ds_read_b64_tr_b16 %0, %8\n\tds_read_b64_tr_b16 %1, %8 offset:256\n\tds_read_b64_tr_b16 %2, %8 offset:1024\n\tds_read_b64_tr_b16 %3, %8 offset:1280\n\t"
                     "ds_read_b64_tr_b16 %4, %8 offset:2048\n\tds_read_b64_tr_b16 %5, %8 offset:2304\n\tds_read_b64_tr_b16 %6, %8 offset:3072\n\tds_read_b64_tr_b16 %7, %8 offset:3328\n\ts_waitcnt lgkmcnt(0)"
                     : "=&v"(t[0]), "=&v"(t[1]), "=&v"(t[2]), "=&v"(t[3]), "=&v"(t[4]), "=&v"(t[5]), "=&v"(t[6]), "=&v"(t[7]) : "v"(a0) : "memory");
#pragma unroll
        for (int s2 = 0; s2 < 4; ++s2) { const bf16x8 xa = __builtin_shufflevector(t[2 * s2], t[2 * s2 + 1], 0, 1, 2, 3, 4, 5, 6, 7); y = MFMA32(xa, C.Cf[4 * sh + s2], y); }
    }
    y = MFMA32(ua, C.Df, y);
    return y;
}
__device__ __forceinline__ void s5_unit(Frame& F, int bp, int g) {
    const int lane = F.lane, w = F.wave, r32 = lane & 31, hi = lane >> 5;
    LAS unsigned char* img = F.lds + w * 8192;
    LAS float* EL = (LAS float*)(F.lds + 65536);
    S5Const C; s5_consts(F, g, C);
    const bf16* U = WSP(bf16, WS_U); bf16* Z = WSP(bf16, WS_Z);
    const int rho = r32, rb = 2 * bp + ((rho >> 2) & 1), rtau = (rho & 3) + 4 * (rho >> 3);
    const bf16* ubase = U + (size_t)(rb * 2048 + 256 * w + rtau) * 1024 + g * 16 + 8 * hi;
    float xr[2] = {0.f, 0.f}, xi[2] = {0.f, 0.f};
    bf16x8 uq[4];
#pragma unroll
    for (int j = 0; j < 4; ++j) uq[j] = *(const bf16x8*)(ubase + (size_t)j * 16 * 1024);
#pragma unroll 1
    for (int tt = 0; tt < 16; ++tt) {
        const bf16x8 ua = uq[0]; uq[0] = uq[1]; uq[1] = uq[2]; uq[2] = uq[3];
        if (tt + 4 < 16) uq[3] = *(const bf16x8*)(ubase + (size_t)(tt + 4) * 16 * 1024);
        f32x16 acc[4];
#pragma unroll
        for (int blk = 0; blk < 4; ++blk) acc[blk] = MFMA32(ua, C.Bf[blk & 1][blk >> 1], (f32x16){});
#pragma unroll
        for (int pg = 0; pg < 2; ++pg)
#pragma unroll
            for (int r = 0; r < 16; ++r) { const float nr = C.lbr[pg] * xr[pg] - C.lbi[pg] * xi[pg] + acc[pg][r], ni = C.lbr[pg] * xi[pg] + C.lbi[pg] * xr[pg] + acc[2 + pg][r]; xr[pg] = nr; xi[pg] = ni; }
    }
#pragma unroll
    for (int pg = 0; pg < 2; ++pg) { EL[(w * 4 + pg * 2 + 0) * 64 + lane] = xr[pg]; EL[(w * 4 + pg * 2 + 1) * 64 + lane] = xi[pg]; }
    __syncthreads();
#pragma unroll
    for (int pg = 0; pg < 2; ++pg) {
        float pr = C.lbr[pg], pi = C.lbi[pg];
#pragma unroll
        for (int k = 0; k < 8; ++k) { const float nr = pr * pr - pi * pi, ni = 2.f * pr * pi; pr = nr; pi = ni; }
        float cr = 0.f, ci = 0.f;
        for (int ww = 0; ww < w; ++ww) { const float er = EL[(ww * 4 + pg * 2 + 0) * 64 + lane], ei = EL[(ww * 4 + pg * 2 + 1) * 64 + lane];
            const float nr = pr * cr - pi * ci + er, ni = pr * ci + pi * cr + ei; cr = nr; ci = ni; }
        xr[pg] = cr; xi[pg] = ci;
    }
#pragma unroll
    for (int j = 0; j < 4; ++j) uq[j] = *(const bf16x8*)(ubase + (size_t)j * 16 * 1024);
#pragma unroll 1
    for (int tt = 0; tt < 16; ++tt) {
        const bf16x8 ua = uq[0]; uq[0] = uq[1]; uq[1] = uq[2]; uq[2] = uq[3];
        if (tt + 4 < 16) uq[3] = *(const bf16x8*)(ubase + (size_t)(tt + 4) * 16 * 1024);
        f32x16 acc[4];
#pragma unroll
        for (int blk = 0; blk < 4; ++blk) acc[blk] = MFMA32(ua, C.Bf[blk & 1][blk >> 1], (f32x16){});
#pragma unroll
        for (int pg = 0; pg < 2; ++pg)
#pragma unroll
            for (int r = 0; r < 16; ++r) { const float nr = C.lbr[pg] * xr[pg] - C.lbi[pg] * xi[pg] + acc[pg][r], ni = C.lbr[pg] * xi[pg] + C.lbi[pg] * xr[pg] + acc[2 + pg][r]; xr[pg] = nr; xi[pg] = ni; acc[pg][r] = nr; acc[2 + pg][r] = ni; }
        const f32x16 y = s5_ytile(acc, ua, C, img, lane);
        if (r32 < 16) {
#pragma unroll
            for (int r = 0; r < 16; ++r) { const int orho = (r & 3) + 8 * (r >> 2) + 4 * hi, ob = 2 * bp + ((orho >> 2) & 1), otau = (orho & 3) + 4 * (orho >> 3);
                Z[(size_t)(ob * 2048 + 256 * w + 16 * tt + otau) * 1024 + g * 16 + r32] = (bf16)f2bf(gelu_tanh(y[r])); }
        }
        LDS_WAIT(); asm volatile("" ::: "memory");
    }
    if (w == 7) {
#pragma unroll
        for (int pg = 0; pg < 2; ++pg) { const size_t o = (size_t)((2 * bp + hi) * 64 + g) * 64 + 32 * pg + r32; F.out[O_SRP + o] = xr[pg]; F.out[O_SIP + o] = xi[pg]; }
    }
    {
        const int T = 8 * bp + w;
        const bf16x8 ua = *(const bf16x8*)(U + (size_t)(MP + 32 * T + r32) * 1024 + g * 16 + 8 * hi);
        f32x16 acc[4];
#pragma unroll
        for (int blk = 0; blk < 4; ++blk) acc[blk] = MFMA32(ua, C.Bf[blk & 1][blk >> 1], (f32x16){});
#pragma unroll
        for (int pg = 0; pg < 2; ++pg)
#pragma unroll
            for (int k4 = 0; k4 < 4; ++k4) { const size_t so = (size_t)((8 * T + 2 * k4 + hi) * 64 + g) * 64 + 32 * pg + r32; float sr = INF(5)[so], si = INF(6)[so];
#pragma unroll
                for (int t = 0; t < 4; ++t) { const int r = 4 * k4 + t; const float nr = C.lbr[pg] * sr - C.lbi[pg] * si + acc[pg][r], ni = C.lbr[pg] * si + C.lbi[pg] * sr + acc[2 + pg][r]; sr = nr; si = ni; acc[pg][r] = nr; acc[2 + pg][r] = ni; }
                F.out[O_SRS + so] = sr; F.out[O_SIS + so] = si; }
        const f32x16 y = s5_ytile(acc, ua, C, img, lane);
        if (r32 < 16) {
#pragma unroll
            for (int r = 0; r < 16; ++r) { const int orho = (r & 3) + 8 * (r >> 2) + 4 * hi; Z[(size_t)(MP + 32 * T + orho) * 1024 + g * 16 + r32] = (bf16)f2bf(gelu_tanh(y[r])); }
        }
        LDS_WAIT();
    }
    __syncthreads();
}

__device__ __forceinline__ unsigned wave_incl_scan(unsigned v, int lane) {
    (void)lane;
    v += (unsigned)__builtin_amdgcn_update_dpp(0, (int)v, 0x111, 0xf, 0xf, true);
    v += (unsigned)__builtin_amdgcn_update_dpp(0, (int)v, 0x112, 0xf, 0xf, true);
    v += (unsigned)__builtin_amdgcn_update_dpp(0, (int)v, 0x114, 0xf, 0xf, true);
    v += (unsigned)__builtin_amdgcn_update_dpp(0, (int)v, 0x118, 0xf, 0xf, true);
    v += (unsigned)__builtin_amdgcn_update_dpp(0, (int)v, 0x142, 0xa, 0xf, false);
    v += (unsigned)__builtin_amdgcn_update_dpp(0, (int)v, 0x143, 0xc, 0xf, false);
    return v;
}
__device__ __forceinline__ unsigned lane63(unsigned v) { return (unsigned)__builtin_amdgcn_readlane((int)v, 63); }
__device__ __forceinline__ unsigned fkey(float f) { const unsigned u = __float_as_uint(f); return (u & 0x80000000u) ? ~u : (u | 0x80000000u); }
template <int MODE> __device__ __forceinline__ void select_query(const float* row, int n_valid, LAS unsigned* hist  , LAS unsigned* mwords  , unsigned* mout, int q32, unsigned* list, int lane) {
    constexpr int NJ = MODE == 0 ? 8 : 9;
    const int L = (n_valid + 255) >> 8;
    unsigned key[NJ][4];
#pragma unroll
    for (int j = 0; j < NJ; ++j) {
        f32x4 v = {0.f, 0.f, 0.f, 0.f};
        if (j < L) v = *(const f32x4*)(row + 256 * j + 4 * lane);
#pragma unroll
        for (int i = 0; i < 4; ++i) { const int kv = 256 * j + 4 * lane + i; key[j][i] = (j < L && kv < n_valid) ? fkey(v[i]) : 0u; }
    }
    unsigned T = 0u, need = 256u; bool all = (n_valid <= 256);
    if (!all) {
#pragma unroll 1
        for (int lvl = 3; lvl >= 0; --lvl) {
            const int sh = 8 * lvl;
            hist[lane] = 0u; hist[64 + lane] = 0u; hist[128 + lane] = 0u; hist[192 + lane] = 0u;
            LDS_WAIT();
            const unsigned pmask = lvl == 3 ? 0u : (0xffffffffu << (sh + 8));
#pragma unroll
            for (int j = 0; j < NJ; ++j) if (j < L) {
#pragma unroll
                for (int i = 0; i < 4; ++i) { const unsigned k = key[j][i]; if (k != 0u && ((k ^ T) & pmask) == 0u) __hip_atomic_fetch_add(&hist[(k >> sh) & 255u], 1u, __ATOMIC_RELAXED, __HIP_MEMORY_SCOPE_WORKGROUP); } }
            LDS_WAIT();
            const unsigned c0 = hist[4 * lane], c1 = hist[4 * lane + 1], c2 = hist[4 * lane + 2], c3 = hist[4 * lane + 3];
            const unsigned tl = c0 + c1 + c2 + c3, incl = wave_incl_scan(tl, lane), tot = lane63(incl);
            unsigned run = tot - incl;
            int fb = -1; unsigned fab = 0u;
            if (run < need && need <= run + c3) { fb = 4 * lane + 3; fab = run; } run += c3;
            if (fb < 0 && run < need && need <= run + c2) { fb = 4 * lane + 2; fab = run; } run += c2;
            if (fb < 0 && run < need && need <= run + c1) { fb = 4 * lane + 1; fab = run; } run += c1;
            if (fb < 0 && run < need && need <= run + c0) { fb = 4 * lane + 0; fab = run; }
            const unsigned long long bal = __ballot(fb >= 0);
            const int src = bal ? (int)__builtin_ctzll(bal) : 0;
            const int bsel = __builtin_amdgcn_readlane(fb, src); const unsigned above = (unsigned)__builtin_amdgcn_readlane((int)fab, src);
            T |= ((unsigned)(bsel < 0 ? 0 : bsel)) << sh; need -= above;
            LDS_WAIT();
        }
    }
    unsigned eqtot = 0u;
    if (!all) { unsigned c = 0u;
#pragma unroll
        for (int j = 0; j < NJ; ++j)
#pragma unroll
            for (int i = 0; i < 4; ++i) c += (key[j][i] == T) ? 1u : 0u;
        eqtot = lane63(wave_incl_scan(c, lane)); }
    const bool ties = !all && eqtot != need;
    unsigned nib[NJ]; unsigned ebase = 0u;
#pragma unroll
    for (int j = 0; j < NJ; ++j) {
        unsigned nb = 0u;
        if (all) {
#pragma unroll
            for (int i = 0; i < 4; ++i) nb |= (key[j][i] != 0u) ? (1u << i) : 0u;
        } else if (!ties) {
#pragma unroll
            for (int i = 0; i < 4; ++i) nb |= (key[j][i] >= T && key[j][i] != 0u) ? (1u << i) : 0u;
        } else {
            unsigned cnt = 0u;
#pragma unroll
            for (int i = 0; i < 4; ++i) cnt += (key[j][i] == T) ? 1u : 0u;
            const unsigned incl = wave_incl_scan(cnt, lane); unsigned run = ebase + incl - cnt; ebase += lane63(incl);
#pragma unroll
            for (int i = 0; i < 4; ++i) { const bool e = key[j][i] == T; if (key[j][i] > T || (e && run < need)) nb |= 1u << i; run += e ? 1u : 0u; }
        }
        nib[j] = nb;
    }
    if (MODE == 0) {
        mwords[lane] = 0u; LDS_WAIT();
#pragma unroll
        for (int j = 0; j < 8; ++j) if (nib[j]) __hip_atomic_fetch_or(&mwords[(lane & 1) * 32 + 4 * j + (lane >> 4)], nib[j] << (4 * ((lane & 15) >> 1)), __ATOMIC_RELAXED, __HIP_MEMORY_SCOPE_WORKGROUP);
        LDS_WAIT();
        const unsigned wv = mwords[lane];
        mout[((lane & 31) * 2 + (lane >> 5)) * 32 + q32] = wv;
        LDS_WAIT();
    } else {
        unsigned base = 0u;
#pragma unroll
        for (int j = 0; j < NJ; ++j) { const unsigned cnt = __builtin_popcount(nib[j]); const unsigned incl = wave_incl_scan(cnt, lane); unsigned pos = base + incl - cnt; base += lane63(incl);
#pragma unroll
            for (int i = 0; i < 4; ++i) if ((nib[j] >> i) & 1u) { if (pos < 256u) list[pos] = (unsigned)(256 * j + 4 * lane + i); ++pos; } }
    }
}
__device__ __forceinline__ float dpp_sum8(float v) {
    v += __uint_as_float(__builtin_amdgcn_update_dpp(0u, __float_as_uint(v), 0xB1, 0xf, 0xf, true));
    v += __uint_as_float(__builtin_amdgcn_update_dpp(0u, __float_as_uint(v), 0x4E, 0xf, 0xf, true));
    v += __uint_as_float(__builtin_amdgcn_update_dpp(0u, __float_as_uint(v), 0x141, 0xf, 0xf, true));
    return v;
}
__device__ __forceinline__ float dpp_sum16(float v) {
    v = dpp_sum8(v);
    v += __uint_as_float(__builtin_amdgcn_update_dpp(0u, __float_as_uint(v), 0x140, 0xf, 0xf, true));
    return v;
}
__device__ __forceinline__ float dpp_max16(float v) {
    v = fmaxf(v, __uint_as_float(__builtin_amdgcn_update_dpp(0u, __float_as_uint(v), 0xB1, 0xf, 0xf, true)));
    v = fmaxf(v, __uint_as_float(__builtin_amdgcn_update_dpp(0u, __float_as_uint(v), 0x4E, 0xf, 0xf, true)));
    v = fmaxf(v, __uint_as_float(__builtin_amdgcn_update_dpp(0u, __float_as_uint(v), 0x141, 0xf, 0xf, true)));
    v = fmaxf(v, __uint_as_float(__builtin_amdgcn_update_dpp(0u, __float_as_uint(v), 0x140, 0xf, 0xf, true)));
    return v;
}
constexpr float IDX_SCALE = 0.125f * 0.35355339059327373f;
constexpr int QIL_PITCH = 1040;
__device__ __forceinline__ void idx_unit_prompt(Frame& F, int b, int qb) {
    const int lane = F.lane, w = F.wave, r32 = lane & 31, hi = lane >> 5;
    const int R0 = b * 2048 + 32 * qb;
    const bf16* QI = WSP(bf16, WS_QI); const bf16* KI = WSP(bf16, WS_KI); float* SC = WSP(float, WS_SCP);
    LAS unsigned char* qil = F.lds;
    LAS unsigned* hist = (LAS unsigned*)(F.lds + 40960) + w * 256;
    LAS unsigned* mw = (LAS unsigned*)(F.lds + 49152) + w * 64;
    { const int row = F.tid >> 4, ch = F.tid & 15; const v4u* src = (const v4u*)(QI + (size_t)(R0 + row) * 512) + ch * 4;
#pragma unroll
      for (int i = 0; i < 4; ++i) *(LAS v4u*)(qil + row * QIL_PITCH + (ch * 4 + i) * 16) = src[i]; }
    float wq[8];
    { const f32x4 a = *(const f32x4*)(WSP(float, WS_WI) + (size_t)(R0 + r32) * 8), c = *(const f32x4*)(WSP(float, WS_WI) + (size_t)(R0 + r32) * 8 + 4);
#pragma unroll
      for (int h = 0; h < 4; ++h) { wq[h] = a[h] * IDX_SCALE; wq[4 + h] = c[h] * IDX_SCALE; } }
    __syncthreads();
    bf16x8 af[4], afn[4];
    if (w <= qb) {
#pragma unroll
        for (int ks = 0; ks < 4; ++ks) af[ks] = *(const bf16x8*)(KI + (size_t)(b * 2048 + 32 * w + r32) * 64 + 16 * ks + 8 * hi);
    }
    for (int kb = w; kb <= qb; kb += 8) {
        if (kb + 8 <= qb) {
#pragma unroll
            for (int ks = 0; ks < 4; ++ks) afn[ks] = *(const bf16x8*)(KI + (size_t)(b * 2048 + 32 * (kb + 8) + r32) * 64 + 16 * ks + 8 * hi);
        }
        f32x16 sc = {};
#pragma unroll 1
        for (int h = 0; h < 8; ++h) {
            f32x16 acc = {}; const float wqh = wq[h];
#pragma unroll
            for (int ks = 0; ks < 4; ++ks) { const bf16x8 bfr = *(const LAS bf16x8*)(qil + r32 * QIL_PITCH + h * 128 + ks * 32 + hi * 16); acc = MFMA32(af[ks], bfr, acc); }
#pragma unroll
            for (int r = 0; r < 16; ++r) sc[r] += fmaxf(acc[r], 0.f) * wqh;
        }
#pragma unroll
        for (int k4 = 0; k4 < 4; ++k4) *(f32x4*)(SC + (size_t)(R0 + r32) * 2048 + 32 * kb + 8 * k4 + 4 * hi) = (f32x4){sc[4 * k4], sc[4 * k4 + 1], sc[4 * k4 + 2], sc[4 * k4 + 3]};
#pragma unroll
        for (int ks = 0; ks < 4; ++ks) af[ks] = afn[ks];
    }
    VM_WAIT(); __syncthreads();
    unsigned* mout = WSP(unsigned, WS_MASK) + (size_t)(b * 64 + qb) * 2048;
    for (int qq = w; qq < 32; qq += 8) select_query<0>(SC + (size_t)(R0 + qq) * 2048, 32 * qb + qq + 1, hist, mw, mout, qq, nullptr, lane);
    __syncthreads();
}
__device__ __forceinline__ void idx_unit_sample(Frame& F, int b) {
    const int lane = F.lane, w = F.wave, r32 = lane & 31, hi = lane >> 5, t = r32 >> 3, h = r32 & 7;
    const bf16* QI = WSP(bf16, WS_QI); const bf16* KI = WSP(bf16, WS_KI); float* SC = WSP(float, WS_SCS);
    LAS unsigned* hist = (LAS unsigned*)(F.lds + 40960) + w * 256;
    const int* PTB = (const int*)F.in[8] + b * 16;
    bf16x8 bfr[4];
#pragma unroll
    for (int ks = 0; ks < 4; ++ks) bfr[ks] = *(const bf16x8*)(QI + (size_t)(MP + 4 * b + t) * 512 + h * 64 + 16 * ks + 8 * hi);
    const float wq = WSP(float, WS_WI)[(size_t)(MP + 4 * b + t) * 8 + h] * IDX_SCALE;
    for (int kb = w; kb < 65; kb += 8) {
        bf16x8 af[4];
        if (kb < 64) {
            const int kv = 32 * kb + r32, page = PTB[kv >> 7];
            const float* src = INF(4) + ((size_t)page * 128 + (kv & 127)) * 64 + 8 * hi;
#pragma unroll
            for (int ks = 0; ks < 4; ++ks) { const f32x4 a = *(const f32x4*)(src + 16 * ks), c = *(const f32x4*)(src + 16 * ks + 4); const v4u pk = pack8(a, c); af[ks] = __builtin_bit_cast(bf16x8, pk); }
        } else {
#pragma unroll
            for (int ks = 0; ks < 4; ++ks) { v4u z = {0u, 0u, 0u, 0u}; if (r32 < 4) z = *(const v4u*)(KI + (size_t)(MP + 4 * b + r32) * 64 + 16 * ks + 8 * hi); af[ks] = __builtin_bit_cast(bf16x8, z); }
        }
        f32x16 acc = {};
#pragma unroll
        for (int ks = 0; ks < 4; ++ks) acc = MFMA32(af[ks], bfr[ks], acc);
        float v[16];
#pragma unroll
        for (int r = 0; r < 16; ++r) v[r] = dpp_sum8(fmaxf(acc[r], 0.f) * wq);
        f32x4 o = {v[0], v[1], v[2], v[3]};
        if (h == 1) o = (f32x4){v[4], v[5], v[6], v[7]}; else if (h == 2) o = (f32x4){v[8], v[9], v[10], v[11]}; else if (h == 3) o = (f32x4){v[12], v[13], v[14], v[15]};
        if (h < 4) *(f32x4*)(SC + (size_t)(4 * b + t) * SCS_PITCH + 32 * kb + 8 * h + 4 * hi) = o;
    }
    VM_WAIT(); __syncthreads();
    if (w < 4) select_query<1>(SC + (size_t)(4 * b + w) * SCS_PITCH, 2049 + w, hist, nullptr, nullptr, 0, WSP(unsigned, WS_LIST) + (size_t)(4 * b + w) * 256, lane);
    __syncthreads();
}

__device__ __forceinline__ void sattn_unit(Frame& F, int b, int t) {
    const int lane = F.lane, w = F.wave, n = lane >> 4, d4 = lane & 15;
    const int rs = 4 * b + t, row = MP + rs;
    const bf16* Q = WSP(bf16, WS_Q);
    LAS float* xm = (LAS float*)(F.lds);
    LAS float* xs = (LAS float*)(F.lds + 512);
    LAS float* pl = (LAS float*)(F.lds + 1024) + w * 512;
    LAS float* ored = (LAS float*)(F.lds + 1024 + 16384);
    float qv[4][4];
#pragma unroll
    for (int j = 0; j < 4; ++j) { const v2u qw = *(const v2u*)(Q + (size_t)row * 1024 + (4 * n + j) * 64 + 4 * d4); qv[j][0] = bflo(qw.x); qv[j][1] = bfhi(qw.x); qv[j][2] = bflo(qw.y); qv[j][3] = bfhi(qw.y); }
    const unsigned kvl = WSP(unsigned, WS_LIST)[(size_t)rs * 256 + 32 * w + (lane & 31)];
    const int page = ((const int*)F.in[8])[b * 16 + ((kvl < 2048u ? kvl : 0u) >> 7)];
    const unsigned long long coff = ((unsigned long long)page * 128ull + (kvl & 127u)) * 256ull;
    const unsigned long long noff = (unsigned long long)(4 * b + (int)(kvl < 2048u ? 0u : kvl - 2048u)) * 256ull;
    const bool isnew = kvl >= 2048u;
    float sv[4][2];
#pragma unroll
    for (int j = 0; j < 4; ++j) { sv[j][0] = 0.f; sv[j][1] = 0.f; }
#pragma unroll 1
    for (int half = 0; half < 2; ++half) {
        f32x4 kvec[16];
#pragma unroll
        for (int k = 0; k < 16; ++k) { const int e = 16 * half + k; const bool nw = __shfl((int)isnew, e) != 0; const unsigned long long o = nw ? __shfl(noff, e) : __shfl(coff, e);
            const float* base = nw ? (F.out + O_KS) : INF(2); kvec[k] = *(const f32x4*)(base + o + 4 * lane); }
#pragma unroll
        for (int k = 0; k < 16; ++k)
#pragma unroll
            for (int j = 0; j < 4; ++j) { float p = qv[j][0] * kvec[k][0] + qv[j][1] * kvec[k][1] + qv[j][2] * kvec[k][2] + qv[j][3] * kvec[k][3]; p = dpp_sum16(p); if (d4 == k) { if (half == 0) sv[j][0] = p; else sv[j][1] = p; } }
    }
    float mj[4], sj[4];
#pragma unroll
    for (int j = 0; j < 4; ++j) { mj[j] = dpp_max16(fmaxf(sv[j][0], sv[j][1])); if (d4 == 0) xm[w * 16 + 4 * n + j] = mj[j]; }
    __syncthreads();
#pragma unroll
    for (int j = 0; j < 4; ++j) { float m = xm[4 * n + j];
#pragma unroll
        for (int ww = 1; ww < 8; ++ww) m = fmaxf(m, xm[ww * 16 + 4 * n + j]);
        const float p0 = __builtin_amdgcn_exp2f(sv[j][0] - m), p1 = __builtin_amdgcn_exp2f(sv[j][1] - m);
        pl[d4 * 16 + 4 * n + j] = p0; pl[(16 + d4) * 16 + 4 * n + j] = p1;
        sj[j] = dpp_sum16(p0 + p1); if (d4 == 0) xs[w * 16 + 4 * n + j] = sj[j]; }
    LDS_WAIT();
    float o[4][4] = {};
#pragma unroll 1
    for (int half = 0; half < 2; ++half) {
        f32x4 vvec[16];
#pragma unroll
        for (int k = 0; k < 16; ++k) { const int e = 16 * half + k; const bool nw = __shfl((int)isnew, e) != 0; const unsigned long long of = nw ? __shfl(noff, e) : __shfl(coff, e);
            const float* base = nw ? (F.out + O_VS) : INF(3); vvec[k] = *(const f32x4*)(base + of + 4 * lane); }
#pragma unroll
        for (int k = 0; k < 16; ++k) { const f32x4 pj = *(const LAS f32x4*)(pl + (16 * half + k) * 16 + 4 * n);
#pragma unroll
            for (int j = 0; j < 4; ++j)
#pragma unroll
                for (int c = 0; c < 4; ++c) o[j][c] += pj[j] * vvec[k][c]; }
    }
#pragma unroll
    for (int j = 0; j < 4; ++j)
#pragma unroll
        for (int c = 0; c < 4; ++c) ored[(w * 16 + j * 4 + c) * 64 + lane] = o[j][c];
    __syncthreads();
    {
        const int part = w, j = part >> 1, c0 = 2 * (part & 1);
        float tot = 0.f;
#pragma unroll
        for (int ww = 0; ww < 8; ++ww) tot += xs[ww * 16 + 4 * n + j];
        float a0 = 0.f, a1 = 0.f;
#pragma unroll
        for (int ww = 0; ww < 8; ++ww) { a0 += ored[(ww * 16 + j * 4 + c0) * 64 + lane]; a1 += ored[(ww * 16 + j * 4 + c0 + 1) * 64 + lane]; }
        const float inv = 1.0f / tot;
        *(unsigned*)(WSP(bf16, WS_O) + (size_t)row * 1024 + (4 * n + j) * 64 + 4 * d4 + c0) = pk2(a0 * inv, a1 * inv);
    }
    __syncthreads();
}

__device__ __forceinline__ void p7_convgate(Frame& F) {
    const int gw = F.vcu * 8 + F.wave, NGW = F.G * 8;
    const bf16* UP = WSP(bf16, WS_UP); bf16* ACT = WSP(bf16, WS_ACT);
    const float* cw = INF(24); const float* cb = INF(25); const float* cst = INF(7);
    for (int it = gw; it < (MROWS / 16) * 11; it += NGW) {
        const int rb = it / 11, cg = it % 11, c = cg * 512 + F.lane * 8;
        const size_t ucol = (size_t)(c >> 7) * 256 + (c & 127);
        float wg[3][8], wv[3][8], bg[8], bv[8];
#pragma unroll
        for (int j = 0; j < 3; ++j) { const f32x4 a0 = *(const f32x4*)(cw + (size_t)j * DFF2 + c), a1 = *(const f32x4*)(cw + (size_t)j * DFF2 + c + 4), b0 = *(const f32x4*)(cw + (size_t)j * DFF2 + DFF + c), b1 = *(const f32x4*)(cw + (size_t)j * DFF2 + DFF + c + 4);
#pragma unroll
            for (int e = 0; e < 4; ++e) { wg[j][e] = a0[e]; wg[j][4 + e] = a1[e]; wv[j][e] = b0[e]; wv[j][4 + e] = b1[e]; } }
        { const f32x4 a0 = *(const f32x4*)(cb + c), a1 = *(const f32x4*)(cb + c + 4), b0 = *(const f32x4*)(cb + DFF + c), b1 = *(const f32x4*)(cb + DFF + c + 4);
#pragma unroll
          for (int e = 0; e < 4; ++e) { bg[e] = a0[e]; bg[4 + e] = a1[e]; bv[e] = b0[e]; bv[4 + e] = b1[e]; } }
        const int r0 = rb * 16;
        v4u cg_[4], cv_[4], ng_[4], nv_[4];
#pragma unroll
        for (int k = 0; k < 4; ++k) { cg_[k] = *(const v4u*)(UP + (size_t)(r0 + k) * DFF2 + ucol); cv_[k] = *(const v4u*)(UP + (size_t)(r0 + k) * DFF2 + ucol + 128); }
        f32x4 g2[2], g1[2], v2[2], v1[2];
        if (r0 < MP && (r0 & 2047) != 0) { const v4u a = *(const v4u*)(UP + (size_t)(r0 - 2) * DFF2 + ucol), b = *(const v4u*)(UP + (size_t)(r0 - 2) * DFF2 + ucol + 128), a1 = *(const v4u*)(UP + (size_t)(r0 - 1) * DFF2 + ucol), b1 = *(const v4u*)(UP + (size_t)(r0 - 1) * DFF2 + ucol + 128);
            unpack8(a, g2[0], g2[1]); unpack8(b, v2[0], v2[1]); unpack8(a1, g1[0], g1[1]); unpack8(b1, v1[0], v1[1]); }
        else { g2[0] = g2[1] = g1[0] = g1[1] = v2[0] = v2[1] = v1[0] = v1[1] = (f32x4){0.f, 0.f, 0.f, 0.f}; }
#pragma unroll 1
        for (int gq = 0; gq < 4; ++gq) {
            const int rg = r0 + 4 * gq;
            if (gq < 3) {
#pragma unroll
                for (int k = 0; k < 4; ++k) { ng_[k] = *(const v4u*)(UP + (size_t)(rg + 4 + k) * DFF2 + ucol); nv_[k] = *(const v4u*)(UP + (size_t)(rg + 4 + k) * DFF2 + ucol + 128); }
            }
            if (rg >= MP) {
                const float* s0 = cst + (size_t)((rg - MP) >> 2) * 2 * DFF2; const float* s1 = s0 + DFF2;
                g2[0] = *(const f32x4*)(s0 + c); g2[1] = *(const f32x4*)(s0 + c + 4); v2[0] = *(const f32x4*)(s0 + DFF + c); v2[1] = *(const f32x4*)(s0 + DFF + c + 4);
                g1[0] = *(const f32x4*)(s1 + c); g1[1] = *(const f32x4*)(s1 + c + 4); v1[0] = *(const f32x4*)(s1 + DFF + c); v1[1] = *(const f32x4*)(s1 + DFF + c + 4);
            }
#pragma unroll
            for (int k = 0; k < 4; ++k) {
                f32x4 g0[2], v0[2]; unpack8(cg_[k], g0[0], g0[1]); unpack8(cv_[k], v0[0], v0[1]);
                float o[8];
#pragma unroll
                for (int e = 0; e < 8; ++e) { const int hh = e >> 2, ee = e & 3;
                    const float gm = bg[e] + wg[0][e] * g2[hh][ee] + wg[1][e] * g1[hh][ee] + wg[2][e] * g0[hh][ee];
                    const float vm = bv[e] + wv[0][e] * v2[hh][ee] + wv[1][e] * v1[hh][ee] + wv[2][e] * v0[hh][ee];
                    o[e] = gm * sigmoidf_(gm) * vm; }
                v4u ow; ow.x = pk2(o[0], o[1]); ow.y = pk2(o[2], o[3]); ow.z = pk2(o[4], o[5]); ow.w = pk2(o[6], o[7]);
                *(v4u*)(ACT + (size_t)(rg + k) * DFF + c) = ow;
                g2[0] = g1[0]; g2[1] = g1[1]; v2[0] = v1[0]; v2[1] = v1[1]; g1[0] = g0[0]; g1[1] = g0[1]; v1[0] = v0[0]; v1[1] = v0[1];
            }
#pragma unroll
            for (int k = 0; k < 4; ++k) { cg_[k] = ng_[k]; cv_[k] = nv_[k]; }
        }
    }
}
__device__ __forceinline__ void p9_final(Frame& F) {
    const int gw = F.vcu * 8 + F.wave, NGW = F.G * 8;
    const float* gf = INF(27);
    for (int m = gw; m < MROWS; m += NGW) {
        GAS f32x4* yr = (GAS f32x4*)(F.out + (size_t)m * 2048) + F.lane; const f32x4* gr = (const f32x4*)gf + F.lane;
        f32x4 v[8]; float s = 0.f;
#pragma unroll
        for (int j = 0; j < 8; ++j) { v[j] = yr[64 * j]; s += (v[j][0] * v[j][0] + v[j][1] * v[j][1]) + (v[j][2] * v[j][2] + v[j][3] * v[j][3]); }
        const float rs = 1.0f / sqrtf(wave_sum(s) * (1.0f / 2048.0f) + EPS_);
#pragma unroll
        for (int j = 0; j < 8; ++j) yr[64 * j] = v[j] * rs * gr[64 * j];
    }
}

#define MFMA16(a, b, c) __builtin_amdgcn_mfma_f32_16x16x32_bf16((a), (b), (c), 0, 0, 0)
constexpr int SG_PITCH = 68;
template <int KW, int NSTG = 4> __device__ __forceinline__ void sg64(LAS float* red, const bf16* A, int lda, const bf16* B, int ldb, int wave, int lane, float (&out)[8]) {
    constexpr int NST = KW < NSTG ? KW : NSTG;
    const int fr = lane & 15, fq = lane >> 4;
    const bf16* ap = A + (size_t)fr * lda + wave * (KW * 32) + 8 * fq;
    const bf16* bp = B + (size_t)fr * ldb + wave * (KW * 32) + 8 * fq;
    f32x4 acc[4][4];
#pragma unroll
    for (int i = 0; i < 4; ++i)
#pragma unroll
        for (int j = 0; j < 4; ++j) acc[i][j] = (f32x4){0.f, 0.f, 0.f, 0.f};
    bf16x8 fa[NST][4], fb[NST][4];
#pragma unroll
    for (int st = 0; st < NST; ++st)
#pragma unroll
        for (int i = 0; i < 4; ++i) { fa[st][i] = *(const bf16x8*)(ap + (size_t)(16 * i) * lda + st * 32); fb[st][i] = *(const bf16x8*)(bp + (size_t)(16 * i) * ldb + st * 32); }
#pragma unroll
    for (int ks = 0; ks < KW; ++ks) {
        const int st = ks % NST;
#pragma unroll
        for (int i = 0; i < 4; ++i)
#pragma unroll
            for (int j = 0; j < 4; ++j) acc[i][j] = MFMA16(fb[st][j], fa[st][i], acc[i][j]);
        if (ks + NST < KW) {
#pragma unroll
            for (int i = 0; i < 4; ++i) { fa[st][i] = *(const bf16x8*)(ap + (size_t)(16 * i) * lda + (ks + NST) * 32); fb[st][i] = *(const bf16x8*)(bp + (size_t)(16 * i) * ldb + (ks + NST) * 32); }
        }
        __builtin_amdgcn_sched_barrier(0);
    }
#pragma unroll
    for (int i = 0; i < 4; ++i)
#pragma unroll
        for (int j = 0; j < 4; ++j) *(LAS f32x4*)(red + (size_t)(wave * 64 + 16 * i + fr) * SG_PITCH + 16 * j + 4 * fq) = acc[i][j];
    LDS_WAIT(); __syncthreads();
    const int row = 8 * wave + (lane >> 3), c0 = 8 * (lane & 7);
    f32x4 s0 = {0.f, 0.f, 0.f, 0.f}, s1 = {0.f, 0.f, 0.f, 0.f};
#pragma unroll
    for (int w = 0; w < 8; ++w) { s0 += *(const LAS f32x4*)(red + (size_t)(w * 64 + row) * SG_PITCH + c0); s1 += *(const LAS f32x4*)(red + (size_t)(w * 64 + row) * SG_PITCH + c0 + 4); }
    out[0] = s0[0]; out[1] = s0[1]; out[2] = s0[2]; out[3] = s0[3]; out[4] = s1[0]; out[5] = s1[1]; out[6] = s1[2]; out[7] = s1[3];
    LDS_WAIT(); __syncthreads();
}
__device__ __forceinline__ void p4_sample(Frame& F, int c) {
    LAS float* red = (LAS float*)F.lds;
    const int m0 = MP + 64 * (c >> 5), n0 = 64 * (c & 31);
    const bf16* WG = WSP(bf16, WS_WG) + (size_t)(256 * (n0 >> 7) + (n0 & 127)) * 1024;
    const int r = m0 + 8 * F.wave + (F.lane >> 3), col = n0 + 8 * (F.lane & 7); const size_t off = (size_t)r * 2048 + col;
    float t[8];
#pragma unroll
    for (int e = 0; e < 8; ++e) t[e] = 0.f;
#pragma unroll 1
    for (int q = 0; q < 3; ++q) {
        const bf16* Ap = (q == 2 ? WSP(bf16, WS_O) : WSP(bf16, WS_Z)) + (size_t)m0 * 1024;
        const bf16* Bp = q == 0 ? WG + (size_t)128 * 1024 : (q == 1 ? WG : WSP(bf16, WS_WP) + (size_t)n0 * 1024);
        float v[8];
        sg64<4, 2>(red, Ap, 1024, Bp, 1024, F.wave, F.lane, v);
        if (q == 0) {
#pragma unroll
            for (int e = 0; e < 8; ++e) t[e] = sigmoidf_(v[e]);
        } else {
            f32x4 s0, s1; unpack8(*(const v4u*)((q == 1 ? WSP(bf16, WS_SGB) : WSP(bf16, WS_SGA)) + off), s0, s1);
#pragma unroll
            for (int e = 0; e < 8; ++e) { const float sc = e < 4 ? s0[e & 3] : s1[e & 3]; t[e] = (q == 1) ? t[e] * v[e] * sc : t[e] + v[e] * sc; }
        }
    }
    v4u w; w.x = pk2(t[0], t[1]); w.y = pk2(t[2], t[3]); w.z = pk2(t[4], t[5]); w.w = pk2(t[6], t[7]);
    *(v4u*)(WSP(bf16, WS_MRG) + off) = w;
}
__device__ __forceinline__ void p5_sample(Frame& F, int c) {
    LAS float* red = (LAS float*)F.lds;
    const int m0 = MP + 64 * (c >> 5), n0 = 64 * (c & 31);
    float a[8];
    sg64<8>(red, WSP(bf16, WS_MRG) + (size_t)m0 * 2048, 2048, WSP(bf16, WS_WO) + (size_t)n0 * 2048, 2048, F.wave, F.lane, a);
    const int r = m0 + 8 * F.wave + (F.lane >> 3), col = n0 + 8 * (F.lane & 7);
    const float* xr = INF(1) + (size_t)(r - MP) * 2048 + col; float* yr = F.out + (size_t)r * 2048 + col;
    const f32x4 x0 = *(const f32x4*)xr, x1 = *(const f32x4*)(xr + 4);
    const f32x4 v0 = x0 + (f32x4){a[0], a[1], a[2], a[3]}, v1 = x1 + (f32x4){a[4], a[5], a[6], a[7]};
    *(f32x4*)yr = v0; *(f32x4*)(yr + 4) = v1; *(v4u*)(WSP(bf16, WS_XB) + (size_t)r * 2048 + col) = pack8(v0, v1);
    float ss = (v0[0] * v0[0] + v0[1] * v0[1]) + (v0[2] * v0[2] + v0[3] * v0[3]) + (v1[0] * v1[0] + v1[1] * v1[1]) + (v1[2] * v1[2] + v1[3] * v1[3]);
    ss = dpp_sum8(ss);
    if ((F.lane & 7) == 0) WSP(float, WS_SS1)[(size_t)r * 32 + (c & 31)] = ss;
}
__device__ __forceinline__ void p8_sample(Frame& F, int c) {
    LAS float* red = (LAS float*)F.lds;
    const int m0 = MP + 64 * (c >> 5), n0 = 64 * (c & 31);
    float a[8];
    sg64<22>(red, WSP(bf16, WS_ACT) + (size_t)m0 * DFF, DFF, WSP(bf16, WS_WDN) + (size_t)n0 * DFF, DFF, F.wave, F.lane, a);
    const int r = m0 + 8 * F.wave + (F.lane >> 3), col = n0 + 8 * (F.lane & 7);
    float* yr = F.out + (size_t)r * 2048 + col;
    *(f32x4*)yr = *(const f32x4*)yr + (f32x4){a[0], a[1], a[2], a[3]}; *(f32x4*)(yr + 4) = *(const f32x4*)(yr + 4) + (f32x4){a[4], a[5], a[6], a[7]};
}

constexpr int NPHASE = 10;
__global__ void __launch_bounds__(512, 2) hybrid_fwd(Args args) {
    extern __shared__ __attribute__((aligned(16))) unsigned char lds[];
    Frame F;
    F.lds = (LAS unsigned char*)lds;
    F.MISC = (volatile LAS unsigned*)(F.lds + MISC_OFF);
    F.tid = threadIdx.x; F.lane = F.tid & 63; F.wave = __builtin_amdgcn_readfirstlane(F.tid >> 6);
    F.G = gridDim.x; { const int bx = blockIdx.x; F.vcu = (F.G % 8 == 0) ? (bx % 8) * (F.G / 8) + bx / 8 : bx; }
    F.in = args.in; F.out = args.out; F.ws = args.ws; F.ctl = (gu32*)(args.ws + WS_CTL);
    for (int u = F.tid; u < 128; u += 512) ((LAS unsigned*)(F.lds + MISC_OFF))[u] = 0u;
    __syncthreads();
    const int lo = args.ph_lo, hi = args.ph_hi;
    const bool multi = (hi - lo) > 1;
    XcdBarrier bar; bar.bar = (unsigned*)(F.ctl + CW_BAR) + args.li * XCD_BAR_WORDS; bar.x = 0; bar.st = nullptr;
    if (multi) bar = xcd_barrier_post((unsigned*)(F.ctl + CW_BAR) + args.li * XCD_BAR_WORDS, F.MISC + 8);
#ifndef PH_MASK
#define PH_MASK 0x3ff
#endif
#define IN(k) (((PH_MASK >> (k)) & 1) && lo <= (k) && (k) < hi)
#define SEAM(k) do { if (IN(k) && IN((k) + 1)) xcd_barrier(bar); } while (0)
    const int c = (int)blockIdx.x;

    if (IN(0)) { p0_prologue(F); SEAM(0); }

    if (IN(1)) {
        pg8::Gemm g{WSP(bf16, WS_XB), WSP(bf16, WS_WIN), 2048, 2048, 2048}; pg8::StaticOrder S; S.init(MROWS, NIN, F.G, c);
        EpiIn E{WSP(bf16, WS_Q), WSP(bf16, WS_KB), WSP(bf16, WS_VB), WSP(bf16, WS_QI), WSP(bf16, WS_KI), WSP(bf16, WS_U), WSP(bf16, WS_SGA), WSP(bf16, WS_SGB), WSP(float, WS_WI), WSP(float, WS_RS0), F.out};
        pg8::gemm_phase<EpiIn, pg8::StaticOrder, true, true>(F.lds + RING_OFF, g, S, E);
        SEAM(1);
    }

    if (IN(2)) {
#ifndef P2_MASK
#define P2_MASK 7
#endif
        const int qb0 = args.qoff;
        if ((P2_MASK & 1) && !(args.flags & 4)) for (;;) { const int u = queue_pop(F, qb0 + 0); if (u >= 128) break; s5_unit(F, u & 1, u >> 1); }
        if ((P2_MASK & 2) && !(args.flags & 8)) for (;;) { const int u = queue_pop(F, qb0 + 1); if (u >= 256) break; idx_unit_prompt(F, u & 3, 63 - (u >> 2)); }
        if ((P2_MASK & 4) && !(args.flags & 16)) for (;;) { const int u = queue_pop(F, qb0 + 2); if (u >= 128) break; idx_unit_sample(F, u); }
        SEAM(2);
    }

    if (IN(3)) {
        {
        const attn_body::bf16* Qp = (const attn_body::bf16*)WSP(bf16, WS_Q);
        const int bh = F.vcu >> 2, s = F.vcu & 3;
#ifndef P3_MASK
#define P3_MASK 3
#endif
        if (F.G == 256 && (P3_MASK & 1)) {
            if (c & 1) { sattn_unit(F, c >> 2, c & 3); }
            for (int i = 0; i < 2; ++i)
                attn_body::attn_unit<8>(bh >> 4, bh & 15, i == 0 ? 7 - s : s, Qp, (const attn_body::bf16*)WSP(bf16, WS_KB), (const attn_body::bf16*)WSP(bf16, WS_VB), (attn_body::bf16*)WSP(bf16, WS_O),
                                        WSP(unsigned, WS_MASK), (char*)lds + RING_OFF, (char*)lds + AMASK_OFF);
        }
        if (P3_MASK & 2) for (int v = c; v < 512; v += F.G) { if (F.G == 256 && (c & 1) && v == c) continue; sattn_unit(F, v >> 2, v & 3); }
        }
        SEAM(3);
    }

    if (IN(4)) {
        if (!(args.flags & 1)) {
        { pg8::Gemm g{WSP(bf16, WS_Z), WSP(bf16, WS_WG), 1024, 1024, 1024}; OrderGlu S{c}; EpiGlu E{WSP(bf16, WS_SGB), WSP(bf16, WS_MRG)};
          pg8::gemm_phase<EpiGlu, OrderGlu, true, true>(F.lds + RING_OFF, g, S, E); }
        { pg8::Gemm g{WSP(bf16, WS_O), WSP(bf16, WS_WP), 1024, 1024, 1024}; OrderProj S{c}; EpiProj E{WSP(bf16, WS_SGA), WSP(bf16, WS_MRG)};
          pg8::gemm_phase<EpiProj, OrderProj, true, true>(F.lds + RING_OFF, g, S, E); }
        }
        if (!(args.flags & 2)) p4_sample(F, c);
        SEAM(4);
    }

    if (IN(5)) {
        pg8::Gemm g{WSP(bf16, WS_MRG), WSP(bf16, WS_WO), 2048, 2048, 2048}; pg8::StaticOrder S; S.init(MP, 2048, F.G, c);
        EpiOut E{INF(0), INF(1), F.out, WSP(bf16, WS_XB), WSP(float, WS_SS1)};
        if (!(args.flags & 1)) pg8::gemm_phase<EpiOut, pg8::StaticOrder, true, true>(F.lds + RING_OFF, g, S, E);
        if (!(args.flags & 2)) p5_sample(F, c);
        SEAM(5);
    }

    if (IN(6)) {
        pg8::Gemm g{WSP(bf16, WS_XB), WSP(bf16, WS_WUP), 2048, 2048, 2048}; pg8::StaticOrder S; S.init(MROWS, DFF2, F.G, c);
        EpiUp E{WSP(float, WS_SS1), WSP(bf16, WS_UP), F.out};
        pg8::gemm_phase<EpiUp, pg8::StaticOrder, true, true>(F.lds + RING_OFF, g, S, E);
        SEAM(6);
    }

    if (IN(7)) { p7_convgate(F); SEAM(7); }

    if (IN(8)) {
        pg8::Gemm g{WSP(bf16, WS_ACT), WSP(bf16, WS_WDN), DFF, DFF, DFF}; pg8::StaticOrder S; S.init(MP, 2048, F.G, c);
        EpiDown E{F.out};
        if (!(args.flags & 1)) pg8::gemm_phase<EpiDown, pg8::StaticOrder, true, true>(F.lds + RING_OFF, g, S, E);
        if (!(args.flags & 2)) p8_sample(F, c);
        SEAM(8);
    }

    if (IN(9)) { p9_final(F); }
#undef IN
#undef SEAM
}

#ifndef MK_N_LAUNCHES
#define MK_N_LAUNCHES 1
#endif
extern "C" void kernel_launch(void* const* d_in, const int* in_sizes, int n_in, void* d_out, int out_size, void* d_ws, size_t ws_size, hipStream_t stream) {
    static int grid = 0;
    if (grid == 0) {
        if (n_in != 28 || (size_t)out_size != O_END || ws_size < WS_END) { fprintf(stderr, "kernel_launch: unexpected shapes: n_in %d out %d ws %zu (want 28, %zu, >= %zu)\n", n_in, out_size, ws_size, (size_t)O_END, (size_t)WS_END); grid = -1; return; }
        int dev = 0, cus = 0, per_cu = 0;
        if (hipGetDevice(&dev) != hipSuccess || hipDeviceGetAttribute(&cus, hipDeviceAttributeMultiprocessorCount, dev) != hipSuccess) { grid = -1; return; }
        if (hipFuncSetAttribute((const void*)hybrid_fwd, hipFuncAttributeMaxDynamicSharedMemorySize, LDS_BYTES) != hipSuccess) { fprintf(stderr, "kernel_launch: hipFuncSetAttribute failed\n"); grid = -1; return; }
        if (hipOccupancyMaxActiveBlocksPerMultiprocessor(&per_cu, (const void*)hybrid_fwd, 512, LDS_BYTES) != hipSuccess || per_cu < 1) fprintf(stderr, "kernel_launch: occupancy query reports %d\n", per_cu);
        (void)hipGetLastError();
        grid = cus;
        if (grid != 256) fprintf(stderr, "kernel_launch: %d CUs (built for 256)\n", grid);
    }
    if (grid < 0) return;
    (void)hipMemsetAsync((char*)d_ws + WS_CTL, 0, CTL_ZERO_BYTES, stream);
    Args a{};
    for (int i = 0; i < 28; ++i) a.in[i] = d_in[i];
    a.out = (float*)d_out; a.ws = (unsigned char*)d_ws;
#ifndef PROBE_FLAGS
#define PROBE_FLAGS 0
#endif
#ifdef PROBE_PHASE
    { const int k = PROBE_PHASE; const int cuts[4] = {0, k + 1, k + 1, NPHASE}; const int los[3] = {0, k, k + 1};
      for (int li = 0; li < 3; ++li) { a.ph_lo = los[li]; a.ph_hi = (li == 1) ? k + 1 : cuts[li == 0 ? 1 : 3]; a.li = li; a.qoff = (li == 1) ? 3 : 0; a.flags = (li == 1) ? PROBE_FLAGS : 0; if (a.ph_lo < a.ph_hi) hipLaunchKernelGGL(hybrid_fwd, dim3(grid), dim3(512), LDS_BYTES, stream, a); } }
#else
    if (MK_N_LAUNCHES == 1) { a.ph_lo = 0; a.ph_hi = NPHASE; hipLaunchKernelGGL(hybrid_fwd, dim3(grid), dim3(512), LDS_BYTES, stream, a); }
    else for (int p = 0; p < NPHASE; ++p) { a.ph_lo = p; a.ph_hi = p + 1; hipLaunchKernelGGL(hybrid_fwd, dim3(grid), dim3(512), LDS_BYTES, stream, a); }
#endif
}
```
